# Optimizing an MI355X kernel written in HIP

```python
import math
import jax
import jax.numpy as jnp
from jax import lax
import numpy as np

D_MODEL = 2048
BATCH = 8
SEQ = 2048
DEPTH = 2

CHUNK = 64
Q_BLOCK = 128
EPS = 1e-6

GLA_DV = 128
GLA_DK = GLA_DV // 2
GLA_WIDTH = 3 * D_MODEL // 8
GLA_HEADS = GLA_WIDTH // GLA_DV
GLA_KEY_WIDTH = GLA_HEADS * GLA_DK
GLA_LOWRANK = 16
GLA_TAU = 16.0

LRU_WIDTH = D_MODEL // 4
LRU_BLOCKS = 8
LRU_BLOCK_DIM = LRU_WIDTH // LRU_BLOCKS
CONV_WIDTH = 4
LRU_C = 8.0

DIFF_DH = 64
DIFF_DV = 2 * DIFF_DH
DIFF_WIDTH = D_MODEL - GLA_WIDTH - LRU_WIDTH
DIFF_HEADS = DIFF_WIDTH // DIFF_DV
DIFF_QK_WIDTH = DIFF_HEADS * 2 * DIFF_DH

MIX_WIDTH = GLA_WIDTH + LRU_WIDTH + DIFF_WIDTH

REL_BUCKETS = 32
REL_MAX_DIST = 128

N_GROUPS = 8
EXPERTS_PER_GROUP = 8
N_EXPERTS = N_GROUPS * EXPERTS_PER_GROUP
TOP_K = 2
D_EXPERT = D_MODEL // 4
MOE_BLOCK = 128

IN_SIZES = (GLA_KEY_WIDTH, GLA_KEY_WIDTH, GLA_WIDTH, GLA_WIDTH, GLA_LOWRANK,
            LRU_WIDTH, LRU_WIDTH,
            DIFF_QK_WIDTH, DIFF_QK_WIDTH, DIFF_WIDTH)
IN_WIDTH = sum(IN_SIZES)
IN_SPLITS = tuple(int(s) for s in np.cumsum(IN_SIZES)[:-1])

kernel_name = "hybrid_gla_rglru_diffattn_hmoe"


def rmsnorm(x, g):
    xf = x.astype(jnp.float32)
    y = xf * lax.rsqrt(jnp.mean(xf * xf, axis=-1, keepdims=True) + EPS)
    return (y * g.astype(jnp.float32)).astype(x.dtype)


def head_rms(o):
    return o * lax.rsqrt(jnp.mean(o * o, axis=-1, keepdims=True) + EPS)


def t5_bucket(rel):
    nb = REL_BUCKETS // 2
    ret = (rel > 0).astype(jnp.int32) * nb
    n = jnp.abs(rel)
    max_exact = nb // 2
    nf = jnp.maximum(n, 1).astype(jnp.float32)
    large = max_exact + (jnp.log(nf / max_exact) / math.log(REL_MAX_DIST / max_exact)
                         * (nb - max_exact)).astype(jnp.int32)
    large = jnp.minimum(large, nb - 1)
    return ret + jnp.where(n < max_exact, n, large)


def gla_mixer(q, k, v, og, a_lr, w_a2, b_a, norm_g):
    f32 = jnp.float32
    B, S, _ = q.shape
    N = S // CHUNK
    log_alpha = jax.nn.log_sigmoid(a_lr.astype(f32) @ w_a2.astype(f32) + b_a.astype(f32)) / GLA_TAU

    def heads(t, d):
        return t.astype(f32).reshape(B, N, CHUNK, GLA_HEADS, d).transpose(0, 3, 1, 2, 4)

    qh = heads(q, GLA_DK) * (GLA_DK ** -0.5)
    kh = heads(k, GLA_DK)
    vh = heads(v, GLA_DV)
    G = jnp.cumsum(heads(log_alpha, GLA_DK), axis=3)
    G_last = G[:, :, :, -1:, :]
    eG = jnp.exp(G)
    enG = jnp.exp(-G)
    q_fwd = qh * eG
    a_fwd = jnp.einsum('bhnid,bhnjd->bhnij', q_fwd, kh * enG)
    a_bwd = jnp.einsum('bhnid,bhnjd->bhnij', qh * enG, kh * eG)
    causal = jnp.tril(jnp.ones((CHUNK, CHUNK), dtype=bool))
    attn = jnp.where(causal, a_fwd, a_bwd)
    o_intra = jnp.einsum('bhnij,bhnjv->bhniv', attn, vh)
    kv = jnp.einsum('bhncd,bhncv->bhndv', kh * jnp.exp(G_last - G), vh)
    decay = jnp.exp(G_last[:, :, :, 0, :])

    def step(state, inp):
        kv_n, dec_n = inp
        return dec_n[..., None] * state + kv_n, state

    init = jnp.zeros((B, GLA_HEADS, GLA_DK, GLA_DV), f32)
    _, s_prev = lax.scan(step, init, (jnp.moveaxis(kv, 2, 0), jnp.moveaxis(decay, 2, 0)))
    s_prev = jnp.moveaxis(s_prev, 0, 2)
    o_inter = jnp.einsum('bhncd,bhndv->bhncv', q_fwd, s_prev)
    o = (o_intra + o_inter).transpose(0, 2, 3, 1, 4).reshape(B, S, GLA_HEADS, GLA_DV)
    o = head_rms(o).reshape(B, S, GLA_WIDTH) * norm_g.astype(f32)
    return o * jax.nn.silu(og.astype(f32))


def rglru_mixer(y_br, x_br, conv_w, conv_b, wa, ba, wx, bx, lam):
    f32 = jnp.float32
    B, S, W = x_br.shape
    xp = jnp.pad(x_br.astype(f32), ((0, 0), (CONV_WIDTH - 1, 0), (0, 0)))
    xc = conv_b.astype(f32)
    for i in range(CONV_WIDTH):
        xc = xc + xp[:, i:i + S] * conv_w[i].astype(f32)
    xb = xc.reshape(B, S, LRU_BLOCKS, LRU_BLOCK_DIM)
    r = jax.nn.sigmoid(jnp.einsum('bsnd,nde->bsne', xb, wa.astype(f32)).reshape(B, S, W) + ba.astype(f32))
    ig = jax.nn.sigmoid(jnp.einsum('bsnd,nde->bsne', xb, wx.astype(f32)).reshape(B, S, W) + bx.astype(f32))
    log_a = -LRU_C * r * jax.nn.softplus(-lam.astype(f32))
    a = jnp.exp(log_a)
    b = jnp.sqrt(-jnp.expm1(2.0 * log_a)) * (ig * xc)

    def combine(lhs, rhs):
        a1, b1 = lhs
        a2, b2 = rhs
        return a1 * a2, a2 * b1 + b2

    _, h = lax.associative_scan(combine, (a, b), axis=1)
    return h * jax.nn.gelu(y_br.astype(f32))


def diff_attention(q, k, v, lq1, lk1, lq2, lk2, subln_g, rel_table, layer_idx):
    f32 = jnp.float32
    B, S, _ = q.shape
    qh = q.astype(f32).reshape(B, S, DIFF_HEADS, 2, DIFF_DH).transpose(0, 2, 3, 1, 4) * (DIFF_DH ** -0.5)
    kh = k.astype(f32).reshape(B, S, DIFF_HEADS, 2, DIFF_DH).transpose(0, 2, 3, 1, 4)
    vh = v.astype(f32).reshape(B, S, DIFF_HEADS, DIFF_DV).transpose(0, 2, 1, 3)
    lam_init = 0.8 - 0.6 * math.exp(-0.3 * layer_idx)
    lam = (jnp.exp(jnp.sum(lq1.astype(f32) * lk1.astype(f32)))
           - jnp.exp(jnp.sum(lq2.astype(f32) * lk2.astype(f32))) + lam_init)
    table = rel_table.astype(f32)
    pos = jnp.arange(S, dtype=jnp.int32)
    outs = []
    for blk in range(S // Q_BLOCK):
        q0 = blk * Q_BLOCK
        kv_len = q0 + Q_BLOCK
        qp = pos[q0:kv_len]
        kp = pos[:kv_len]
        bias = table[t5_bucket(kp[None, :] - qp[:, None])].transpose(2, 0, 1)[:, None]
        mask = (kp[None, :] // CHUNK) <= (qp[:, None] // CHUNK)
        logits = jnp.einsum('bhmqd,bhmkd->bhmqk', qh[:, :, :, q0:kv_len], kh[:, :, :, :kv_len]) + bias
        p = jax.nn.softmax(jnp.where(mask, logits, -1e30), axis=-1)
        attn = p[:, :, 0] - lam * p[:, :, 1]
        outs.append(jnp.einsum('bhqk,bhkv->bhqv', attn, vh[:, :, :kv_len]))
    o = jnp.concatenate(outs, axis=2)
    o = head_rms(o) * subln_g.astype(f32) * (1.0 - lam_init)
    return o.transpose(0, 2, 1, 3).reshape(B, S, DIFF_WIDTH)


def hier_moe(u, wg, bg, we, be, w1, w3, w2):
    f32 = jnp.float32
    B, S, D = u.shape
    T = B * S
    xt = u.reshape(T, D)
    tok_ids = jnp.arange(T, dtype=jnp.int32)
    g_logits = (xt @ wg + bg).astype(f32)
    g_prob = jax.nn.softmax(g_logits, axis=-1)
    g_idx = jnp.argmax(g_logits, axis=-1).astype(jnp.int32)
    g_w = g_prob[tok_ids, g_idx]
    e_all = (xt @ we + be).astype(f32).reshape(T, N_GROUPS, EXPERTS_PER_GROUP)
    e_logits = e_all[tok_ids, g_idx]
    top_v, top_i = lax.top_k(e_logits, TOP_K)
    e_w = jax.nn.softmax(top_v, axis=-1)
    expert = (g_idx[:, None] * EXPERTS_PER_GROUP + top_i).reshape(-1)
    weight = (g_w[:, None] * e_w).reshape(-1)
    tok = jnp.repeat(tok_ids, TOP_K)
    A = T * TOP_K
    order = jnp.argsort(expert)
    e_sorted = expert[order]
    counts = jnp.bincount(expert, length=N_EXPERTS)
    starts = jnp.cumsum(counts) - counts
    padded = (counts + MOE_BLOCK - 1) // MOE_BLOCK * MOE_BLOCK
    pends = jnp.cumsum(padded)
    pstarts = pends - padded
    dest = pstarts[e_sorted] + (jnp.arange(A, dtype=jnp.int32) - starts[e_sorted])
    P = A + N_EXPERTS * MOE_BLOCK
    n_blocks = P // MOE_BLOCK
    slot_tok = jnp.zeros((P,), jnp.int32).at[dest].set(tok[order])
    slot_w = jnp.zeros((P,), f32).at[dest].set(weight[order])
    block_start = jnp.arange(n_blocks, dtype=pends.dtype) * MOE_BLOCK
    block_expert = jnp.minimum(jnp.searchsorted(pends, block_start, side='right'), N_EXPERTS - 1)
    xs = xt[slot_tok].reshape(n_blocks, MOE_BLOCK, D)

    def run_block(args):
        xb, e = args
        hid = jax.nn.silu(xb @ w1[e]) * (xb @ w3[e])
        return hid @ w2[e]

    y = lax.map(run_block, (xs, block_expert)).reshape(P, D)
    out = jnp.zeros((T, D), f32).at[slot_tok].add(y.astype(f32) * slot_w[:, None])
    return out.reshape(B, S, D).astype(u.dtype)


def setup_inputs(seed: int = 0) -> dict:
    key = jax.random.key(seed)
    ks = jax.random.split(key, 32)
    L, D = DEPTH, D_MODEL

    def nrm(k, shape, scale):
        return jax.random.normal(k, shape, jnp.float32) * scale

    u = jax.random.uniform(ks[15], (L, LRU_WIDTH), jnp.float32, minval=0.9, maxval=0.999)
    a0 = u ** (1.0 / LRU_C)
    return {
        "x": nrm(ks[0], (BATCH, SEQ, D), 1.0),
        "c": nrm(ks[1], (BATCH, D), 1.0),
        "ada_w": nrm(ks[2], (L, D, 6 * D), 0.5 * D ** -0.5),
        "ada_b": nrm(ks[3], (L, 6 * D), 0.02),
        "norm1_g": 1.0 + nrm(ks[4], (L, D), 0.02),
        "w_in": nrm(ks[5], (L, D, IN_WIDTH), D ** -0.5),
        "gla_w_a2": nrm(ks[6], (L, GLA_LOWRANK, GLA_KEY_WIDTH), GLA_LOWRANK ** -0.5),
        "gla_b_a": nrm(ks[7], (L, GLA_KEY_WIDTH), 0.02),
        "gla_norm_g": 1.0 + nrm(ks[8], (L, GLA_WIDTH), 0.02),
        "lru_conv_w": nrm(ks[9], (L, CONV_WIDTH, LRU_WIDTH), CONV_WIDTH ** -0.5),
        "lru_conv_b": nrm(ks[10], (L, LRU_WIDTH), 0.02),
        "lru_wa": nrm(ks[11], (L, LRU_BLOCKS, LRU_BLOCK_DIM, LRU_BLOCK_DIM), LRU_BLOCK_DIM ** -0.5),
        "lru_ba": nrm(ks[12], (L, LRU_WIDTH), 0.02),
        "lru_wx": nrm(ks[13], (L, LRU_BLOCKS, LRU_BLOCK_DIM, LRU_BLOCK_DIM), LRU_BLOCK_DIM ** -0.5),
        "lru_bx": nrm(ks[14], (L, LRU_WIDTH), 0.02),
        "lru_lambda": jnp.log(a0) - jnp.log1p(-a0),
        "diff_lq1": nrm(ks[16], (L, DIFF_DH), 0.1),
        "diff_lk1": nrm(ks[17], (L, DIFF_DH), 0.1),
        "diff_lq2": nrm(ks[18], (L, DIFF_DH), 0.1),
        "diff_lk2": nrm(ks[19], (L, DIFF_DH), 0.1),
        "diff_subln_g": 1.0 + nrm(ks[20], (L, DIFF_DV), 0.02),
        "rel_bias": nrm(ks[21], (REL_BUCKETS, DIFF_HEADS), 0.5),
        "w_out": nrm(ks[22], (L, MIX_WIDTH, D), MIX_WIDTH ** -0.5),
        "norm2_g": 1.0 + nrm(ks[23], (L, D), 0.02),
        "router_g_w": nrm(ks[24], (L, D, N_GROUPS), D ** -0.5),
        "router_g_b": nrm(ks[25], (L, N_GROUPS), 0.01),
        "router_e_w": nrm(ks[26], (L, D, N_EXPERTS), D ** -0.5),
        "router_e_b": nrm(ks[27], (L, N_EXPERTS), 0.01),
        "moe_w1": nrm(ks[28], (L, N_EXPERTS, D, D_EXPERT), D ** -0.5),
        "moe_w3": nrm(ks[29], (L, N_EXPERTS, D, D_EXPERT), D ** -0.5),
        "moe_w2": nrm(ks[30], (L, N_EXPERTS, D_EXPERT, D), D_EXPERT ** -0.5),
        "final_g": 1.0 + nrm(ks[31], (D,), 0.02),
    }


def reference(x, c, ada_w, ada_b, norm1_g, w_in, gla_w_a2, gla_b_a, gla_norm_g,
              lru_conv_w, lru_conv_b, lru_wa, lru_ba, lru_wx, lru_bx, lru_lambda,
              diff_lq1, diff_lk1, diff_lq2, diff_lk2, diff_subln_g, rel_bias, w_out,
              norm2_g, router_g_w, router_g_b, router_e_w, router_e_b,
              moe_w1, moe_w3, moe_w2, final_g):
    h = x
    for l in range(DEPTH):
        mod = jax.nn.silu(c) @ ada_w[l] + ada_b[l]
        sh1, sc1, g1, sh2, sc2, g2 = jnp.split(mod[:, None, :], 6, axis=-1)
        u = rmsnorm(h, norm1_g[l]) * (1.0 + sc1) + sh1
        proj = u @ w_in[l]
        gq, gk, gv, gog, ga, ly, lx, dq, dk, dv = jnp.split(proj, IN_SPLITS, axis=-1)
        o_gla = gla_mixer(gq, gk, gv, gog, ga, gla_w_a2[l], gla_b_a[l], gla_norm_g[l])
        o_lru = rglru_mixer(ly, lx, lru_conv_w[l], lru_conv_b[l], lru_wa[l], lru_ba[l],
                            lru_wx[l], lru_bx[l], lru_lambda[l])
        o_diff = diff_attention(dq, dk, dv, diff_lq1[l], diff_lk1[l], diff_lq2[l], diff_lk2[l],
                                diff_subln_g[l], rel_bias, l)
        mixed = jnp.concatenate([o_gla, o_lru, o_diff], axis=-1).astype(u.dtype)
        h = h + g1 * (mixed @ w_out[l])
        u = rmsnorm(h, norm2_g[l]) * (1.0 + sc2) + sh2
        h = h + g2 * hier_moe(u, router_g_w[l], router_g_b[l], router_e_w[l], router_e_b[l],
                              moe_w1[l], moe_w3[l], moe_w2[l])
    return rmsnorm(h, final_g)
```

```cpp
#include <hip/hip_runtime.h>
#include <cstdio>
#include <cstdint>

#define PLAN {0, 16, 0}

#define GAS __attribute__((address_space(1)))
#define LAS __attribute__((address_space(3)))
typedef unsigned short bf16;
typedef short bf16x8 __attribute__((ext_vector_type(8)));
typedef short s16x4 __attribute__((ext_vector_type(4)));
typedef float f32x2 __attribute__((ext_vector_type(2)));
typedef float f32x4 __attribute__((ext_vector_type(4)));
typedef float f32x16 __attribute__((ext_vector_type(16)));
typedef unsigned u32x2 __attribute__((ext_vector_type(2)));
typedef unsigned u32x4 __attribute__((ext_vector_type(4)));
typedef __bf16 bf16x2_t __attribute__((ext_vector_type(2)));
#define DI __device__ __forceinline__

constexpr int NB = 8, SEQ = 2048, D = 2048, T = NB * SEQ, NL = 2;
constexpr int INW = 5648, PLD = 5888;
constexpr int C_GQ = 0, C_GK = 384, C_GV = 768, C_GOG = 1536, C_LY = 2304, C_LX = 2816, C_DQ = 3328, C_DK = 4096, C_DV = 4864, C_GA = 5632;
constexpr int NE = 64, DE = 512;
constexpr float EPS = 1e-6f, LOG2E = 1.4426950408889634f;
constexpr int NPH = 16;

constexpr size_t MiB = 1u << 20;
constexpr size_t WS_CTL = 0, CTL_BYTES = 65536;
constexpr size_t WS_MOD = 1 * MiB;
constexpr size_t WS_WR = 2 * MiB;
constexpr size_t WS_LIST = 4 * MiB;
constexpr size_t WS_WT = 8 * MiB;
constexpr size_t WS_CB = 8 * MiB + 512 * 1024;
constexpr size_t WS_PAR = 9 * MiB;
constexpr size_t WS_WIN = 16 * MiB;
constexpr size_t WS_WOUT = 64 * MiB;
constexpr size_t WS_W13 = 80 * MiB;
constexpr size_t WS_W2 = 592 * MiB;
constexpr size_t WS_H = 848 * MiB;
constexpr size_t WS_U = 976 * MiB;
constexpr size_t WS_PROJ = 1040 * MiB;
constexpr size_t WS_MIX = 1224 * MiB;
constexpr size_t WS_HID = 1288 * MiB;
constexpr size_t WS_Y2 = 1336 * MiB;
constexpr size_t WS_DELTA = 1464 * MiB;
constexpr size_t WS_END = 1528 * MiB;
constexpr int CW_FLAG = 0;
constexpr int CW_Q = 64;
constexpr int CW_CNT = 2048;
constexpr int CW_BAR = 4096;

constexpr int RING_BYTES = 131072;
constexpr int ROWTAB_OFF = 131072;
constexpr int TILETAB_OFF = 143360;
constexpr int MISC_OFF = 145408;
constexpr int LDS_BYTES = 147456;

DI unsigned pk2(float lo, float hi) { f32x2 v = {lo, hi}; return __builtin_bit_cast(unsigned, __builtin_convertvector(v, bf16x2_t)); }
DI float bflo(unsigned w) { return __uint_as_float(w << 16); }
DI float bfhi(unsigned w) { return __uint_as_float(w & 0xffff0000u); }
DI float bf2f(bf16 v) { return __uint_as_float((unsigned)v << 16); }
DI float wave_sum(float v) {
#pragma unroll
    for (int o = 1; o < 64; o <<= 1) v += __shfl_xor(v, o);
    return v;
}
DI float frcp(float x) { return __builtin_amdgcn_rcpf(x); }
DI float fsigmoid(float x) { return frcp(1.f + __builtin_amdgcn_exp2f(-1.4426950408889634f * x)); }
DI float fsilu(float x) { return x * frcp(1.f + __builtin_amdgcn_exp2f(-1.4426950408889634f * x)); }
DI float fgelu_tanh(float x) { const float u2 = (2.0f * 0.7978845608028654f * 1.4426950408889634f) * (x + 0.044715f * x * x * x); return x * frcp(1.f + __builtin_amdgcn_exp2f(-u2)); }
#define LDS_WAIT() asm volatile("s_waitcnt lgkmcnt(0)" ::: "memory")
#define VM_WAIT() asm volatile("s_waitcnt vmcnt(0)" ::: "memory")
#define LBAR() do { asm volatile("s_waitcnt lgkmcnt(0)" ::: "memory"); __builtin_amdgcn_s_barrier(); asm volatile("" ::: "memory"); } while (0)

#define XB_TMO      128
#define XB_XCNT(j)  (256  + 64 * (j))
#define XB_XSUB(j)  (1280 + 64 * (j))
#define XB_XGEN(j)  (2304 + 64 * (j))
#define XB_TOP      3328
#define XB_TOPGEN   3392
#define XCD_BAR_WORDS 3456
#define XB_SPIN_CAP (1u << 18)
DI unsigned xb_ld(unsigned* p)              { return __hip_atomic_load(p, __ATOMIC_RELAXED, __HIP_MEMORY_SCOPE_AGENT); }
DI unsigned xb_add(unsigned* p, unsigned v) { return __hip_atomic_fetch_add(p, v, __ATOMIC_RELAXED, __HIP_MEMORY_SCOPE_AGENT); }
DI unsigned xb_xcc_id() { return (unsigned)__builtin_amdgcn_s_getreg((3 << 11) | 20) & 0xFu; }
#define XB_SPIN(cond, bar) do { unsigned _sp = 0; while (cond) { __builtin_amdgcn_s_sleep(1); \
    if ((++_sp & 255u) == 0u) { if (xb_ld(&(bar)[XB_TMO])) break; if (_sp > XB_SPIN_CAP) { atomicAdd(&(bar)[XB_TMO], 1u); break; } } } } while (0)
struct XcdBarrier { unsigned* bar; unsigned x; volatile LAS unsigned* st; };
DI XcdBarrier xcd_barrier_post(unsigned* bar, volatile LAS unsigned* st) {
    XcdBarrier b; b.bar = bar; b.x = xb_xcc_id(); b.st = st;
    if (threadIdx.x == 0) (void)xb_add(&bar[XB_XCNT(b.x)], 1u);
    return b;
}
DI void xcd_barrier_complete(unsigned* bar, unsigned x, unsigned& nloc, unsigned& nx) {
    const unsigned G = gridDim.x * gridDim.y * gridDim.z;
    unsigned sum, cnt, mine, sp = 0u;
    for (;;) {
        sum = 0u; cnt = 0u; mine = 0u;
#pragma unroll
        for (unsigned j = 0; j < 16; ++j) { const unsigned c = xb_ld(&bar[XB_XCNT(j)]); sum += c; cnt += (c > 0u) ? 1u : 0u; mine = (j == x) ? c : mine; }
        if (sum == G) break;
        __builtin_amdgcn_s_sleep(1);
        if ((++sp & 255u) == 0u) { if (xb_ld(&bar[XB_TMO])) break; if (sp > XB_SPIN_CAP) { atomicAdd(&bar[XB_TMO], 1u); break; } }
    }
    nloc = mine > 0u ? mine : 1u; nx = cnt > 0u ? cnt : 1u;
}
DI void xcd_barrier(const XcdBarrier& b) {
    asm volatile("s_waitcnt vmcnt(0)" ::: "memory");
    __syncthreads();
    if (threadIdx.x == 0) {
        unsigned* bar = b.bar;
        __builtin_amdgcn_s_waitcnt(0);
        unsigned nloc = b.st[0], nx = b.st[1];
        if (nloc == 0u) { xcd_barrier_complete(bar, b.x, nloc, nx); b.st[0] = nloc; b.st[1] = nx; }
        const unsigned old = xb_add(&bar[XB_XSUB(b.x)], 1u);
        const unsigned gen = old / nloc;
        if (old + 1u == (gen + 1u) * nloc) {
            __builtin_amdgcn_fence(__ATOMIC_RELEASE, "agent");
            asm volatile("s_waitcnt vmcnt(0)" ::: "memory");
            const unsigned og = xb_add(&bar[XB_TOP], 1u);
            const unsigned tg = og / nx;
            if (og + 1u == (tg + 1u) * nx) xb_add(&bar[XB_TOPGEN], 1u);
            else XB_SPIN(xb_ld(&bar[XB_TOPGEN]) == tg, bar);
            __builtin_amdgcn_fence(__ATOMIC_ACQUIRE, "agent");
            xb_add(&bar[XB_XGEN(b.x)], 1u);
            asm volatile("s_waitcnt vmcnt(0)" ::: "memory");
        } else {
            XB_SPIN(xb_ld(&bar[XB_XGEN(b.x)]) == gen, bar);
            __builtin_amdgcn_fence(__ATOMIC_ACQUIRE, "agent");
            asm volatile("s_waitcnt vmcnt(0)" ::: "memory");
        }
    }
    __syncthreads();
}

namespace pg8 {
constexpr int BM = 256, BK = 64, HALF = 128, HTB = HALF * BK * 2, STAGE_BYTES = 8 * HTB, NXCD = 8, WGM = 8;
__host__ __device__ __forceinline__ int lds_byte(int r, int c) { const int st = (r >> 4) * 2 + (c >> 5), rr = r & 15, cc = c & 31, ob = rr * 64 + cc * 2; return st * 1024 + (ob ^ (((ob >> 9) & 1) << 5)); }
__host__ __device__ __forceinline__ void stage_rc(int b, int& R, int& C) { const int st = b / 1024, sb = b % 1024, swz = sb ^ (((sb >> 9) & 1) << 5); R = (st >> 1) * 16 + swz / 64; C = (st & 1) * 32 + (swz % 64) / 2; }
__host__ __device__ __forceinline__ int perm32(int rho) { const int n = rho >> 4, i = rho & 15; return 8 * (i >> 2) + 4 * n + (i & 3); }

struct Unit { int pm, pn, e, aux; };

DI s16x4 tr_read_b(const LAS unsigned char* p) { return __builtin_bit_cast(s16x4, __builtin_amdgcn_ds_read_tr16_b64_v4i16((LAS s16x4*)p)); }
template <class Epi, class Sched, bool ALIGN_EPI = true, int BF = 0>
DI void gemm_phase(LAS unsigned char* lds, const Sched& S, const Epi& E) {
    int tid_ = threadIdx.x; asm volatile("" : "+v"(tid_));
    const int tid = tid_, wid = __builtin_amdgcn_readfirstlane(tid >> 6), lane = tid & 63, wr = wid >> 2, wc = wid & 3, fr = lane & 15, fq = lane >> 4;
    const int K = S.K, nt = K / BK;
    const unsigned K2 = (unsigned)K * 2u;
    unsigned voffB[2];
#pragma unroll
    for (int i = 0; i < 2; ++i) { int R, C; stage_rc(tid * 16 + i * 8192, R, C); const int Rb = Epi::PERM ? ((R & ~31) + perm32(R & 31)) : R;
        voffB[i] = (unsigned)(Rb * K + C) * 2u; }
    const unsigned hstepB = (unsigned)HALF * K * 2u;
    const unsigned ldsw = (unsigned)wid * 1024u;
    const int aoff = lds_byte(wr * 64 + fr, fq * 8), boff = lds_byte(wc * 32 + fr, fq * 8);
    const __amdgpu_buffer_rsrc_t rsA = __builtin_amdgcn_make_buffer_rsrc((void*)S.A, 0, 0x7fffffff, 0x00020000);
    const __amdgpu_buffer_rsrc_t rsB = __builtin_amdgcn_make_buffer_rsrc((void*)S.Bt, 0, 0x7fffffff, 0x00020000);
    const __amdgpu_buffer_rsrc_t rsF = __builtin_amdgcn_make_buffer_rsrc((void*)((BF == 1 && (wid & 1)) ? S.Bf1 : S.Bf0), 0, 0x7fffffff, 0x00020000);
    constexpr unsigned KBMUL = (BF == 1) ? 1024u : 4096u, ROWB = (BF == 1) ? 2048u : 8192u;
    unsigned voffF = 0, wrowoff = 0, bwr0 = 0, brd0 = 0; const unsigned ldsbase = (unsigned)(unsigned long long)lds;
    u32x4 bq[8];
    if constexpr (BF == 2) {
        const unsigned r0 = ((unsigned)wid & 3u) + 8u * ((unsigned)wid >> 2);
        voffF = (unsigned)lane * 16u; wrowoff = r0 * ROWB;
        const unsigned seg = 8u * (lane >> 3) + 4u * (lane & 1) + ((lane >> 1) & 3);
        bwr0 = r0 * 512u + ((seg ^ (((r0 & 3u) << 2) | (((r0 >> 3) & 1u) << 4))) << 3);
    } else if constexpr (BF == 1) {
        const unsigned rh = lane >> 5, c = lane & 31, kq = (unsigned)wid >> 1, hs = (unsigned)wid & 1u;
        const unsigned r0w = 2u * (kq & 1u) + 8u * (kq >> 1), r0 = r0w + rh;
        voffF = rh * ROWB + c * 16u; wrowoff = r0w * ROWB;
        const unsigned seg = 32u * hs + 8u * (c >> 3) + 4u * (c & 1) + ((c >> 1) & 3);
        bwr0 = r0 * 512u + ((seg ^ (((r0 & 3u) << 2) | (((r0 >> 3) & 1u) << 4))) << 3);
    }
    if constexpr (BF != 0) {
        const unsigned segb = 8u * wc, mask = (((unsigned)fr >> 2) << 2) | (((unsigned)fq & 1u) << 4);
        brd0 = (unsigned)(8 * fq + (fr >> 2)) * 512u + (((segb ^ mask) | ((unsigned)fr & 3u)) << 3);
    }
    const unsigned brdA = ldsbase + brd0, brdB = ldsbase + (brd0 ^ 32u);
#define PG8_ROWD(i) ((unsigned)(((i) & 1) * 4 + ((i) >> 1) * 16))
#define PG8_LDBF(bp, kb) do { const unsigned _s = (bp) + (kb) * KBMUL + wrowoff; _Pragma("unroll") for (int _i = 0; _i < 8; ++_i) \
        bq[_i] = __builtin_bit_cast(u32x4, __builtin_amdgcn_raw_buffer_load_b128(rsF, voffF, _s + PG8_ROWD(_i) * ROWB, 0)); } while (0)
#define PG8_WRB(slot) do { PG8_WAIT_V(4); _Pragma("unroll") for (int _i = 0; _i < 8; ++_i) { \
        u32x2 _w; _w.x = pk2(__uint_as_float(bq[_i].x), __uint_as_float(bq[_i].y)); _w.y = pk2(__uint_as_float(bq[_i].z), __uint_as_float(bq[_i].w)); \
        *(LAS u32x2*)(lds + PG8_SB(slot, 0) + bwr0 + PG8_ROWD(_i) * 512u) = _w; } } while (0)
#define PG8_TR(d, a, off) asm volatile("ds_read_b64_tr_b16 %0, %1 offset:%2" : "=v"(d) : "v"(a), "i"(off) : "memory")
#define PG8_LDBT(dst, b, bj) do { constexpr int _o = PG8_SB(b, 0) + (bj) * 256; s16x4 _t0, _t1, _t2, _t3, _t4, _t5, _t6, _t7; \
        PG8_TR(_t0, brdA, _o); PG8_TR(_t1, brdA, _o + 2048); PG8_TR(_t2, brdA, _o + 16384); PG8_TR(_t3, brdA, _o + 18432); PG8_TR(_t4, brdB, _o); PG8_TR(_t5, brdB, _o + 2048); PG8_TR(_t6, brdB, _o + 16384); PG8_TR(_t7, brdB, _o + 18432); \
        dst[0][0] = __builtin_shufflevector(_t0, _t1, 0, 1, 2, 3, 4, 5, 6, 7); dst[0][1] = __builtin_shufflevector(_t2, _t3, 0, 1, 2, 3, 4, 5, 6, 7); \
        dst[1][0] = __builtin_shufflevector(_t4, _t5, 0, 1, 2, 3, 4, 5, 6, 7); dst[1][1] = __builtin_shufflevector(_t6, _t7, 0, 1, 2, 3, 4, 5, 6, 7); } while (0)
#define PG8_TIEB(x) asm volatile("s_waitcnt lgkmcnt(0)" : "+v"(x[0][0]), "+v"(x[0][1]), "+v"(x[1][0]), "+v"(x[1][1]) :: "memory")
#define PG8_LDBTH(dst, n, b, bj) do { constexpr int _o = PG8_SB(b, 0) + (bj) * 256; const unsigned _a = (n) ? brdB : brdA; s16x4 _t0, _t1, _t2, _t3; \
        PG8_TR(_t0, _a, _o); PG8_TR(_t1, _a, _o + 2048); PG8_TR(_t2, _a, _o + 16384); PG8_TR(_t3, _a, _o + 18432); \
        dst[n][0] = __builtin_shufflevector(_t0, _t1, 0, 1, 2, 3, 4, 5, 6, 7); dst[n][1] = __builtin_shufflevector(_t2, _t3, 0, 1, 2, 3, 4, 5, 6, 7); } while (0)
#define PG8_TIEH(x, n, cnt) asm volatile("s_waitcnt lgkmcnt(" #cnt ")" : "+v"(x[n][0]), "+v"(x[n][1]) :: "memory")
#define PG8_MMAH(ai, bj, n, At, Bt) do { _Pragma("unroll") for (int m = 0; m < 4; ++m) _Pragma("unroll") for (int k = 0; k < 2; ++k) \
        acc[ai][bj][m][n] = __builtin_amdgcn_mfma_f32_16x16x32_bf16(Bt[n][k], At[m][k], acc[ai][bj][m][n], 0, 0, 0); } while (0)
#define PG8_MMA2(ai, bj0, bj1, b) do { __builtin_amdgcn_s_setprio(1); PG8_MMAH(ai, bj0, 0, At, B0); PG8_SCHED; PG8_LDBTH(B0, 0, b, bj1); PG8_SCHED; PG8_MMAH(ai, bj0, 1, At, B0); PG8_SCHED; PG8_LDBTH(B0, 1, b, bj1); PG8_SCHED; \
        PG8_TIEH(B0, 0, 4); PG8_MMAH(ai, bj1, 0, At, B0); PG8_SCHED; PG8_TIEH(B0, 1, 0); PG8_MMAH(ai, bj1, 1, At, B0); __builtin_amdgcn_s_setprio(0); } while (0)
#define PG8_SA(b, h) (((BF != 0 ? 4 : 0) + (b) * 2 + (h)) * HTB)
#define PG8_SB(b, h) (((BF != 0 ? 0 : 4) + (b) * 2 + (h)) * HTB)
#define PG8_STAGE_A(bufoff, kb, va) do { _Pragma("unroll") for (int _i = 0; _i < 2; ++_i) \
        __builtin_amdgcn_raw_ptr_buffer_load_lds(rsA, (LAS unsigned*)(lds + (bufoff) + ldsw + _i * 8192), 16, (va)[_i], (kb), 0, 0); } while (0)
#define PG8_STAGE_B(bufoff, bp, kb) do { _Pragma("unroll") for (int _i = 0; _i < 2; ++_i) \
        __builtin_amdgcn_raw_ptr_buffer_load_lds(rsB, (LAS unsigned*)(lds + (bufoff) + ldsw + _i * 8192), 16, voffB[_i], (bp) + (kb), 0, 0); } while (0)
#define PG8_LDA(dst, b, h) do { _Pragma("unroll") for (int m = 0; m < 4; ++m) _Pragma("unroll") for (int k = 0; k < 2; ++k) dst[m][k] = *(const LAS bf16x8*)(lds + PG8_SA(b, h) + aoff + m * 2048 + k * 1024); } while (0)
#define PG8_LDB(dst, b, h) do { _Pragma("unroll") for (int n = 0; n < 2; ++n) _Pragma("unroll") for (int k = 0; k < 2; ++k) dst[n][k] = *(const LAS bf16x8*)(lds + PG8_SB(b, h) + boff + n * 2048 + k * 1024); } while (0)
#define PG8_MMA(ai, bj, At, Bt) do { __builtin_amdgcn_s_setprio(1); _Pragma("unroll") for (int m = 0; m < 4; ++m) _Pragma("unroll") for (int n = 0; n < 2; ++n) _Pragma("unroll") for (int k = 0; k < 2; ++k) \
        acc[ai][bj][m][n] = __builtin_amdgcn_mfma_f32_16x16x32_bf16(Bt[n][k], At[m][k], acc[ai][bj][m][n], 0, 0, 0); __builtin_amdgcn_s_setprio(0); } while (0)
#define PG8_WAIT_V(n) asm volatile("s_waitcnt vmcnt(" #n ")" ::: "memory")
#define PG8_WAIT_L(n) asm volatile("s_waitcnt lgkmcnt(" #n ")" ::: "memory")
#define PG8_BAR __builtin_amdgcn_s_barrier()
#define PG8_SCHED __builtin_amdgcn_sched_barrier(0)
    Unit cur, nxt; int ui = 0;
    if (!S.next(0, cur)) return;
    f32x4 acc[2][2][4][2];
#pragma unroll
    for (int a = 0; a < 2; ++a)
#pragma unroll
        for (int b = 0; b < 2; ++b)
#pragma unroll
            for (int m = 0; m < 4; ++m)
#pragma unroll
                for (int n = 0; n < 2; ++n) acc[a][b][m][n] = (f32x4){0.f, 0.f, 0.f, 0.f};
    bf16x8 At[4][2], B0[2][2], B1[2][2];
    unsigned vAc[2][2];
#define PG8_SETVA(dst, unit, uidx) do { int _t = tid; if constexpr (BF != 0) asm volatile("" : "+v"(_t));   \
        _Pragma("unroll") for (int _i = 0; _i < 2; ++_i) { int _R, _C; stage_rc(_t * 16 + _i * 8192, _R, _C); \
        _Pragma("unroll") for (int _h = 0; _h < 2; ++_h) dst[_h][_i] = S.arow(unit, uidx, 128 * _h + _R) * K2 + (unsigned)_C * 2u; } } while (0)
    PG8_SETVA(vAc, cur, 0);
    unsigned cB = S.bbase(cur);
    if constexpr (BF == 0) {
        PG8_STAGE_B(PG8_SB(0, 0), cB, 0u); PG8_STAGE_B(PG8_SB(0, 1), cB + hstepB, 0u); PG8_STAGE_A(PG8_SA(0, 0), 0u, vAc[0]); PG8_STAGE_A(PG8_SA(0, 1), 0u, vAc[1]);
        if (wr == 1) PG8_BAR;
        PG8_WAIT_V(2); PG8_BAR;
        PG8_STAGE_B(PG8_SB(1, 0), cB, 128u); PG8_STAGE_A(PG8_SA(1, 0), 128u, vAc[0]); PG8_STAGE_B(PG8_SB(1, 1), cB + hstepB, 128u);
        PG8_WAIT_V(6); PG8_BAR;
    } else {
        PG8_LDBF(cB, 0u); PG8_STAGE_A(PG8_SA(0, 0), 0u, vAc[0]); PG8_STAGE_A(PG8_SA(0, 1), 0u, vAc[1]);
        if (wr == 1) PG8_BAR;
        PG8_WRB(0); PG8_WAIT_V(2); PG8_WAIT_L(0); PG8_BAR;
        PG8_LDBF(cB, 128u); PG8_STAGE_A(PG8_SA(1, 0), 128u, vAc[0]);
        PG8_WAIT_V(10); PG8_BAR;
    }
#define PG8_KTRIP(kb1, kb2, kb3, VA2, B2) do { if constexpr (BF != 0) { \
              \
            PG8_LDBT(B0, 0, 0); PG8_SCHED; PG8_LDA(At, 0, 0); PG8_STAGE_A(PG8_SA(1, 1), kb1, vAc[1]); \
            PG8_WAIT_V(12); PG8_TIEB(B0); PG8_BAR; PG8_MMA2(0, 0, 1, 0); PG8_BAR; PG8_SCHED; \
            PG8_WRB(1); PG8_SCHED; PG8_LDBF(B2, kb2); PG8_SCHED; PG8_LDA(At, 0, 1); PG8_STAGE_A(PG8_SA(0, 0), kb2, VA2[0]); \
            PG8_WAIT_V(12); PG8_WAIT_L(0); PG8_BAR; PG8_MMA2(1, 1, 0, 0); PG8_BAR; PG8_SCHED; \
            PG8_LDBT(B0, 1, 0); PG8_SCHED; PG8_LDA(At, 1, 0); PG8_STAGE_A(PG8_SA(0, 1), kb2, VA2[1]); \
            PG8_WAIT_V(12); PG8_TIEB(B0); PG8_BAR; PG8_MMA2(0, 0, 1, 1); PG8_BAR; PG8_SCHED; \
            PG8_WRB(0); PG8_SCHED; PG8_LDBF(B2, kb3); PG8_SCHED; PG8_LDA(At, 1, 1); PG8_STAGE_A(PG8_SA(1, 0), kb3, VA2[0]); \
            PG8_WAIT_V(12); PG8_WAIT_L(0); PG8_BAR; PG8_MMA2(1, 1, 0, 1); PG8_BAR; PG8_SCHED; } else { \
            PG8_LDB(B0, 0, 0); PG8_LDB(B1, 0, 1); PG8_SCHED; PG8_LDA(At, 0, 0); PG8_STAGE_A(PG8_SA(1, 1), kb1, vAc[1]); \
            PG8_WAIT_V(8); PG8_WAIT_L(0); PG8_BAR; PG8_MMA(0, 0, At, B0); PG8_MMA(0, 1, At, B1); PG8_BAR; PG8_SCHED; \
            PG8_LDA(At, 0, 1); PG8_STAGE_B(PG8_SB(0, 0), B2, kb2); PG8_STAGE_B(PG8_SB(0, 1), (B2) + hstepB, kb2); PG8_STAGE_A(PG8_SA(0, 0), kb2, VA2[0]); \
            PG8_WAIT_V(8); PG8_WAIT_L(0); PG8_BAR; PG8_MMA(1, 0, At, B0); PG8_MMA(1, 1, At, B1); PG8_BAR; PG8_SCHED; \
            PG8_LDB(B0, 1, 0); PG8_LDB(B1, 1, 1); PG8_SCHED; PG8_LDA(At, 1, 0); PG8_STAGE_A(PG8_SA(0, 1), kb2, VA2[1]); \
            PG8_WAIT_V(8); PG8_WAIT_L(0); PG8_BAR; PG8_MMA(0, 0, At, B0); PG8_MMA(0, 1, At, B1); PG8_BAR; PG8_SCHED; \
            PG8_LDA(At, 1, 1); PG8_STAGE_B(PG8_SB(1, 0), B2, kb3); PG8_STAGE_B(PG8_SB(1, 1), (B2) + hstepB, kb3); PG8_STAGE_A(PG8_SA(1, 0), kb3, VA2[0]); \
            PG8_WAIT_V(8); PG8_WAIT_L(0); PG8_BAR; PG8_MMA(1, 0, At, B0); PG8_MMA(1, 1, At, B1); PG8_BAR; PG8_SCHED; } } while (0)
    for (;;) {
        for (int t = 0; t < nt - 2; t += 2) { const unsigned kb1 = (unsigned)(t + 1) * 128u; PG8_KTRIP(kb1, kb1 + 128u, kb1 + 256u, vAc, cB); }
        const bool has_next = S.next(ui + 1, nxt);
        unsigned vAn[2][2]; unsigned nB = cB;
#pragma unroll
        for (int h = 0; h < 2; ++h)
#pragma unroll
            for (int i = 0; i < 2; ++i) vAn[h][i] = vAc[h][i];
        if (has_next) { nB = S.bbase(nxt); PG8_SETVA(vAn, nxt, ui + 1); }
        { const unsigned kb1 = (unsigned)(nt - 1) * 128u; PG8_KTRIP(kb1, 0u, 128u, vAn, nB); }
        if constexpr (ALIGN_EPI) { if (wr == 0) PG8_BAR; }
        if constexpr (BF != 0) { int t_ = tid; asm volatile("" : "+v"(t_)); E(acc, cur, ui, wr, wc, t_ & 15, (t_ & 63) >> 4); }
        else E(acc, cur, ui, wr, wc, fr, fq);
        if (!has_next) break;
#pragma unroll
        for (int a = 0; a < 2; ++a)
#pragma unroll
            for (int b = 0; b < 2; ++b)
#pragma unroll
                for (int m = 0; m < 4; ++m)
#pragma unroll
                    for (int n = 0; n < 2; ++n) acc[a][b][m][n] = (f32x4){0.f, 0.f, 0.f, 0.f};
        cur = nxt; cB = nB; ++ui;
#pragma unroll
        for (int h = 0; h < 2; ++h)
#pragma unroll
            for (int i = 0; i < 2; ++i) vAc[h][i] = vAn[h][i];
        if constexpr (ALIGN_EPI) { if (wr == 1) PG8_BAR; }
    }
    PG8_WAIT_V(0);
    if constexpr (!ALIGN_EPI) { if (wr == 0) PG8_BAR; }
    PG8_BAR;
#undef PG8_KTRIP
#undef PG8_LDBF
#undef PG8_WRB
#undef PG8_LDBT
#undef PG8_TR
#undef PG8_TIEB
#undef PG8_ROWD
#undef PG8_LDBTH
#undef PG8_TIEH
#undef PG8_MMAH
#undef PG8_MMA2
#undef PG8_SETVA
#undef PG8_SA
#undef PG8_SB
#undef PG8_STAGE_A
#undef PG8_STAGE_B
#undef PG8_LDA
#undef PG8_LDB
#undef PG8_MMA
#undef PG8_WAIT_V
#undef PG8_WAIT_L
#undef PG8_BAR
#undef PG8_SCHED
}

struct DenseSched {
    int K; const char* A; const char* Bt; int nM, nN, nwg, G, c; static constexpr const float* Bf0 = nullptr; static constexpr const float* Bf1 = nullptr;
    DI void init(const void* A_, const void* Bt_, int M, int N, int K_, int G_, int c_) { A = (const char*)A_; Bt = (const char*)Bt_; K = K_; nM = M / BM; nN = N / BM; nwg = nM * nN; G = G_; c = c_; }
    DI bool next(int i, Unit& u) const {
        const long L = (long)i * G + c; if (L >= nwg) return false;
        int wgid = (int)L; { const int q = nwg / NXCD, r = nwg % NXCD, xcd = wgid % NXCD, off = wgid / NXCD; wgid = (xcd < r ? xcd * (q + 1) : r * (q + 1) + (xcd - r) * q) + off; }
        const int nig = WGM * nN, gid = wgid / nig, fm = gid * WGM, gsz = (nM - fm) < WGM ? (nM - fm) : WGM;
        u.pm = fm + ((wgid % nig) % gsz); u.pn = (wgid % nig) / gsz; u.e = 0; u.aux = 0; return true;
    }
    DI unsigned arow(const Unit& u, int, int r) const { return (unsigned)(u.pm * BM + r); }
    DI unsigned bbase(const Unit& u) const { return (unsigned)u.pn * (unsigned)(BM * 2) * (unsigned)K; }
};
struct MoeSched {
    int K; const char* A; const char* Bt; const float* Bf0; const float* Bf1; unsigned bstride_e, bstride_pn; int npn, G, c; const LAS int* tile_e; const LAS int* tile_l; const LAS unsigned* rowtab; bool gather;
    int rt0, rt_end, rmax;
    int lin, L0, Lend, cl, Gl;
    DI bool unit_of(int i, int& rt, int& pn) const {
        if (i >= rmax) return false;
        if (lin) { if (cl < 0) return false; const int L = L0 + i * Gl + cl; rt = L / npn; pn = L - rt * npn; return L < Lend; }
        if (G % (8 * npn) == 0) { const int x = c & 7, j = c >> 3, per = G / (8 * npn); pn = j % npn; rt = rt0 + i * (G / npn) + per * x + j / npn; return rt < rt_end; }
        const int L = i * G + c; rt = rt0 + L / npn; pn = L % npn; return rt < rt_end;
    }
    DI bool next(int i, Unit& u) const {
        int rt, pn; if (!unit_of(i, rt, pn)) return false;
        u.pm = rt; u.pn = pn; u.e = __builtin_amdgcn_readfirstlane(tile_e[rt]); u.aux = __builtin_amdgcn_readfirstlane(tile_l[rt]); return true;
    }
    DI unsigned arow(const Unit& u, int ui, int r) const { return gather ? rowtab[ui * 256 + r] : (unsigned)(u.pm * BM + r); }
    DI unsigned bbase(const Unit& u) const { return (unsigned)u.e * bstride_e + (unsigned)u.pn * bstride_pn; }
};

struct EpiProj {
    static constexpr bool PERM = true;
    bf16* O; int ldc;
    DI void operator()(const f32x4 (&acc)[2][2][4][2], const Unit& u, int, int wr, int wc, int fr, int fq) const {
        const int row0 = u.pm * BM + wr * 64 + fr, col0 = u.pn * BM + wc * 32 + 8 * fq;
#pragma unroll
        for (int ai = 0; ai < 2; ++ai)
#pragma unroll
            for (int m = 0; m < 4; ++m) { bf16* rowp = O + (size_t)(row0 + ai * HALF + m * 16) * ldc + col0;
#pragma unroll
                for (int bj = 0; bj < 2; ++bj) { const f32x4 v0 = acc[ai][bj][m][0], v1 = acc[ai][bj][m][1];
                    u32x4 w; w.x = pk2(v0[0], v0[1]); w.y = pk2(v0[2], v0[3]); w.z = pk2(v1[0], v1[1]); w.w = pk2(v1[2], v1[3]);
                    *(u32x4*)(rowp + bj * HALF) = w; } }
    }
};
struct EpiDelta {
    static constexpr bool PERM = true;
    bf16* O; const float* g;
    DI void operator()(const f32x4 (&acc)[2][2][4][2], const Unit& u, int, int wr, int wc, int fr, int fq) const {
        const int row0 = u.pm * BM + wr * 64 + fr, col0 = u.pn * BM + wc * 32 + 8 * fq;
        const float* gb = g + (size_t)(u.pm >> 3) * (6 * D) + col0;
        f32x4 gv[2][2];
#pragma unroll
        for (int bj = 0; bj < 2; ++bj)
#pragma unroll
            for (int n = 0; n < 2; ++n) gv[bj][n] = *(const f32x4*)(gb + bj * HALF + 4 * n);
#pragma unroll
        for (int ai = 0; ai < 2; ++ai)
#pragma unroll
            for (int m = 0; m < 4; ++m) { bf16* rowp = O + (size_t)(row0 + ai * HALF + m * 16) * D + col0;
#pragma unroll
                for (int bj = 0; bj < 2; ++bj) { const f32x4 v0 = acc[ai][bj][m][0] * gv[bj][0], v1 = acc[ai][bj][m][1] * gv[bj][1];
                    u32x4 w; w.x = pk2(v0[0], v0[1]); w.y = pk2(v0[2], v0[3]); w.z = pk2(v1[0], v1[1]); w.w = pk2(v1[2], v1[3]);
                    *(u32x4*)(rowp + bj * HALF) = w; } }
    }
};
struct EpiSwiglu {
    static constexpr bool PERM = true;
    bf16* O;
    DI void operator()(const f32x4 (&acc)[2][2][4][2], const Unit& u, int, int wr, int wc, int fr, int fq) const {
        const int row0 = u.pm * BM + wr * 64 + fr, col0 = u.pn * HALF + wc * 32 + 8 * fq;
#pragma unroll
        for (int ai = 0; ai < 2; ++ai)
#pragma unroll
            for (int m = 0; m < 4; ++m) { bf16* rowp = O + (size_t)(row0 + ai * HALF + m * 16) * DE + col0;
                float hv[8];
#pragma unroll
                for (int n = 0; n < 2; ++n)
#pragma unroll
                    for (int j = 0; j < 4; ++j) { const float a = acc[ai][0][m][n][j], b = acc[ai][1][m][n][j]; hv[4 * n + j] = fsilu(a) * b; }
                u32x4 w; w.x = pk2(hv[0], hv[1]); w.y = pk2(hv[2], hv[3]); w.z = pk2(hv[4], hv[5]); w.w = pk2(hv[6], hv[7]);
                *(u32x4*)rowp = w; }
    }
};
struct EpiY2 {
    static constexpr bool PERM = true;
    bf16* Y; const LAS int* rowtab;
    DI void operator()(const f32x4 (&acc)[2][2][4][2], const Unit& u, int ui, int wr, int wc, int fr, int fq) const {
        const int col0 = u.pn * BM + wc * 32 + 8 * fq;
#pragma unroll
        for (int ai = 0; ai < 2; ++ai)
#pragma unroll
            for (int m = 0; m < 4; ++m) { const int r = ai * HALF + wr * 64 + m * 16 + fr; const int a = rowtab[(ui * 256 + r) * 2]; const float wgt = __int_as_float(rowtab[(ui * 256 + r) * 2 + 1]);
                if (a >= 0) { bf16* rowp = Y + (size_t)a * D + col0;
#pragma unroll
                    for (int bj = 0; bj < 2; ++bj) { const f32x4 v0 = acc[ai][bj][m][0] * wgt, v1 = acc[ai][bj][m][1] * wgt;
                        u32x4 w; w.x = pk2(v0[0], v0[1]); w.y = pk2(v0[2], v0[3]); w.z = pk2(v1[0], v1[1]); w.w = pk2(v1[2], v1[3]);
                        *(u32x4*)(rowp + bj * HALF) = w; } } }
    }
};
}

struct Args { const float* in[32]; float* out; unsigned char* ws; int ph_lo, ph_hi, li, qset; };
struct Frame {
    LAS unsigned char* lds; volatile LAS unsigned* MISC; unsigned* ctl;
    int tid, lane, wave, G, vcu, qset, skip;
    const float* const* in; float* out; unsigned char* ws;
};
enum { I_X = 0, I_C, I_ADAW, I_ADAB, I_N1G, I_WIN, I_GWA2, I_GBA, I_GNG, I_LCW, I_LCB, I_LWA, I_LBA, I_LWX, I_LBX, I_LLAM, I_DLQ1, I_DLK1, I_DLQ2, I_DLK2, I_DSUB, I_RELB, I_WOUT, I_N2G,
       I_RGW, I_RGB, I_REW, I_REB, I_W1, I_W3, I_W2, I_FING };


constexpr int par_size(int id) {
    return id == I_N1G ? 4096 : id == I_GWA2 ? 12288 : id == I_GBA ? 768 : id == I_GNG ? 1536 : id == I_LCW ? 4096 : id == I_LCB ? 1024 : id == I_LWA ? 65536 : id == I_LBA ? 1024 : id == I_LWX ? 65536 :
           id == I_LBX ? 1024 : id == I_LLAM ? 1024 : (id >= I_DLQ1 && id <= I_DLK2) ? 128 : id == I_DSUB ? 256 : id == I_RELB ? 192 : id == I_N2G ? 4096 : id == I_RGB ? 16 : id == I_REB ? 128 : id == I_FING ? 2048 : 0;
}
constexpr int par_off(int id) { int o = 0; for (int i = 0; i < id; ++i) o += par_size(i); return o; }
constexpr int PAR_TOTAL = par_off(32);
#define PARP(id) ((const float*)(F.ws + WS_PAR) + par_off(id))
struct CvItem { const float* src; bf16* dst; unsigned ldsrc, lddst; int nvalid; };
DI void cv_load(const CvItem& ci, f32x4 (&v)[8], int lane) {
    const int kq = lane >> 3, c = lane & 7;
    if (4 * c < ci.nvalid) {
#pragma unroll
        for (int i = 0; i < 8; ++i) v[i] = __builtin_nontemporal_load((const f32x4*)(ci.src + (size_t)(8 * kq + i) * ci.ldsrc + 4 * c));
    } else {
#pragma unroll
        for (int i = 0; i < 8; ++i) v[i] = (f32x4){0.f, 0.f, 0.f, 0.f};
    }
}
DI void cv_store(const CvItem& ci, const f32x4 (&v)[8], int lane) {
    const int kq = lane >> 3, c = lane & 7;
#pragma unroll
    for (int q = 0; q < 4; ++q) { u32x4 o; o.x = pk2(v[0][q], v[1][q]); o.y = pk2(v[2][q], v[3][q]); o.z = pk2(v[4][q], v[5][q]); o.w = pk2(v[6][q], v[7][q]);
        __builtin_nontemporal_store(o, (u32x4*)(ci.dst + (size_t)(4 * c + q) * ci.lddst + 8 * kq)); }
}
DI CvItem moe_item(Frame& F, int l, int r) {
    CvItem c; c.nvalid = 32;
    if (r < 65536) {
        const int e = r / 1024, r2 = r % 1024, kb = r2 / 32, nb = r2 % 32, n0 = nb * 32, jt = n0 >> 8, rr = n0 & 255;
        const float* W = (rr < 128) ? F.in[I_W1] : F.in[I_W3];
        c.src = W + ((size_t)(l * NE + e) * D + kb * 64) * DE + jt * 128 + (rr & 127); c.ldsrc = DE;
        c.dst = (bf16*)(F.ws + WS_W13) + ((size_t)(l * NE + e) * 1024 + n0) * D + kb * 64; c.lddst = D;
    } else {
        r -= 65536; const int e = r / 512, r2 = r % 512, kb = r2 / 64, nb = r2 % 64;
        c.src = F.in[I_W2] + ((size_t)(l * NE + e) * DE + kb * 64) * D + nb * 32; c.ldsrc = D;
        c.dst = (bf16*)(F.ws + WS_W2) + ((size_t)(l * NE + e) * D + nb * 32) * DE + kb * 64; c.lddst = DE;
    }
    return c;
}
DI void moe_convert_wg(Frame& F, int l, int it) {
    const int r0 = it * 64 + F.wave, lane = F.lane;
    f32x4 va[8], vb[8], vc[8];
#define CV_L(buf, j) cv_load(moe_item(F, l, r0 + 8 * (j)), buf, lane)
#define CV_S(buf, j) cv_store(moe_item(F, l, r0 + 8 * (j)), buf, lane)
    CV_L(va, 0); CV_L(vb, 1); CV_L(vc, 2);
    CV_S(va, 0); CV_L(va, 3);
    CV_S(vb, 1); CV_L(vb, 4);
    CV_S(vc, 2); CV_L(vc, 5);
    CV_S(va, 3); CV_L(va, 6);
    CV_S(vb, 4); CV_L(vb, 7);
    CV_S(vc, 5); CV_S(va, 6); CV_S(vb, 7);
#undef CV_L
#undef CV_S
}
DI void p0_prologue(Frame& F) {
    const int tid = F.tid;
    {
        LAS float* SC = (LAS float*)F.lds;
        LAS float* RED = (LAS float*)(F.lds + 65536);
        const float* cin = F.in[I_C];
        for (int idx = tid; idx < NB * D; idx += 512) { const float c = cin[idx]; SC[idx] = fsilu(c); }
        __syncthreads();
        for (int tile = blockIdx.x; tile < 256; tile += F.G) {
            const int l = tile >> 7, col0 = (tile & 127) * 96;
            const int cg = tid % 24, rs = tid / 24;
            f32x4 acc[NB];
#pragma unroll
            for (int b = 0; b < NB; ++b) acc[b] = (f32x4){0.f, 0.f, 0.f, 0.f};
            if (tid < 504) {
                const float* wp = F.in[I_ADAW] + (size_t)l * D * (6 * D) + col0 + 4 * cg;
#pragma unroll 4
                for (int k = rs; k < D; k += 21) { const f32x4 w = __builtin_nontemporal_load((const f32x4*)(wp + (size_t)k * (6 * D)));
#pragma unroll
                    for (int b = 0; b < NB; ++b) acc[b] += SC[b * D + k] * w; }
#pragma unroll
                for (int b = 0; b < NB; ++b) *(LAS f32x4*)(RED + (rs * NB + b) * 96 + cg * 4) = acc[b];
            }
            __syncthreads();
            for (int idx = tid; idx < NB * 96; idx += 512) { const int b = idx / 96, cc = idx % 96; float s = F.in[I_ADAB][(size_t)l * 6 * D + col0 + cc];
                for (int r = 0; r < 21; ++r) s += RED[(r * NB + b) * 96 + cc];
                ((float*)(F.ws + WS_MOD))[(size_t)(l * NB + b) * (6 * D) + col0 + cc] = s; }
            __syncthreads();
        }
    }
    {
        const int gt = F.vcu * 512 + tid, NT_ = F.G * 512;
        float* PAR = (float*)(F.ws + WS_PAR);
#define PAR_COPY(id) for (int idx = gt; idx < par_size(id); idx += NT_) PAR[par_off(id) + idx] = F.in[id][idx];
        PAR_COPY(I_N1G) PAR_COPY(I_GWA2) PAR_COPY(I_GBA) PAR_COPY(I_GNG) PAR_COPY(I_LCW) PAR_COPY(I_LCB) PAR_COPY(I_LWA) PAR_COPY(I_LBA) PAR_COPY(I_LWX) PAR_COPY(I_LBX) PAR_COPY(I_LLAM)
        PAR_COPY(I_DLQ1) PAR_COPY(I_DLK1) PAR_COPY(I_DLQ2) PAR_COPY(I_DLK2) PAR_COPY(I_DSUB) PAR_COPY(I_RELB) PAR_COPY(I_N2G) PAR_COPY(I_RGB) PAR_COPY(I_REB) PAR_COPY(I_FING)
#undef PAR_COPY
    }
    {
        const int gt = F.vcu * 512 + tid, NT_ = F.G * 512;
        bf16* WR = (bf16*)(F.ws + WS_WR);
        for (int idx = gt; idx < NL * 80 * D; idx += NT_) { const int l = idx / (80 * D), rem = idx % (80 * D), n = rem / D, k = rem % D;
            float w = 0.f; if (n < 8) w = F.in[I_RGW][((size_t)l * D + k) * 8 + n]; else if (n < 72) w = F.in[I_REW][((size_t)l * D + k) * 64 + (n - 8)];
            const unsigned hi = pk2(w, 0.f) & 0xffffu; const float rem_ = w - bflo(hi); const unsigned lo = pk2(rem_, 0.f) & 0xffffu;
            WR[((size_t)(l * 2 + 0) * 80 + n) * D + k] = (bf16)hi; WR[((size_t)(l * 2 + 1) * 80 + n) * D + k] = (bf16)lo; }
    }
    {
        const int gw = F.vcu * 8 + F.wave, NGW = F.G * 8, lane = F.lane;
        constexpr int I_A = 32 * 184, I_B = 32 * 64, I_L = I_A + I_B;
        for (int it = gw; it < NL * I_L; it += NGW) {
            const int l = it / I_L; int r = it % I_L; CvItem ci;
            if (r < I_A) {
                const int kb = r / 184, nb = r % 184, n0 = nb * 32; int src0, nv;
                if (n0 < 2304) { src0 = n0; nv = 32; } else if (n0 < 5632) { src0 = n0 + 16; nv = 32; } else if (n0 == 5632) { src0 = 2304; nv = 16; } else { src0 = 0; nv = 0; }
                ci.src = F.in[I_WIN] + ((size_t)l * D + kb * 64) * INW + src0; ci.ldsrc = INW; ci.nvalid = nv; ci.dst = (bf16*)(F.ws + WS_WIN) + ((size_t)l * PLD + n0) * D + kb * 64; ci.lddst = D;
            } else {
                r -= I_A; const int kb = r / 64, nb = r % 64;
                ci.src = F.in[I_WOUT] + ((size_t)l * D + kb * 64) * D + nb * 32; ci.ldsrc = D; ci.nvalid = 32; ci.dst = (bf16*)(F.ws + WS_WOUT) + ((size_t)l * D + nb * 32) * D + kb * 64; ci.lddst = D;
            }
            f32x4 v[8]; cv_load(ci, v, lane); cv_store(ci, v, lane);
        }
    }
}

template <int MODE>
DI void p_norm(Frame& F) {
    const int gw = F.vcu * 8 + F.wave, NGW = F.G * 8, lane = F.lane;
    const float* MOD = (const float*)(F.ws + WS_MOD);
    float* H = (float*)(F.ws + WS_H);
    bf16* U = (bf16*)(F.ws + WS_U);
    const bf16* Y2 = (const bf16*)(F.ws + WS_Y2);
    constexpr int L = (MODE == 1) ? 1 : 0;
    constexpr int LP = (MODE == 1) ? 0 : 1;
    if (MODE != 2) {
        const bf16* WRH = (const bf16*)(F.ws + WS_WR) + (size_t)(L * 2 + 0) * 80 * D; const bf16* WRL = (const bf16*)(F.ws + WS_WR) + (size_t)(L * 2 + 1) * 80 * D;
        for (int o = gw; o < NB * 72; o += NGW) { const int b = o / 72, n = o % 72; const float* sh = MOD + (size_t)(L * NB + b) * 6 * D + 3 * D; float a = 0.f;
#pragma unroll
            for (int j = 0; j < 4; ++j) { const int k = 8 * lane + 512 * j; const u32x4 wh = *(const u32x4*)(WRH + (size_t)n * D + k), wl = *(const u32x4*)(WRL + (size_t)n * D + k);
                const f32x4 s0 = *(const f32x4*)(sh + k), s1 = *(const f32x4*)(sh + k + 4);
                a += s0[0] * (bflo(wh.x) + bflo(wl.x)) + s0[1] * (bfhi(wh.x) + bfhi(wl.x)) + s0[2] * (bflo(wh.y) + bflo(wl.y)) + s0[3] * (bfhi(wh.y) + bfhi(wl.y))
                   + s1[0] * (bflo(wh.z) + bflo(wl.z)) + s1[1] * (bfhi(wh.z) + bfhi(wl.z)) + s1[2] * (bflo(wh.w) + bflo(wl.w)) + s1[3] * (bfhi(wh.w) + bfhi(wl.w)); }
            a = wave_sum(a);
            if (lane == 0) ((float*)(F.ws + WS_CB))[(L * NB + b) * 80 + n] = a + ((n < 8) ? PARP(I_RGB)[L * 8 + n] : PARP(I_REB)[L * 64 + n - 8]); }
    }
    for (int row0 = gw * 8; row0 < T; row0 += NGW * 8) {
        const int b = row0 / SEQ;
        f32x4 gs[8], sh[8], g2[8];
#pragma unroll
        for (int j = 0; j < 8; ++j) { const int idx = 4 * lane + 256 * j;
            if (MODE == 2) { gs[j] = *(const f32x4*)(PARP(I_FING) + idx); sh[j] = (f32x4){0.f, 0.f, 0.f, 0.f}; }
            else { const f32x4 g = *(const f32x4*)(PARP(I_N1G) + (size_t)L * D + idx), sc = *(const f32x4*)(MOD + (size_t)(L * NB + b) * 6 * D + D + idx);
                gs[j] = g * (sc + 1.0f); sh[j] = *(const f32x4*)(MOD + (size_t)(L * NB + b) * 6 * D + idx); }
            if (MODE != 0) g2[j] = *(const f32x4*)(MOD + (size_t)(LP * NB + b) * 6 * D + 5 * D + idx); }
        for (int rr = 0; rr < 8; ++rr) {
            const int r = row0 + rr;
            f32x4 x[8]; float ss = 0.f;
#pragma unroll
            for (int j = 0; j < 8; ++j) { const int idx = 4 * lane + 256 * j;
                if (MODE == 0) x[j] = __builtin_nontemporal_load((const f32x4*)(F.in[I_X] + (size_t)r * D + idx));
                else { x[j] = *(const f32x4*)(H + (size_t)r * D + idx);
                    const u32x2 y0 = __builtin_nontemporal_load((const u32x2*)(Y2 + (size_t)(2 * r) * D + idx)), y1 = __builtin_nontemporal_load((const u32x2*)(Y2 + (size_t)(2 * r + 1) * D + idx));
                    f32x4 y; y[0] = bflo(y0.x) + bflo(y1.x); y[1] = bfhi(y0.x) + bfhi(y1.x); y[2] = bflo(y0.y) + bflo(y1.y); y[3] = bfhi(y0.y) + bfhi(y1.y);
                    x[j] += g2[j] * y; }
                ss += (x[j][0] * x[j][0] + x[j][1] * x[j][1]) + (x[j][2] * x[j][2] + x[j][3] * x[j][3]); }
            const float rs = __builtin_amdgcn_rsqf(wave_sum(ss) * (1.0f / D) + EPS);
#pragma unroll
            for (int j = 0; j < 8; ++j) { const int idx = 4 * lane + 256 * j;
                if (MODE == 2) { __builtin_nontemporal_store(x[j] * rs * gs[j], (f32x4*)(F.out + (size_t)r * D + idx)); }
                else { if (MODE != 0) *(f32x4*)(H + (size_t)r * D + idx) = x[j];
                    const f32x4 u = x[j] * rs * gs[j] + sh[j]; u32x2 w; w.x = pk2(u[0], u[1]); w.y = pk2(u[2], u[3]);
                    *(u32x2*)(U + (size_t)r * D + idx) = w; } }
        }
    }
}

DI void p_norm2_router(Frame& F, int l) {
    const int tid = F.tid, lane = F.lane, w = F.wave;
    const float* MOD = (const float*)(F.ws + WS_MOD);
    float* H = (float*)(F.ws + WS_H);
    const float* HIN = (l == 0) ? F.in[I_X] : (const float*)(F.ws + WS_H);
    const bf16* DELTA = (const bf16*)(F.ws + WS_DELTA);
    bf16* U = (bf16*)(F.ws + WS_U);
    const bf16* WRH = (const bf16*)(F.ws + WS_WR) + (size_t)(l * 2 + 0) * 80 * D;
    const bf16* WRL = (const bf16*)(F.ws + WS_WR) + (size_t)(l * 2 + 1) * 80 * D;
    int* LIST = (int*)(F.ws + WS_LIST);
    float* WT = (float*)(F.ws + WS_WT);
    unsigned* CNT = F.ctl + CW_CNT + 64 * l + 128 * F.qset;
    LAS float* PART = (LAS float*)F.lds;
    LAS float* SSQ = (LAS float*)(F.lds + 81920);
    LAS float* CBP = (LAS float*)(F.lds + 83968);
    LAS float* CB = (LAS float*)(F.lds + 102400);
    LAS float* LG = (LAS float*)(F.lds + 102912);
    LAS float* RS = (LAS float*)(F.lds + 121344);
    LAS unsigned* HIST = (LAS unsigned*)(F.lds + 121600);
    LAS unsigned* BASE = (LAS unsigned*)(F.lds + 121856);
    const float* G2 = PARP(I_N2G) + (size_t)l * D;
    for (int step = blockIdx.x; step < T / 64; step += F.G) {
        const int row0 = step * 64, b = row0 / SEQ;
        const float* SC = MOD + (size_t)(l * NB + b) * 6 * D + 4 * D;
        const float* SH = MOD + (size_t)(l * NB + b) * 6 * D + 3 * D;
        if (tid < 64) HIST[tid] = 0u;
        if (tid < 72) CB[tid] = ((const float*)(F.ws + WS_CB))[(l * NB + b) * 80 + tid];
        { const int r = lane & 15, kg = lane >> 4;
          f32x4 acc[4][5]; float ssq[4] = {0.f, 0.f, 0.f, 0.f};
#pragma unroll
          for (int rb = 0; rb < 4; ++rb)
#pragma unroll
              for (int nb = 0; nb < 5; ++nb) acc[rb][nb] = (f32x4){0.f, 0.f, 0.f, 0.f};
          const size_t ho0 = (size_t)(row0 + r) * D + 256 * w + 8 * kg;
#pragma unroll 1
          for (int kk = 0; kk < 8; ++kk) {
              const int k = 256 * w + 32 * kk + 8 * kg;
              f32x4 gs0, gs1;
              { const f32x4 g0 = *(const f32x4*)(G2 + k), g1 = *(const f32x4*)(G2 + k + 4), c0 = *(const f32x4*)(SC + k), c1 = *(const f32x4*)(SC + k + 4); gs0 = g0 * (c0 + 1.0f); gs1 = g1 * (c1 + 1.0f); }
              bf16x8 bh[5], bl[5];
#pragma unroll
              for (int nb = 0; nb < 5; ++nb) { bh[nb] = *(const bf16x8*)(WRH + (size_t)(nb * 16 + r) * D + k); bl[nb] = *(const bf16x8*)(WRL + (size_t)(nb * 16 + r) * D + k); }
#pragma unroll
              for (int rb = 0; rb < 4; ++rb) {
                  const size_t ho = ho0 + (size_t)(16 * rb) * D + 32 * kk; const u32x4 dl = *(const u32x4*)(DELTA + ho);
                  f32x4 x0 = *(const f32x4*)(HIN + ho), x1 = *(const f32x4*)(HIN + ho + 4);
                  x0[0] += bflo(dl.x); x0[1] += bfhi(dl.x); x0[2] += bflo(dl.y); x0[3] += bfhi(dl.y); x1[0] += bflo(dl.z); x1[1] += bfhi(dl.z); x1[2] += bflo(dl.w); x1[3] += bfhi(dl.w);
                  *(f32x4*)(H + ho) = x0; *(f32x4*)(H + ho + 4) = x1;
                  ssq[rb] += (x0[0] * x0[0] + x0[1] * x0[1]) + (x0[2] * x0[2] + x0[3] * x0[3]) + (x1[0] * x1[0] + x1[1] * x1[1]) + (x1[2] * x1[2] + x1[3] * x1[3]);
                  const f32x4 v0 = x0 * gs0, v1 = x1 * gs1;
                  u32x4 hi, lo;
                  hi.x = pk2(v0[0], v0[1]); hi.y = pk2(v0[2], v0[3]); hi.z = pk2(v1[0], v1[1]); hi.w = pk2(v1[2], v1[3]);
                  lo.x = pk2(v0[0] - bflo(hi.x), v0[1] - bfhi(hi.x)); lo.y = pk2(v0[2] - bflo(hi.y), v0[3] - bfhi(hi.y)); lo.z = pk2(v1[0] - bflo(hi.z), v1[1] - bfhi(hi.z)); lo.w = pk2(v1[2] - bflo(hi.w), v1[3] - bfhi(hi.w));
                  const bf16x8 ah = __builtin_bit_cast(bf16x8, hi), al = __builtin_bit_cast(bf16x8, lo);
#pragma unroll
                  for (int nb = 0; nb < 5; ++nb) {
                      acc[rb][nb] = __builtin_amdgcn_mfma_f32_16x16x32_bf16(ah, bh[nb], acc[rb][nb], 0, 0, 0);
                      acc[rb][nb] = __builtin_amdgcn_mfma_f32_16x16x32_bf16(ah, bl[nb], acc[rb][nb], 0, 0, 0);
                      acc[rb][nb] = __builtin_amdgcn_mfma_f32_16x16x32_bf16(al, bh[nb], acc[rb][nb], 0, 0, 0); } } }
#pragma unroll
          for (int rb = 0; rb < 4; ++rb) { float s = ssq[rb]; s += __shfl_xor(s, 16); s += __shfl_xor(s, 32); if (kg == 0) SSQ[w * 64 + 16 * rb + r] = s; }
          if (w >= 4) {
#pragma unroll
              for (int rb = 0; rb < 4; ++rb)
#pragma unroll
                  for (int nb = 0; nb < 5; ++nb)
#pragma unroll
                      for (int j = 0; j < 4; ++j) PART[((w - 4) * 64 + 16 * rb + 4 * kg + j) * 80 + nb * 16 + r] = acc[rb][nb][j]; }
          __syncthreads();
          if (w < 4) {
#pragma unroll
              for (int rb = 0; rb < 4; ++rb)
#pragma unroll
                  for (int nb = 0; nb < 5; ++nb)
#pragma unroll
                      for (int j = 0; j < 4; ++j) { const int pi = (w * 64 + 16 * rb + 4 * kg + j) * 80 + nb * 16 + r; PART[pi] += acc[rb][nb][j]; } } }
        __syncthreads();
        for (int idx = tid; idx < 64 * 72; idx += 512) { const int row = idx / 72, n = idx % 72;
            float s = 0.f, ss = 0.f;
#pragma unroll
            for (int q = 0; q < 4; ++q) s += PART[(q * 64 + row) * 80 + n];
#pragma unroll
            for (int q = 0; q < 8; ++q) ss += SSQ[q * 64 + row];
            const float rs = __builtin_amdgcn_rsqf(ss * (1.0f / D) + EPS);
            LG[row * 72 + n] = rs * s + CB[n]; if (n == 0) RS[row] = rs; }
        __syncthreads();
        int e0 = 0, e1 = 0; unsigned rk0 = 0, rk1 = 0; float wt0 = 0.f, wt1 = 0.f;
        if (tid < 64) {
            const LAS float* lg = LG + tid * 72;
            int gi = 0; float gm = lg[0];
#pragma unroll
            for (int j = 1; j < 8; ++j) if (lg[j] > gm) { gm = lg[j]; gi = j; }
            float gsum = 0.f;
#pragma unroll
            for (int j = 0; j < 8; ++j) gsum += __expf(lg[j] - gm);
            const float gw = 1.0f / gsum;
            const LAS float* el = lg + 8 + gi * 8;
            int i0 = 0; float v0 = el[0];
#pragma unroll
            for (int j = 1; j < 8; ++j) if (el[j] > v0) { v0 = el[j]; i0 = j; }
            int i1 = -1; float v1 = -3.0e38f;
#pragma unroll
            for (int j = 0; j < 8; ++j) if (j != i0 && el[j] > v1) { v1 = el[j]; i1 = j; }
            const float ex = __expf(v1 - v0), w0 = 1.0f / (1.0f + ex), w1 = ex * w0;
            e0 = gi * 8 + i0; e1 = gi * 8 + i1; wt0 = gw * w0; wt1 = gw * w1;
            rk0 = __hip_atomic_fetch_add(HIST + e0, 1u, __ATOMIC_RELAXED, __HIP_MEMORY_SCOPE_WORKGROUP); rk1 = __hip_atomic_fetch_add(HIST + e1, 1u, __ATOMIC_RELAXED, __HIP_MEMORY_SCOPE_WORKGROUP);
        }
        __syncthreads();
        if (tid < 64) { int tt = tid; asm volatile("" : "+v"(tt)); const unsigned n = HIST[tt]; BASE[tt] = n ? atomicAdd(CNT + tt, n) : 0u; }
        __syncthreads();
        if (tid < 64) { const int tok = row0 + tid;
            LIST[e0 * 16384 + BASE[e0] + rk0] = tok * 2; LIST[e1 * 16384 + BASE[e1] + rk1] = tok * 2 + 1;
            WT[tok * 2] = wt0; WT[tok * 2 + 1] = wt1; }
        { f32x4 gs[8], sh[8];
#pragma unroll
          for (int j = 0; j < 8; ++j) { const int idx = 4 * lane + 256 * j; gs[j] = *(const f32x4*)(G2 + idx) * (*(const f32x4*)(SC + idx) + 1.0f); sh[j] = *(const f32x4*)(SH + idx); }
          for (int i = 0; i < 8; ++i) { const int rl = 8 * w + i; const float rs = RS[rl];
#pragma unroll
              for (int j = 0; j < 8; ++j) { const int idx = 4 * lane + 256 * j; const f32x4 x = *(const f32x4*)(H + (size_t)(row0 + rl) * D + idx);
                  const f32x4 u = x * rs * gs[j] + sh[j]; u32x2 wv; wv.x = pk2(u[0], u[1]); wv.y = pk2(u[2], u[3]);
                  *(u32x2*)(U + (size_t)(row0 + rl) * D + idx) = wv; } } }
        __syncthreads();
    }
}

DI int moe_tiles(Frame& F, int l) {
    LAS int* TE = (LAS int*)(F.lds + TILETAB_OFF); LAS int* TL = TE + 192; LAS int* CN = TE + 384;
    __syncthreads();
    if (F.tid < 64) CN[F.tid] = (int)__hip_atomic_load(F.ctl + CW_CNT + 64 * l + 128 * F.qset + F.tid, __ATOMIC_RELAXED, __HIP_MEMORY_SCOPE_AGENT);
    __syncthreads();
    if (F.tid == 0) { int nt = 0; for (int e = 0; e < 64; ++e) { const int n = (CN[e] + 255) >> 8; for (int j = 0; j < n && nt < 192; ++j) { TE[nt] = e; TL[nt] = j; ++nt; } } CN[64] = nt; }
    __syncthreads();
    return CN[64];
}


DI unsigned offb(unsigned row, unsigned ch) { return 256u * row + 16u * (ch ^ (((row & 3u) << 2) | ((row >> 2) & 3u))); }
DI int swap23(int r) { return (r & ~12) | ((r & 4) << 1) | ((r & 8) >> 1); }
DI int t5_bucket(int rel) {
    const int ret = rel > 0 ? 16 : 0; const int n = rel < 0 ? -rel : rel;
    if (n < 8) return ret + n;
    const float v = logf((float)n * 0.125f) / 2.7725887f * 8.0f;
    int large = 8 + (int)(v + 1e-5f); if (large > 15) large = 15;
    return ret + large;
}
DI int dequeue(Frame& F, unsigned* q) {
    __syncthreads();
    if (F.tid == 0) F.MISC[2] = atomicAdd(q, 1u);
    __syncthreads();
    return (int)F.MISC[2];
}
DI s16x4 tr_read(const LAS unsigned char* p) { return __builtin_bit_cast(s16x4, __builtin_amdgcn_ds_read_tr16_b64_v4i16((LAS s16x4*)p)); }
DI bf16x8 cat8(s16x4 lo, s16x4 hi) { return __builtin_shufflevector(lo, hi, 0, 1, 2, 3, 4, 5, 6, 7); }
DI bf16x8 pack8(float a0, float a1, float a2, float a3, float a4, float a5, float a6, float a7) { u32x4 p; p.x = pk2(a0, a1); p.y = pk2(a2, a3); p.z = pk2(a4, a5); p.w = pk2(a6, a7); return __builtin_bit_cast(bf16x8, p); }
#define MFMA32(a, b, c) __builtin_amdgcn_mfma_f32_32x32x16_bf16((a), (b), (c), 0, 0, 0)
DI float vmax(float a, float b) { float r; asm("v_max_f32 %0, %1, %2" : "=v"(r) : "v"(a), "v"(b)); return r; }
DI float vmax3(float a, float b, float c) { float r; asm("v_max3_f32 %0, %1, %2, %3" : "=v"(r) : "v"(a), "v"(b), "v"(c)); return r; }

DI void attn_unit(Frame& F, int l, int b, int hh, int qb, float lam, float cfin) {
    int tid = F.tid, lane = F.lane; const int w = F.wave;
    asm volatile("" : "+v"(tid), "+v"(lane));
    const int map = w >> 2, wq = w & 3;
    const bf16* PROJ = (const bf16*)(F.ws + WS_PROJ);
    bf16* MIX = (bf16*)(F.ws + WS_MIX);
    LAS unsigned char* lds = F.lds;
    constexpr int TABOFF = 98304;
    LAS float* TAB2 = (LAS float*)(lds + TABOFF);
    const int tokbase = b * SEQ;
    const int q0 = qb * 128 + wq * 32, cq = q0 >> 6, ntiles = 2 * qb + 2;
    if (tid < 255) TAB2[tid] = PARP(I_RELB)[t5_bucket(tid - 191) * 6 + hh] * LOG2E;
    LAS float* SGL = (LAS float*)(lds + TABOFF + 1024);
    if (tid >= 256 && tid < 384) SGL[tid - 256] = PARP(I_DSUB)[l * 128 + tid - 256];
    const float far2 = PARP(I_RELB)[15 * 6 + hh] * LOG2E;
    const int h_ = lane >> 5, blk = (lane >> 4) & 1, qq = (lane & 15) >> 2, pp = lane & 3;
    bf16x8 Qf[4];
    { const bf16* qp = PROJ + (size_t)(tokbase + q0 + (lane & 31)) * PLD + C_DQ + hh * 128 + map * 64 + 8 * h_;
#pragma unroll
      for (int s = 0; s < 4; ++s) Qf[s] = *(const bf16x8*)(qp + 16 * s); }
    unsigned srcK[2], srcV[2];
#pragma unroll
    for (int pi = 0; pi < 2; ++pi) { const int p = 2 * w + pi, row = 4 * p + (lane >> 4), pc = lane & 15, ch = pc ^ (((row & 3) << 2) | ((row >> 2) & 3));
        srcK[pi] = (unsigned)((tokbase + row) * PLD + C_DK + hh * 128 + 8 * ch);
        srcV[pi] = (unsigned)((tokbase + swap23(row)) * PLD + C_DV + hh * 128 + 8 * ch); }
#define ATT_STAGE(kt) do { const unsigned ko = (unsigned)(kt) * 64u * PLD; const int st_ = ((kt) % 3) * 32768; _Pragma("unroll") for (int pi = 0; pi < 2; ++pi) { \
        __builtin_amdgcn_global_load_lds((const unsigned*)(PROJ + (size_t)(srcK[pi] + ko)), (LAS unsigned*)(lds + st_ + (2 * w + pi) * 1024), 16, 0, 0); \
        __builtin_amdgcn_global_load_lds((const unsigned*)(PROJ + (size_t)(srcV[pi] + ko)), (LAS unsigned*)(lds + st_ + 16384 + (2 * w + pi) * 1024), 16, 0, 0); } } while (0)
    unsigned kad[4], vad[2][4];
#pragma unroll
    for (int s = 0; s < 4; ++s) kad[s] = offb(lane & 31, 8 * map + 2 * s + h_);
#pragma unroll
    for (int t = 0; t < 2; ++t)
#pragma unroll
        for (int c = 0; c < 4; ++c) vad[t][c] = offb(8 * h_ + 4 * t + qq, 4 * c + 2 * blk + (pp >> 1)) + 8 * (pp & 1);
    f32x16 O[4];
#pragma unroll
    for (int c = 0; c < 4; ++c)
#pragma unroll
        for (int r = 0; r < 16; ++r) O[c][r] = 0.f;
    float m = -1.0e30f, lsum = 0.f;
    constexpr float C1 = 0.125f * LOG2E, THR = 8.0f;
    f32x16 S0, S1;
    bf16x8 Pf[4];
#define ATT_QK(kt) do { const LAS unsigned char* Kb = lds + ((kt) % 3) * 32768; \
        const LAS unsigned char* kp[4]; _Pragma("unroll") for (int s4 = 0; s4 < 4; ++s4) { kp[s4] = Kb + kad[s4]; asm volatile("" : "+v"(kp[s4])); } \
        _Pragma("unroll") for (int r = 0; r < 16; ++r) { S0[r] = 0.f; S1[r] = 0.f; } \
        bf16x8 kf[4][2]; _Pragma("unroll") for (int s4 = 0; s4 < 4; ++s4) { kf[s4][0] = *(const LAS bf16x8*)(kp[s4]); kf[s4][1] = *(const LAS bf16x8*)(kp[s4] + 8192); } \
        _Pragma("unroll") for (int s4 = 0; s4 < 4; ++s4) { S0 = MFMA32(kf[s4][0], Qf[s4], S0); S1 = MFMA32(kf[s4][1], Qf[s4], S1); } } while (0)
#define ATT_PV(kt) do { const LAS unsigned char* Vb = lds + ((kt) % 3) * 32768 + 16384; \
        _Pragma("unroll") for (int c2 = 0; c2 < 4; c2 += 2) { bf16x8 vf[2][4]; \
            _Pragma("unroll") for (int cc = 0; cc < 2; ++cc) { const LAS unsigned char* vp0 = Vb + vad[0][c2 + cc]; const LAS unsigned char* vp1 = Vb + vad[1][c2 + cc]; asm volatile("" : "+v"(vp0), "+v"(vp1)); \
                _Pragma("unroll") for (int ks = 0; ks < 4; ++ks) vf[cc][ks] = cat8(tr_read(vp0 + 4096 * ks), tr_read(vp1 + 4096 * ks)); } \
            _Pragma("unroll") for (int cc = 0; cc < 2; ++cc) _Pragma("unroll") for (int ks = 0; ks < 4; ++ks) O[c2 + cc] = MFMA32(vf[cc][ks], Pf[ks], O[c2 + cc]); } } while (0)
#define ATT_SM(kt, PN) do { \
        const bool nearT = (kt) >= cq - 2; float mx; \
        if (nearT) { const int idx0 = 64 * (kt) - q0 - (lane & 31) + 4 * h_ + 191; \
            _Pragma("unroll") for (int r = 0; r < 16; ++r) { const int cr = (r & 3) + 8 * (r >> 2); S0[r] = S0[r] * C1 + TAB2[idx0 + cr]; S1[r] = S1[r] * C1 + TAB2[idx0 + 32 + cr]; } } \
        mx = vmax(S0[0], S1[0]); \
        _Pragma("unroll") for (int r = 1; r < 16; ++r) mx = vmax3(mx, S0[r], S1[r]); \
        if (!nearT) mx = mx * C1 + far2; \
        mx = vmax(mx, __shfl_xor(mx, 32)); \
        float alpha = 1.0f; const bool resc = __any(mx > m + THR); \
        if (resc) { const float mn = vmax(m, mx); alpha = __builtin_amdgcn_exp2f(m - mn); m = mn; } \
        float rsum = 0.f; \
        if (nearT) { _Pragma("unroll") for (int r = 0; r < 16; ++r) { S0[r] = __builtin_amdgcn_exp2f(S0[r] - m); S1[r] = __builtin_amdgcn_exp2f(S1[r] - m); rsum += S0[r] + S1[r]; } } \
        else { const float nb = far2 - m; _Pragma("unroll") for (int r = 0; r < 16; ++r) { S0[r] = __builtin_amdgcn_exp2f(__builtin_fmaf(S0[r], C1, nb)); S1[r] = __builtin_amdgcn_exp2f(__builtin_fmaf(S1[r], C1, nb)); rsum += S0[r] + S1[r]; } } \
        PN[0] = pack8(S0[0], S0[1], S0[2], S0[3], S0[4], S0[5], S0[6], S0[7]); PN[1] = pack8(S0[8], S0[9], S0[10], S0[11], S0[12], S0[13], S0[14], S0[15]); \
        PN[2] = pack8(S1[0], S1[1], S1[2], S1[3], S1[4], S1[5], S1[6], S1[7]); PN[3] = pack8(S1[8], S1[9], S1[10], S1[11], S1[12], S1[13], S1[14], S1[15]); \
        lsum = lsum * alpha + rsum; \
        if (resc) { _Pragma("unroll") for (int c = 0; c < 4; ++c) _Pragma("unroll") for (int r = 0; r < 16; ++r) O[c][r] *= alpha; } } while (0)
    ATT_STAGE(0); ATT_STAGE(1);
    asm volatile("s_waitcnt vmcnt(4)" ::: "memory"); LBAR();
    for (int kt = 0; kt < ntiles; ++kt) {
        const bool more = kt + 2 < ntiles;
        if (more) ATT_STAGE(kt + 2);
        if (kt <= cq) { ATT_QK(kt); ATT_SM(kt, Pf); ATT_PV(kt); }
        if (more) asm volatile("s_waitcnt vmcnt(4)" ::: "memory"); else asm volatile("s_waitcnt vmcnt(0)" ::: "memory");
        LBAR();
    }
#undef ATT_STAGE
#undef ATT_QK
#undef ATT_PV
#undef ATT_SM
    const float ltot = lsum + __shfl_xor(lsum, 32), inv = 1.0f / ltot;
    LAS float* COMB = (LAS float*)lds;
    if (map == 1) {
#pragma unroll
        for (int c = 0; c < 4; ++c)
#pragma unroll
            for (int r = 0; r < 16; ++r) COMB[(wq * 64 + c * 16 + r) * 64 + lane] = O[c][r] * inv;
    }
    __syncthreads();
    if (map == 0) {
        float ss = 0.f;
#pragma unroll
        for (int c = 0; c < 4; ++c)
#pragma unroll
            for (int r = 0; r < 16; ++r) { const float o = O[c][r] * inv - lam * COMB[(wq * 64 + c * 16 + r) * 64 + lane]; O[c][r] = o; ss += o * o; }
        ss += __shfl_xor(ss, 32);
        const float rms = cfin * __builtin_amdgcn_rsqf(ss * (1.0f / 128.0f) + EPS);
        bf16* op = MIX + (size_t)(tokbase + q0 + (lane & 31)) * D + 1280 + hh * 128 + 4 * h_;
        const LAS float* sg = SGL + 4 * h_;
#pragma unroll
        for (int c = 0; c < 4; ++c)
#pragma unroll
            for (int g = 0; g < 4; ++g) { const f32x4 gv = *(const LAS f32x4*)(sg + 32 * c + 8 * g);
                u32x2 wv; wv.x = pk2(O[c][4 * g] * rms * gv[0], O[c][4 * g + 1] * rms * gv[1]); wv.y = pk2(O[c][4 * g + 2] * rms * gv[2], O[c][4 * g + 3] * rms * gv[3]);
                *(u32x2*)(op + 32 * c + 8 * g) = wv; }
    }
    __syncthreads();
}

constexpr int GL_G = 0, GL_QN = 16384, GL_KF = 25600, GL_KN = 34816, GL_OP = 0, GL_QF = 44032, GL_KD = 53248, GL_AM = 62464, GL_VV = 71680, GL_SS = 89088, GL_ALR = 106496, GL_DEC = 110592, GL_SEG = 110848, GL_GL = 112896, GL_GNG = 113664, GL_ALRB = 106496, GL_WA2H = 108544, GL_WA2L = 114688, GL_Z = 116736;
DI void gla_unit(Frame& F, int l, int b, int hh) {
    const int tid = F.tid, lane = F.lane, w = F.wave;
    const bf16* PROJ = (const bf16*)(F.ws + WS_PROJ);
    bf16* MIX = (bf16*)(F.ws + WS_MIX);
    LAS unsigned char* lds = F.lds;
    LAS float* G = (LAS float*)(lds + GL_G); LAS float* OP = (LAS float*)(lds + GL_OP); LAS float* ALR = (LAS float*)(lds + GL_ALR);
    LAS float* DEC = (LAS float*)(lds + GL_DEC); LAS float* SEG = (LAS float*)(lds + GL_SEG); LAS float* GLL = (LAS float*)(lds + GL_GL);
    const int tokbase = b * SEQ;
    const int ta = tid >> 3, dg = tid & 7;
    const int cd = tid & 63, seg = tid >> 6;
    const int h_ = lane >> 5, blk = (lane >> 4) & 1, qq = (lane & 15) >> 2, pp = lane & 3;
    for (int i = tid; i < 1024; i += 512) { const int ch = i >> 4, r = i & 15; const float wv = PARP(I_GWA2)[((size_t)l * 16 + r) * 384 + hh * 64 + ch];
        const unsigned hi = pk2(wv, 0.f) & 0xffffu; const float res = wv - __uint_as_float(hi << 16);
        *(LAS bf16*)(lds + GL_WA2H + i * 2) = (bf16)hi; *(LAS bf16*)(lds + GL_WA2L + i * 2) = (bf16)(pk2(res, 0.f) & 0xffffu); }
    LAS float* Zf = (LAS float*)(lds + GL_Z);
    const int t2 = tid - 256;
    const bool a_lane = t2 >= 0 && t2 < 128;
#define GLA_ZSTAGE() do { if (w < 4) { const int tb_ = w >> 1, cb_ = w & 1; f32x16 z_; _Pragma("unroll") for (int r = 0; r < 16; ++r) z_[r] = 0.f; \
        const bf16x8 bA_ = *(const LAS bf16x8*)(lds + GL_ALRB + (32 * tb_ + (lane & 31)) * 32 + 16 * h_); \
        z_ = MFMA32(*(const LAS bf16x8*)(lds + GL_WA2H + (32 * cb_ + (lane & 31)) * 32 + 16 * h_), bA_, z_); \
        z_ = MFMA32(*(const LAS bf16x8*)(lds + GL_WA2L + (32 * cb_ + (lane & 31)) * 32 + 16 * h_), bA_, z_); \
        _Pragma("unroll") for (int g = 0; g < 4; ++g) *(LAS f32x4*)(Zf + (32 * tb_ + (lane & 31)) * 68 + 32 * cb_ + 8 * g + 4 * h_) = (f32x4){z_[4 * g], z_[4 * g + 1], z_[4 * g + 2], z_[4 * g + 3]}; } } while (0)
    LAS float* GNL = (LAS float*)(lds + GL_GNG);
    if (tid < 128) GNL[tid] = PARP(I_GNG)[l * 768 + hh * 128 + tid];
    const float ba = PARP(I_GBA)[l * 384 + hh * 64 + cd];
    f32x16 Sacc;
#pragma unroll
    for (int r = 0; r < 16; ++r) Sacc[r] = 0.f;
    const int sdb = w >> 2, svb = w & 3;
    for (int i = tid; i < 64 * 136 / 2; i += 512) ((LAS unsigned*)(lds + GL_SS))[i] = 0u;
    u32x4 nq, nk, nv0, nv1, nog0, nog1, na;
    {
        const bf16* rp = PROJ + (size_t)(tokbase + ta) * PLD;
        nq = *(const u32x4*)(rp + C_GQ + hh * 64 + 8 * dg); nk = *(const u32x4*)(rp + C_GK + hh * 64 + 8 * dg);
        nv0 = *(const u32x4*)(rp + C_GV + hh * 128 + 16 * dg); nv1 = *(const u32x4*)(rp + C_GV + hh * 128 + 16 * dg + 8);
        nog0 = *(const u32x4*)(rp + C_GOG + hh * 128 + 16 * dg); nog1 = *(const u32x4*)(rp + C_GOG + hh * 128 + 16 * dg + 8);
        na = a_lane ? *(const u32x4*)(PROJ + (size_t)(tokbase + (t2 >> 1)) * PLD + C_GA + 8 * (t2 & 1)) : (u32x4){0u, 0u, 0u, 0u};
    }
#define GLA_ALR_WRITE() do { if (a_lane) *(LAS u32x4*)(lds + GL_ALRB + t2 * 16) = na; } while (0)
    GLA_ALR_WRITE();
    LBAR();
    GLA_ZSTAGE();
    LBAR();
    for (int n = 0; n < 32; ++n) {
        const int tok0 = tokbase + 64 * n;
        const u32x4 cq_ = nq, ck_ = nk, cv0 = nv0, cv1 = nv1;
        float g8[8]; float run = 0.f;
#pragma unroll
        for (int tt = 0; tt < 8; ++tt) { const float x = ba + Zf[(8 * seg + tt) * 68 + cd];
            const float ls = fminf(x, 0.f) - __logf(1.0f + __expf(-fabsf(x)));
            run += ls * (1.0f / 16.0f); g8[tt] = run; }
        SEG[seg * 64 + cd] = run;
        LBAR();
        { float off = 0.f;
#pragma unroll
          for (int s2 = 0; s2 < 8; ++s2) off += (s2 < seg) ? SEG[s2 * 64 + cd] : 0.f;
#pragma unroll
          for (int tt = 0; tt < 8; ++tt) G[(8 * seg + tt) * 64 + cd] = g8[tt] + off;
          if (seg == 7) DEC[cd] = __expf(g8[7] + off); }
        if (n + 1 < 32) { const bf16* rp = PROJ + (size_t)(tok0 + 64 + ta) * PLD;
            nq = *(const u32x4*)(rp + C_GQ + hh * 64 + 8 * dg); nk = *(const u32x4*)(rp + C_GK + hh * 64 + 8 * dg);
            nv0 = *(const u32x4*)(rp + C_GV + hh * 128 + 16 * dg); nv1 = *(const u32x4*)(rp + C_GV + hh * 128 + 16 * dg + 8);
            if (a_lane) na = *(const u32x4*)(PROJ + (size_t)(tok0 + 64 + (t2 >> 1)) * PLD + C_GA + 8 * (t2 & 1)); }
        LBAR();
        {
            const float qv[8] = {bflo(cq_.x), bfhi(cq_.x), bflo(cq_.y), bfhi(cq_.y), bflo(cq_.z), bfhi(cq_.z), bflo(cq_.w), bfhi(cq_.w)};
            const float kv[8] = {bflo(ck_.x), bfhi(ck_.x), bflo(ck_.y), bfhi(ck_.y), bflo(ck_.z), bfhi(ck_.z), bflo(ck_.w), bfhi(ck_.w)};
            float qf[8], qn[8], kf[8], kn[8], kd[8];
#pragma unroll
            for (int j = 0; j < 8; ++j) { const float g = G[ta * 64 + 8 * dg + j]; const float eg = __expf(g), eng = __expf(-g), ed = DEC[8 * dg + j] * eng;
                qf[j] = qv[j] * 0.125f * eg; qn[j] = qv[j] * 0.125f * eng; kf[j] = kv[j] * eg; kn[j] = kv[j] * eng; kd[j] = kv[j] * ed; }
            const int to = ta * 144 + 16 * dg;
            *(LAS bf16x8*)(lds + GL_QF + to) = pack8(qf[0], qf[1], qf[2], qf[3], qf[4], qf[5], qf[6], qf[7]);
            *(LAS bf16x8*)(lds + GL_QN + to) = pack8(qn[0], qn[1], qn[2], qn[3], qn[4], qn[5], qn[6], qn[7]);
            *(LAS bf16x8*)(lds + GL_KF + to) = pack8(kf[0], kf[1], kf[2], kf[3], kf[4], kf[5], kf[6], kf[7]);
            *(LAS bf16x8*)(lds + GL_KN + to) = pack8(kn[0], kn[1], kn[2], kn[3], kn[4], kn[5], kn[6], kn[7]);
            *(LAS bf16x8*)(lds + GL_KD + to) = pack8(kd[0], kd[1], kd[2], kd[3], kd[4], kd[5], kd[6], kd[7]);
            *(LAS u32x4*)(lds + GL_VV + ta * 272 + 32 * dg) = cv0; *(LAS u32x4*)(lds + GL_VV + ta * 272 + 32 * dg + 16) = cv1;
        }
        LBAR();
        if (w < 4) {
            const int ib = w >> 1, jb = w & 1;
            f32x16 cf, cb_;
#pragma unroll
            for (int r = 0; r < 16; ++r) { cf[r] = 0.f; cb_[r] = 0.f; }
            const int ra = (32 * jb + (lane & 31)) * 144 + 16 * h_, rb = (32 * ib + (lane & 31)) * 144 + 16 * h_;
            if (jb <= ib) {
#pragma unroll
                for (int s = 0; s < 4; ++s) cf = MFMA32(*(const LAS bf16x8*)(lds + GL_KN + ra + 32 * s), *(const LAS bf16x8*)(lds + GL_QF + rb + 32 * s), cf); }
            if (jb >= ib) {
#pragma unroll
                for (int s = 0; s < 4; ++s) cb_ = MFMA32(*(const LAS bf16x8*)(lds + GL_KF + ra + 32 * s), *(const LAS bf16x8*)(lds + GL_QN + rb + 32 * s), cb_); }
            const int i_ = 32 * ib + (lane & 31);
#pragma unroll
            for (int g = 0; g < 4; ++g) { float v[4];
#pragma unroll
                for (int j = 0; j < 4; ++j) { const int jj = 32 * jb + 8 * g + 4 * h_ + j; v[j] = (jj <= i_) ? cf[4 * g + j] : cb_[4 * g + j]; }
                u32x2 wv; wv.x = pk2(v[0], v[1]); wv.y = pk2(v[2], v[3]);
                *(LAS u32x2*)(lds + GL_AM + i_ * 144 + (32 * jb + 8 * g + 4 * h_) * 2) = wv; }
        } else { GLA_ALR_WRITE(); }
        LBAR();
        {
            const int ib = w >> 2, vb = w & 3;
            bf16x8 vvf[4];
#pragma unroll
            for (int ks = 0; ks < 4; ++ks) { const LAS unsigned char* p0 = lds + GL_VV + (16 * ks + 8 * h_ + qq) * 272 + (32 * vb + 16 * blk + 4 * pp) * 2; vvf[ks] = cat8(tr_read(p0), tr_read(p0 + 4 * 272)); }
            f32x16 o;
#pragma unroll
            for (int r = 0; r < 16; ++r) o[r] = 0.f;
            const int ra = (32 * ib + (lane & 31)) * 144 + 16 * h_;
#pragma unroll
            for (int ks = 0; ks < 4; ++ks) o = MFMA32(*(const LAS bf16x8*)(lds + GL_AM + ra + 32 * ks), vvf[ks], o);
#pragma unroll
            for (int ks = 0; ks < 4; ++ks) { const LAS unsigned char* p0 = lds + GL_SS + (16 * ks + 8 * h_ + qq) * 272 + (32 * vb + 16 * blk + 4 * pp) * 2;
                o = MFMA32(*(const LAS bf16x8*)(lds + GL_QF + ra + 32 * ks), cat8(tr_read(p0), tr_read(p0 + 4 * 272)), o); }
#pragma unroll
            for (int r = 0; r < 16; ++r) Sacc[r] *= DEC[32 * sdb + (r & 3) + 8 * (r >> 2) + 4 * h_];
#pragma unroll
            for (int ks = 0; ks < 4; ++ks) { const LAS unsigned char* p0 = lds + GL_KD + (16 * ks + 8 * h_ + qq) * 144 + (32 * sdb + 16 * blk + 4 * pp) * 2;
                Sacc = MFMA32(cat8(tr_read(p0), tr_read(p0 + 4 * 144)), vvf[ks], Sacc); }
            GLA_ZSTAGE();
            LBAR();
#pragma unroll
            for (int r = 0; r < 16; ++r) { const int rr = (r & 3) + 8 * (r >> 2) + 4 * h_;
                OP[(32 * ib + rr) * 132 + 32 * vb + (lane & 31)] = o[r];
                *(LAS bf16*)(lds + GL_SS + (32 * sdb + rr) * 272 + (32 * svb + (lane & 31)) * 2) = (bf16)(pk2(Sacc[r], 0.f) & 0xffffu); }
        }
        LBAR();
        {
            f32x4 ov[4]; float ss = 0.f;
#pragma unroll
            for (int j = 0; j < 4; ++j) { ov[j] = *(const LAS f32x4*)(OP + ta * 132 + 16 * dg + 4 * j); ss += (ov[j][0] * ov[j][0] + ov[j][1] * ov[j][1]) + (ov[j][2] * ov[j][2] + ov[j][3] * ov[j][3]); }
            ss += __shfl_xor(ss, 1); ss += __shfl_xor(ss, 2); ss += __shfl_xor(ss, 4);
            const float rms = __builtin_amdgcn_rsqf(ss * (1.0f / 128.0f) + EPS);
            const LAS float* ng = GNL + 16 * dg;
            const unsigned ogw[8] = {nog0.x, nog0.y, nog0.z, nog0.w, nog1.x, nog1.y, nog1.z, nog1.w};
            unsigned ow[8];
#pragma unroll
            for (int j = 0; j < 4; ++j) { const f32x4 gv = *(const LAS f32x4*)(ng + 4 * j);
                const float a0 = ov[j][0] * rms * gv[0] * fsilu(bflo(ogw[2 * j])), a1 = ov[j][1] * rms * gv[1] * fsilu(bfhi(ogw[2 * j]));
                const float a2 = ov[j][2] * rms * gv[2] * fsilu(bflo(ogw[2 * j + 1])), a3 = ov[j][3] * rms * gv[3] * fsilu(bfhi(ogw[2 * j + 1]));
                ow[2 * j] = pk2(a0, a1); ow[2 * j + 1] = pk2(a2, a3); }
            bf16* op = MIX + (size_t)(tok0 + ta) * D + hh * 128 + 16 * dg;
            *(u32x4*)op = (u32x4){ow[0], ow[1], ow[2], ow[3]}; *(u32x4*)(op + 8) = (u32x4){ow[4], ow[5], ow[6], ow[7]};
            if (n + 1 < 32) { const bf16* rp = PROJ + (size_t)(tok0 + 64 + ta) * PLD;
                nog0 = *(const u32x4*)(rp + C_GOG + hh * 128 + 16 * dg); nog1 = *(const u32x4*)(rp + C_GOG + hh * 128 + 16 * dg + 8); }
        }
        LBAR();
    }
}

constexpr int LR_XR = 0, LR_XC = 17408, LR_XCB = 33792, LR_WAB = 43008, LR_WXB = 52224, LR_RI = 61440, LR_SP = 95232, LR_SH = 97280, LR_HC = 99328;
#undef GLA_ALR_WRITE
#undef GLA_ZSTAGE
DI void lru_unit(Frame& F, int l, int b, int nb) {
    const int tid = F.tid, lane = F.lane, w = F.wave;
    const bf16* PROJ = (const bf16*)(F.ws + WS_PROJ);
    bf16* MIX = (bf16*)(F.ws + WS_MIX);
    LAS unsigned char* lds = F.lds;
    LAS float* XR = (LAS float*)(lds + LR_XR); LAS float* XC = (LAS float*)(lds + LR_XC); LAS float* RI = (LAS float*)(lds + LR_RI);
    LAS float* SP = (LAS float*)(lds + LR_SP); LAS float* SH = (LAS float*)(lds + LR_SH); LAS float* HC = (LAS float*)(lds + LR_HC);
    const int tokbase = b * SEQ, ch0 = nb * 64;
    const int ta = tid >> 3, cg = tid & 7;
    const int cc = tid & 63, seg = tid >> 6;
    const int h_ = lane >> 5, blk = (lane >> 4) & 1, qq = (lane & 15) >> 2, pp = lane & 3;
    float cw[4][8], cb[8];
#pragma unroll
    for (int j = 0; j < 8; ++j) { cb[j] = PARP(I_LCB)[l * 512 + ch0 + 8 * cg + j];
#pragma unroll
        for (int i = 0; i < 4; ++i) cw[i][j] = PARP(I_LCW)[((size_t)l * 4 + i) * 512 + ch0 + 8 * cg + j]; }
    const float bac = PARP(I_LBA)[l * 512 + ch0 + cc], bxc = PARP(I_LBX)[l * 512 + ch0 + cc];
    const float lamc = PARP(I_LLAM)[l * 512 + ch0 + cc]; const float c8 = -8.0f * LOG2E * log1pf(__expf(-lamc));
    for (int i = tid; i < 64 * 64; i += 512) { const int d = i >> 6, e = i & 63;
        *(LAS bf16*)(lds + LR_WAB + d * 144 + e * 2) = (bf16)(pk2(PARP(I_LWA)[(((size_t)l * 8 + nb) * 64 + d) * 64 + e], 0.f) & 0xffffu);
        *(LAS bf16*)(lds + LR_WXB + d * 144 + e * 2) = (bf16)(pk2(PARP(I_LWX)[(((size_t)l * 8 + nb) * 64 + d) * 64 + e], 0.f) & 0xffffu); }
    if (tid < 192) XR[tid] = 0.f;
    if (tid < 64) HC[tid] = 0.f;
    u32x4 nx, ny;
    { const bf16* rp = PROJ + (size_t)(tokbase + ta) * PLD; nx = *(const u32x4*)(rp + C_LX + ch0 + 8 * cg); ny = *(const u32x4*)(rp + C_LY + ch0 + 8 * cg); }
    LBAR();
    for (int n = 0; n < 32; ++n) {
        const int tok0 = tokbase + 64 * n, par = n & 1;
        { LAS float* xp = XR + (3 + ta) * 64 + 8 * cg;
          *(LAS f32x4*)xp = (f32x4){bflo(nx.x), bfhi(nx.x), bflo(nx.y), bfhi(nx.y)}; *(LAS f32x4*)(xp + 4) = (f32x4){bflo(nx.z), bfhi(nx.z), bflo(nx.w), bfhi(nx.w)}; }
        if (n + 1 < 32) nx = *(const u32x4*)(PROJ + (size_t)(tok0 + 64 + ta) * PLD + C_LX + ch0 + 8 * cg);
        LBAR();
        { float xc[8];
#pragma unroll
          for (int j = 0; j < 8; ++j) xc[j] = cb[j];
#pragma unroll
          for (int i = 0; i < 4; ++i) { const f32x4 a = *(const LAS f32x4*)(XR + (ta + i) * 64 + 8 * cg), c2 = *(const LAS f32x4*)(XR + (ta + i) * 64 + 8 * cg + 4);
              xc[0] += a[0] * cw[i][0]; xc[1] += a[1] * cw[i][1]; xc[2] += a[2] * cw[i][2]; xc[3] += a[3] * cw[i][3];
              xc[4] += c2[0] * cw[i][4]; xc[5] += c2[1] * cw[i][5]; xc[6] += c2[2] * cw[i][6]; xc[7] += c2[3] * cw[i][7]; }
          *(LAS f32x4*)(XC + ta * 64 + 8 * cg) = (f32x4){xc[0], xc[1], xc[2], xc[3]}; *(LAS f32x4*)(XC + ta * 64 + 8 * cg + 4) = (f32x4){xc[4], xc[5], xc[6], xc[7]};
          *(LAS bf16x8*)(lds + LR_XCB + ta * 144 + 16 * cg) = pack8(xc[0], xc[1], xc[2], xc[3], xc[4], xc[5], xc[6], xc[7]); }
        LBAR();
        if (tid < 192) XR[tid] = XR[64 * 64 + tid];
        { const int mat = w >> 2, tb = (w >> 1) & 1, eb = w & 1;
          const int wo = mat ? LR_WXB : LR_WAB;
          f32x16 c;
#pragma unroll
          for (int r = 0; r < 16; ++r) c[r] = 0.f;
          const int ra = (32 * tb + (lane & 31)) * 144 + 16 * h_;
#pragma unroll
          for (int ks = 0; ks < 4; ++ks) { const LAS unsigned char* p0 = lds + wo + (16 * ks + 8 * h_ + qq) * 144 + (32 * eb + 16 * blk + 4 * pp) * 2;
              c = MFMA32(*(const LAS bf16x8*)(lds + LR_XCB + ra + 32 * ks), cat8(tr_read(p0), tr_read(p0 + 4 * 144)), c); }
#pragma unroll
          for (int r = 0; r < 16; ++r) RI[(mat * 64 + 32 * tb + (r & 3) + 8 * (r >> 2) + 4 * h_) * 66 + 32 * eb + (lane & 31)] = c[r]; }
        LBAR();
        float hloc[8], pcum[8];
        { float Hh = 0.f, P = 1.f;
#pragma unroll
          for (int tt = 0; tt < 8; ++tt) { const int t = 8 * seg + tt;
              const float rg = fsigmoid(RI[t * 66 + cc] + bac), ig = fsigmoid(RI[(64 + t) * 66 + cc] + bxc), xc = XC[t * 64 + cc];
              const float a = __builtin_amdgcn_exp2f(rg * c8), om = fmaxf(1.0f - a * a, 0.0f), bb = __builtin_amdgcn_sqrtf(om) * (ig * xc);
              Hh = a * Hh + bb; P *= a; hloc[tt] = Hh; pcum[tt] = P; }
          SP[seg * 64 + cc] = P; SH[seg * 64 + cc] = Hh; }
        LBAR();
        { float hin = HC[par * 64 + cc]; float sp[7], sh7[7];
#pragma unroll
          for (int s2 = 0; s2 < 7; ++s2) { sp[s2] = SP[s2 * 64 + cc]; sh7[s2] = SH[s2 * 64 + cc]; }
#pragma unroll
          for (int s2 = 0; s2 < 7; ++s2) { const float nh = sp[s2] * hin + sh7[s2]; hin = (s2 < seg) ? nh : hin; }
#pragma unroll
          for (int tt = 0; tt < 8; ++tt) XC[(8 * seg + tt) * 64 + cc] = hloc[tt] + pcum[tt] * hin;
          if (seg == 7) HC[(par ^ 1) * 64 + cc] = hloc[7] + pcum[7] * hin; }
        LBAR();
        { const f32x4 h0 = *(const LAS f32x4*)(XC + ta * 64 + 8 * cg), h1 = *(const LAS f32x4*)(XC + ta * 64 + 8 * cg + 4);
          u32x4 o; o.x = pk2(h0[0] * fgelu_tanh(bflo(ny.x)), h0[1] * fgelu_tanh(bfhi(ny.x))); o.y = pk2(h0[2] * fgelu_tanh(bflo(ny.y)), h0[3] * fgelu_tanh(bfhi(ny.y)));
          o.z = pk2(h1[0] * fgelu_tanh(bflo(ny.z)), h1[1] * fgelu_tanh(bfhi(ny.z))); o.w = pk2(h1[2] * fgelu_tanh(bflo(ny.w)), h1[3] * fgelu_tanh(bfhi(ny.w)));
          *(u32x4*)(MIX + (size_t)(tok0 + ta) * D + 768 + ch0 + 8 * cg) = o;
          if (n + 1 < 32) ny = *(const u32x4*)(PROJ + (size_t)(tok0 + 64 + ta) * PLD + C_LY + ch0 + 8 * cg); }
        LBAR();
    }
}

DI void p_mixers(Frame& F, int l) {
    const float lam_init = 0.8f - 0.6f * expf(-0.3f * (float)l);
    if (F.wave == 0) {
        float a = (F.lane < 64) ? PARP(I_DLQ1)[l * 64 + F.lane] * PARP(I_DLK1)[l * 64 + F.lane] : 0.f, c = PARP(I_DLQ2)[l * 64 + F.lane] * PARP(I_DLK2)[l * 64 + F.lane];
        a = wave_sum(a); c = wave_sum(c);
        if (F.lane == 0) F.MISC[4] = __float_as_uint(expf(a) - expf(c) + lam_init);
    }
    __syncthreads();
    const float lam = __uint_as_float(F.MISC[4]);
    unsigned* q = F.ctl + CW_Q + 64 * 4 * l + 512 * F.qset;
#define CONVERT_LOOP() do { if (!(F.skip & 8)) for (;;) { const int it = dequeue(F, q + 192); if (it >= 1024) break; moe_convert_wg(F, l, it); } } while (0)
    const bool streamer = ((blockIdx.x >> 3) & 7) < 3;
    if (streamer) CONVERT_LOOP();
    if (!(F.skip & 1)) for (;;) { const int it = dequeue(F, q); if (it >= 48) break; gla_unit(F, l, it / 6, it % 6); }
    if (!(F.skip & 2)) for (;;) { const int it = dequeue(F, q + 64); if (it >= 64) break; lru_unit(F, l, it >> 3, it & 7); }
    if (!(F.skip & 4)) for (;;) { const int it = dequeue(F, q + 128); if (it >= 768) break; const int qb = 15 - it / 48, bh = it % 48; attn_unit(F, l, bh / 6, bh % 6, qb, lam, 1.0f - lam_init); }
    if (!streamer && !(F.skip & 16)) CONVERT_LOOP();
#undef CONVERT_LOOP
}

#define REFRESH() do { int t_ = threadIdx.x; asm volatile("" : "+v"(t_)); F.tid = t_; F.lane = t_ & 63; F.wave = __builtin_amdgcn_readfirstlane(t_ >> 6); } while (0)
#define IN(k) (lo <= (k) && (k) < hi)
#define SEAM(k) do { if (IN(k) && IN((k) + 1)) xcd_barrier(bar); } while (0)
template <int L>
DI void layer_phases(Frame& F, const XcdBarrier& bar, const int lo, const int hi) {
    constexpr int l = L, pb = 1 + 7 * L;
    if (IN(pb)) { REFRESH(); p_norm<L>(F); SEAM(pb); }
    if (IN(pb + 1)) {
        REFRESH();
        pg8::DenseSched S; S.init(F.ws + WS_U, F.ws + WS_WIN + (size_t)l * PLD * D * 2, T, PLD, D, F.G, (int)blockIdx.x);
        pg8::EpiProj E{(bf16*)(F.ws + WS_PROJ), PLD};
        pg8::gemm_phase<pg8::EpiProj, pg8::DenseSched>(F.lds, S, E);
        SEAM(pb + 1);
    }
    if (IN(pb + 2)) { REFRESH(); p_mixers(F, l); SEAM(pb + 2); }
    if (IN(pb + 3)) {
        REFRESH();
        pg8::DenseSched S; S.init(F.ws + WS_MIX, F.ws + WS_WOUT + (size_t)l * D * D * 2, T, D, D, F.G, (int)blockIdx.x);
        pg8::EpiDelta E{(bf16*)(F.ws + WS_DELTA), (const float*)(F.ws + WS_MOD) + (size_t)l * NB * 6 * D + 2 * D};
        pg8::gemm_phase<pg8::EpiDelta, pg8::DenseSched>(F.lds, S, E);
        SEAM(pb + 3);
    }
    if (IN(pb + 4)) { REFRESH(); p_norm2_router(F, l); SEAM(pb + 4); }
#define MOE_SPLIT() const int n1 = ntile * 4, R2 = n1 / F.G, rem = n1 - R2 * F.G, n_idle = F.G - rem; \
        int E_rt = (rem > 0) ? (3 * n_idle) / 8 : 0; { const int cap = R2 * (F.G / 4); if (E_rt > cap) E_rt = cap; }
    if (IN(pb + 5)) {
        REFRESH();
        const int ntile = moe_tiles(F, l);
        const LAS int* TE = (const LAS int*)(F.lds + TILETAB_OFF); const LAS int* TL = TE + 192; const LAS int* CN = TE + 384;
        LAS unsigned* RT = (LAS unsigned*)(F.lds + ROWTAB_OFF); LAS int* RT2 = (LAS int*)(F.lds + ROWTAB_OFF);
        const int* LIST = (const int*)(F.ws + WS_LIST); const float* WT = (const float*)(F.ws + WS_WT);
        MOE_SPLIT();
        const int c = (int)blockIdx.x;
        pg8::MoeSched S; S.K = D; S.A = (const char*)(F.ws + WS_U); S.Bt = (const char*)(F.ws + WS_W13) + (size_t)l * NE * 1024 * D * 2; S.Bf0 = nullptr; S.Bf1 = nullptr; S.bstride_e = 1024u * D * 2u; S.bstride_pn = 256u * 2u * D;
        S.npn = 4; S.G = F.G; S.c = c; S.tile_e = TE; S.tile_l = TL; S.rowtab = RT; S.gather = true;
        S.rt0 = 0; S.rt_end = ntile; S.rmax = R2; S.lin = 0; S.L0 = 0; S.Lend = 0; S.cl = 0; S.Gl = 1;
        pg8::EpiSwiglu E{(bf16*)(F.ws + WS_HID)};
#define FILL_RT() do { for (int ui = 0; ui < 12; ++ui) { int rt, pn; if (!S.unit_of(ui, rt, pn)) break; const int e = TE[rt], tl = TL[rt]; \
            for (int r = F.tid; r < 256; r += 512) { const int slot = tl * 256 + r; RT[ui * 256 + r] = (slot < CN[e]) ? (unsigned)(LIST[e * 16384 + slot] >> 1) : 0u; } } __syncthreads(); } while (0)
#define FILL_RT2(S2) do { for (int ui = 0; ui < 6; ++ui) { int rt, pn; if (!(S2).unit_of(ui, rt, pn)) break; const int e = TE[rt], tl = TL[rt]; \
            for (int r = F.tid; r < 256; r += 512) { const int slot = tl * 256 + r; int a = -1, wb = 0; if (slot < CN[e]) { a = LIST[e * 16384 + slot]; wb = __float_as_int(WT[a]); } \
                RT2[(ui * 256 + r) * 2] = a; RT2[(ui * 256 + r) * 2 + 1] = wb; } } __syncthreads(); } while (0)
        FILL_RT();
        pg8::gemm_phase<pg8::EpiSwiglu, pg8::MoeSched>(F.lds, S, E);
        if (rem > 0) {
            xcd_barrier(bar);
            const int rtB = ntile - R2 * (F.G / 4), perB = (rtB + 7) >> 3;
#define PB_RT(cc) (R2 * (F.G / 4) + perB * ((cc) & 7) + ((cc) >> 5))
#define PB_BUSY(cc) ((((cc) >> 5) < perB) && (PB_RT(cc) < ntile))
            __syncthreads();
            if (F.tid == 0) F.MISC[6] = 0u;
            __syncthreads();
            if (F.tid < c && !PB_BUSY(F.tid)) __hip_atomic_fetch_add((LAS unsigned*)(F.lds + MISC_OFF) + 6, 1u, __ATOMIC_RELAXED, __HIP_MEMORY_SCOPE_WORKGROUP);
            __syncthreads();
            const int idle_rank = (int)F.MISC[6];
            if (PB_BUSY(c)) {
                S.rmax = 1; S.lin = 1; S.L0 = PB_RT(c) * 4 + ((c >> 3) & 3); S.Lend = S.L0 + 1; S.cl = 0; S.Gl = 1;
                __syncthreads(); FILL_RT();
                pg8::gemm_phase<pg8::EpiSwiglu, pg8::MoeSched>(F.lds, S, E);
            } else if (E_rt > 0) {
                pg8::MoeSched S2; S2.K = DE; S2.A = (const char*)(F.ws + WS_HID); S2.Bt = (const char*)(F.ws + WS_W2); S2.Bf0 = F.in[I_W2] + (size_t)l * NE * DE * D; S2.Bf1 = nullptr; S2.bstride_e = (unsigned)D * DE * 4u; S2.bstride_pn = 1024u;
                S2.npn = 8; S2.G = F.G; S2.c = c; S2.tile_e = TE; S2.tile_l = TL; S2.rowtab = nullptr; S2.gather = false;
                S2.rt0 = 0; S2.rt_end = E_rt; S2.rmax = 3; S2.lin = 1; S2.L0 = 0; S2.Lend = 8 * E_rt; S2.cl = idle_rank; S2.Gl = n_idle;
                __syncthreads(); FILL_RT2(S2);
                pg8::EpiY2 E2{(bf16*)(F.ws + WS_Y2), RT2};
                pg8::gemm_phase<pg8::EpiY2, pg8::MoeSched, true, 2>(F.lds, S2, E2);
            }
        }
        SEAM(pb + 5);
    }
    if (IN(pb + 6)) {
        REFRESH();
        const int ntile = moe_tiles(F, l);
        const LAS int* TE = (const LAS int*)(F.lds + TILETAB_OFF); const LAS int* TL = TE + 192; const LAS int* CN = TE + 384;
        LAS int* RT2 = (LAS int*)(F.lds + ROWTAB_OFF);
        const int* LIST = (const int*)(F.ws + WS_LIST); const float* WT = (const float*)(F.ws + WS_WT);
        MOE_SPLIT();
        pg8::MoeSched S; S.K = DE; S.A = (const char*)(F.ws + WS_HID); S.Bt = (const char*)(F.ws + WS_W2); S.Bf0 = F.in[I_W2] + (size_t)l * NE * DE * D; S.Bf1 = nullptr; S.bstride_e = (unsigned)D * DE * 4u; S.bstride_pn = 1024u;
        S.npn = 8; S.G = F.G; S.c = (int)blockIdx.x; S.tile_e = TE; S.tile_l = TL; S.rowtab = nullptr; S.gather = false;
        S.rt0 = E_rt; S.rt_end = ntile; S.rmax = 6; S.lin = 0; S.L0 = 0; S.Lend = 0; S.cl = 0; S.Gl = 1;
        FILL_RT2(S);
        pg8::EpiY2 E{(bf16*)(F.ws + WS_Y2), RT2};
        pg8::gemm_phase<pg8::EpiY2, pg8::MoeSched, true, 2>(F.lds, S, E);
        SEAM(pb + 6);
    }
#undef MOE_SPLIT
#undef PB_RT
#undef PB_BUSY
#undef FILL_RT
#undef FILL_RT2
}
__global__ void __launch_bounds__(512, 2) mega(Args args) {
    extern __shared__ __attribute__((aligned(16))) unsigned char lds_raw[];
    Frame F;
    F.lds = (LAS unsigned char*)lds_raw; F.MISC = (volatile LAS unsigned*)(F.lds + MISC_OFF);
    F.tid = threadIdx.x; F.lane = F.tid & 63; F.wave = __builtin_amdgcn_readfirstlane(F.tid >> 6);
    F.G = gridDim.x; { const int bx = blockIdx.x; F.vcu = (F.G % 8 == 0) ? (bx % 8) * (F.G / 8) + bx / 8 : bx; }
    F.in = args.in; F.out = args.out; F.ws = args.ws; F.ctl = (unsigned*)(args.ws + WS_CTL); F.qset = args.qset & 255; F.skip = args.qset >> 8;
    if (F.tid < 64) F.MISC[F.tid] = 0u;
    __syncthreads();
    const int lo = args.ph_lo, hi = args.ph_hi;
    XcdBarrier bar; bar.bar = F.ctl + CW_BAR + args.li * XCD_BAR_WORDS; bar.x = 0; bar.st = F.MISC;
    bar = xcd_barrier_post(F.ctl + CW_BAR + args.li * XCD_BAR_WORDS, F.MISC);
    if (IN(0)) { p0_prologue(F); SEAM(0); }
    layer_phases<0>(F, bar, lo, hi);
    layer_phases<1>(F, bar, lo, hi);
    if (IN(15)) { REFRESH(); p_norm<2>(F); }
}
#undef IN
#undef SEAM

extern "C" void kernel_launch(void* const* d_in, const int* in_sizes, int n_in, void* d_out, int out_size, void* d_ws, size_t ws_size, hipStream_t stream) {
    static int grid = 0;
    if (grid == 0) {
        if (n_in != 32 || out_size != T * D || ws_size < WS_END) { fprintf(stderr, "kernel_launch: unexpected shapes (n_in %d, out %d, ws %zu)\n", n_in, out_size, ws_size); grid = -1; return; }
        int dev = 0, cus = 0, per_cu = 0;
        if (hipGetDevice(&dev) != hipSuccess || hipDeviceGetAttribute(&cus, hipDeviceAttributeMultiprocessorCount, dev) != hipSuccess) { grid = -1; return; }
        if (hipFuncSetAttribute((const void*)mega, hipFuncAttributeMaxDynamicSharedMemorySize, LDS_BYTES) != hipSuccess) { fprintf(stderr, "kernel_launch: hipFuncSetAttribute failed\n"); grid = -1; return; }
        if (hipOccupancyMaxActiveBlocksPerMultiprocessor(&per_cu, (const void*)mega, 512, LDS_BYTES) != hipSuccess || per_cu < 1) fprintf(stderr, "kernel_launch: occupancy query reports %d\n", per_cu);
        (void)hipGetLastError();
        grid = cus;
    }
    if (grid < 0) return;
    if (hipMemsetAsync((char*)d_ws + WS_CTL, 0, CTL_BYTES, stream) != hipSuccess) return;
    Args a{};
    for (int i = 0; i < 32; ++i) a.in[i] = (const float*)d_in[i];
    a.out = (float*)d_out; a.ws = (unsigned char*)d_ws;
    static const int plan[][3] = { PLAN };
    for (int li = 0; li < (int)(sizeof(plan) / sizeof(plan[0])); ++li) { a.ph_lo = plan[li][0]; a.ph_hi = plan[li][1]; a.li = li; a.qset = plan[li][2];
        hipLaunchKernelGGL(mega, dim3(grid), dim3(512), LDS_BYTES, stream, a); }
}
```

```cpp
#include <hip/hip_runtime.h>
#include <cstdio>
#include <cstdint>

#define PLAN {0, 16, 0}

#define GAS __attribute__((address_space(1)))
#define LAS __attribute__((address_space(3)))
typedef unsigned short bf16;
typedef short bf16x8 __attribute__((ext_vector_type(8)));
typedef short s16x4 __attribute__((ext_vector_type(4)));
typedef float f32x2 __attribute__((ext_vector_type(2)));
typedef float f32x4 __attribute__((ext_vector_type(4)));
typedef float f32x16 __attribute__((ext_vector_type(16)));
typedef unsigned u32x2 __attribute__((ext_vector_type(2)));
typedef unsigned u32x4 __attribute__((ext_vector_type(4)));
typedef __bf16 bf16x2_t __attribute__((ext_vector_type(2)));
#define DI __device__ __forceinline__

constexpr int NB = 8, SEQ = 2048, D = 2048, T = NB * SEQ, NL = 2;
constexpr int INW = 5648, PLD = 5888;
constexpr int C_GQ = 0, C_GK = 384, C_GV = 768, C_GOG = 1536, C_LY = 2304, C_LX = 2816, C_DQ = 3328, C_DK = 4096, C_DV = 4864, C_GA = 5632;
constexpr int NE = 64, DE = 512;
constexpr float EPS = 1e-6f, LOG2E = 1.4426950408889634f;
constexpr int NPH = 16;

constexpr size_t MiB = 1u << 20;
constexpr size_t WS_CTL = 0, CTL_BYTES = 65536;
constexpr size_t WS_MOD = 1 * MiB;
constexpr size_t WS_WR = 2 * MiB;
constexpr size_t WS_LIST = 4 * MiB;
constexpr size_t WS_WT = 8 * MiB;
constexpr size_t WS_CB = 8 * MiB + 512 * 1024;
constexpr size_t WS_PAR = 9 * MiB;
constexpr size_t WS_WIN = 16 * MiB;
constexpr size_t WS_WOUT = 64 * MiB;
constexpr size_t WS_W13 = 80 * MiB;
constexpr size_t WS_W2 = 592 * MiB;
constexpr size_t WS_H = 848 * MiB;
constexpr size_t WS_U = 976 * MiB;
constexpr size_t WS_PROJ = 1040 * MiB;
constexpr size_t WS_MIX = 1224 * MiB;
constexpr size_t WS_HID = 1288 * MiB;
constexpr size_t WS_Y2 = 1336 * MiB;
constexpr size_t WS_DELTA = 1464 * MiB;
constexpr size_t WS_END = 1528 * MiB;
constexpr int CW_FLAG = 0;
constexpr int CW_Q = 64;
constexpr int CW_CNT = 2048;
constexpr int CW_BAR = 4096;

constexpr int RING_BYTES = 131072;
constexpr int ROWTAB_OFF = 131072;
constexpr int TILETAB_OFF = 143360;
constexpr int MISC_OFF = 145408;
constexpr int LDS_BYTES = 147456;

DI unsigned pk2(float lo, float hi) { f32x2 v = {lo, hi}; return __builtin_bit_cast(unsigned, __builtin_convertvector(v, bf16x2_t)); }
DI float bflo(unsigned w) { return __uint_as_float(w << 16); }
DI float bfhi(unsigned w) { return __uint_as_float(w & 0xffff0000u); }
DI float bf2f(bf16 v) { return __uint_as_float((unsigned)v << 16); }
DI float wave_sum(float v) {
#pragma unroll
    for (int o = 1; o < 64; o <<= 1) v += __shfl_xor(v, o);
    return v;
}
DI float frcp(float x) { return __builtin_amdgcn_rcpf(x); }
DI float fsigmoid(float x) { return frcp(1.f + __builtin_amdgcn_exp2f(-1.4426950408889634f * x)); }
DI float fsilu(float x) { return x * frcp(1.f + __builtin_amdgcn_exp2f(-1.4426950408889634f * x)); }
DI float fgelu_tanh(float x) { const float u2 = (2.0f * 0.7978845608028654f * 1.4426950408889634f) * (x + 0.044715f * x * x * x); return x * frcp(1.f + __builtin_amdgcn_exp2f(-u2)); }
#define LDS_WAIT() asm volatile("s_waitcnt lgkmcnt(0)" ::: "memory")
#define VM_WAIT() asm volatile("s_waitcnt vmcnt(0)" ::: "memory")
#define LBAR() do { asm volatile("s_waitcnt lgkmcnt(0)" ::: "memory"); __builtin_amdgcn_s_barrier(); asm volatile("" ::: "memory"); } while (0)

#define XB_TMO      128
#define XB_XCNT(j)  (256  + 64 * (j))
#define XB_XSUB(j)  (1280 + 64 * (j))
#define XB_XGEN(j)  (2304 + 64 * (j))
#define XB_TOP      3328
#define XB_TOPGEN   3392
#define XCD_BAR_WORDS 3456
#define XB_SPIN_CAP (1u << 18)
DI unsigned xb_ld(unsigned* p)              { return __hip_atomic_load(p, __ATOMIC_RELAXED, __HIP_MEMORY_SCOPE_AGENT); }
DI unsigned xb_add(unsigned* p, unsigned v) { return __hip_atomic_fetch_add(p, v, __ATOMIC_RELAXED, __HIP_MEMORY_SCOPE_AGENT); }
DI unsigned xb_xcc_id() { return (unsigned)__builtin_amdgcn_s_getreg((3 << 11) | 20) & 0xFu; }
#define XB_SPIN(cond, bar) do { unsigned _sp = 0; while (cond) { __builtin_amdgcn_s_sleep(1); \
    if ((++_sp & 255u) == 0u) { if (xb_ld(&(bar)[XB_TMO])) break; if (_sp > XB_SPIN_CAP) { atomicAdd(&(bar)[XB_TMO], 1u); break; } } } } while (0)
struct XcdBarrier { unsigned* bar; unsigned x; volatile LAS unsigned* st; };
DI XcdBarrier xcd_barrier_post(unsigned* bar, volatile LAS unsigned* st) {
    XcdBarrier b; b.bar = bar; b.x = xb_xcc_id(); b.st = st;
    if (threadIdx.x == 0) (void)xb_add(&bar[XB_XCNT(b.x)], 1u);
    return b;
}
DI void xcd_barrier_complete(unsigned* bar, unsigned x, unsigned& nloc, unsigned& nx) {
    const unsigned G = gridDim.x * gridDim.y * gridDim.z;
    unsigned sum, cnt, mine, sp = 0u;
    for (;;) {
        sum = 0u; cnt = 0u; mine = 0u;
#pragma unroll
        for (unsigned j = 0; j < 16; ++j) { const unsigned c = xb_ld(&bar[XB_XCNT(j)]); sum += c; cnt += (c > 0u) ? 1u : 0u; mine = (j == x) ? c : mine; }
        if (sum == G) break;
        __builtin_amdgcn_s_sleep(1);
        if ((++sp & 255u) == 0u) { if (xb_ld(&bar[XB_TMO])) break; if (sp > XB_SPIN_CAP) { atomicAdd(&bar[XB_TMO], 1u); break; } }
    }
    nloc = mine > 0u ? mine : 1u; nx = cnt > 0u ? cnt : 1u;
}
DI void xcd_barrier(const XcdBarrier& b) {
    asm volatile("s_waitcnt vmcnt(0)" ::: "memory");
    __syncthreads();
    if (threadIdx.x == 0) {
        unsigned* bar = b.bar;
        __builtin_amdgcn_s_waitcnt(0);
        unsigned nloc = b.st[0], nx = b.st[1];
        if (nloc == 0u) { xcd_barrier_complete(bar, b.x, nloc, nx); b.st[0] = nloc; b.st[1] = nx; }
        const unsigned old = xb_add(&bar[XB_XSUB(b.x)], 1u);
        const unsigned gen = old / nloc;
        if (old + 1u == (gen + 1u) * nloc) {
            __builtin_amdgcn_fence(__ATOMIC_RELEASE, "agent");
            asm volatile("s_waitcnt vmcnt(0)" ::: "memory");
            const unsigned og = xb_add(&bar[XB_TOP], 1u);
            const unsigned tg = og / nx;
            if (og + 1u == (tg + 1u) * nx) xb_add(&bar[XB_TOPGEN], 1u);
            else XB_SPIN(xb_ld(&bar[XB_TOPGEN]) == tg, bar);
            __builtin_amdgcn_fence(__ATOMIC_ACQUIRE, "agent");
            xb_add(&bar[XB_XGEN(b.x)], 1u);
            asm volatile("s_waitcnt vmcnt(0)" ::: "memory");
        } else {
            XB_SPIN(xb_ld(&bar[XB_XGEN(b.x)]) == gen, bar);
            __builtin_amdgcn_fence(__ATOMIC_ACQUIRE, "agent");
            asm volatile("s_waitcnt vmcnt(0)" ::: "memory");
        }
    }
    __syncthreads();
}

namespace pg8 {
constexpr int BM = 256, BK = 64, HALF = 128, HTB = HALF * BK * 2, STAGE_BYTES = 8 * HTB, NXCD = 8, WGM = 8;
__host__ __device__ __forceinline__ int lds_byte(int r, int c) { const int st = (r >> 4) * 2 + (c >> 5), rr = r & 15, cc = c & 31, ob = rr * 64 + cc * 2; return st * 1024 + (ob ^ (((ob >> 9) & 1) << 5)); }
__host__ __device__ __forceinline__ void stage_rc(int b, int& R, int& C) { const int st = b / 1024, sb = b % 1024, swz = sb ^ (((sb >> 9) & 1) << 5); R = (st >> 1) * 16 + swz / 64; C = (st & 1) * 32 + (swz % 64) / 2; }
__host__ __device__ __forceinline__ int perm32(int rho) { const int n = rho >> 4, i = rho & 15; return 8 * (i >> 2) + 4 * n + (i & 3); }

struct Unit { int pm, pn, e, aux; };

DI s16x4 tr_read_b(const LAS unsigned char* p) { return __builtin_bit_cast(s16x4, __builtin_amdgcn_ds_read_tr16_b64_v4i16((LAS s16x4*)p)); }
template <class Epi, class Sched, bool ALIGN_EPI = true, int BF = 0>
DI void gemm_phase(LAS unsigned char* lds, const Sched& S, const Epi& E) {
    int tid_ = threadIdx.x; asm volatile("" : "+v"(tid_));
    const int tid = tid_, wid = __builtin_amdgcn_readfirstlane(tid >> 6), lane = tid & 63, wr = wid >> 2, wc = wid & 3, fr = lane & 15, fq = lane >> 4;
    const int K = S.K, nt = K / BK;
    const unsigned K2 = (unsigned)K * 2u;
    unsigned voffB[2];
#pragma unroll
    for (int i = 0; i < 2; ++i) { int R, C; stage_rc(tid * 16 + i * 8192, R, C); const int Rb = Epi::PERM ? ((R & ~31) + perm32(R & 31)) : R;
        voffB[i] = (unsigned)(Rb * K + C) * 2u; }
    const unsigned hstepB = (unsigned)HALF * K * 2u;
    const unsigned ldsw = (unsigned)wid * 1024u;
    const int aoff = lds_byte(wr * 64 + fr, fq * 8), boff = lds_byte(wc * 32 + fr, fq * 8);
    const __amdgpu_buffer_rsrc_t rsA = __builtin_amdgcn_make_buffer_rsrc((void*)S.A, 0, 0x7fffffff, 0x00020000);
    const __amdgpu_buffer_rsrc_t rsB = __builtin_amdgcn_make_buffer_rsrc((void*)S.Bt, 0, 0x7fffffff, 0x00020000);
    const __amdgpu_buffer_rsrc_t rsF = __builtin_amdgcn_make_buffer_rsrc((void*)((BF == 1 && (wid & 1)) ? S.Bf1 : S.Bf0), 0, 0x7fffffff, 0x00020000);
    constexpr unsigned KBMUL = (BF == 1) ? 1024u : 4096u, ROWB = (BF == 1) ? 2048u : 8192u;
    unsigned voffF = 0, wrowoff = 0, bwr0 = 0, brd0 = 0; const unsigned ldsbase = (unsigned)(unsigned long long)lds;
    u32x4 bq[8];
    if constexpr (BF == 2) {
        const unsigned r0 = ((unsigned)wid & 3u) + 8u * ((unsigned)wid >> 2);
        voffF = (unsigned)lane * 16u; wrowoff = r0 * ROWB;
        const unsigned seg = 8u * (lane >> 3) + 4u * (lane & 1) + ((lane >> 1) & 3);
        bwr0 = r0 * 512u + ((seg ^ (((r0 & 3u) << 2) | (((r0 >> 3) & 1u) << 4))) << 3);
    } else if constexpr (BF == 1) {
        const unsigned rh = lane >> 5, c = lane & 31, kq = (unsigned)wid >> 1, hs = (unsigned)wid & 1u;
        const unsigned r0w = 2u * (kq & 1u) + 8u * (kq >> 1), r0 = r0w + rh;
        voffF = rh * ROWB + c * 16u; wrowoff = r0w * ROWB;
        const unsigned seg = 32u * hs + 8u * (c >> 3) + 4u * (c & 1) + ((c >> 1) & 3);
        bwr0 = r0 * 512u + ((seg ^ (((r0 & 3u) << 2) | (((r0 >> 3) & 1u) << 4))) << 3);
    }
    if constexpr (BF != 0) {
        const unsigned segb = 8u * wc, mask = (((unsigned)fr >> 2) << 2) | (((unsigned)fq & 1u) << 4);
        brd0 = (unsigned)(8 * fq + (fr >> 2)) * 512u + (((segb ^ mask) | ((unsigned)fr & 3u)) << 3);
    }
    const unsigned brdA = ldsbase + brd0, brdB = ldsbase + (brd0 ^ 32u);
#define PG8_ROWD(i) ((unsigned)(((i) & 1) * 4 + ((i) >> 1) * 16))
#define PG8_LDBF(bp, kb) do { const unsigned _s = (bp) + (kb) * KBMUL + wrowoff; _Pragma("unroll") for (int _i = 0; _i < 8; ++_i) \
        bq[_i] = __builtin_bit_cast(u32x4, __builtin_amdgcn_raw_buffer_load_b128(rsF, voffF, _s + PG8_ROWD(_i) * ROWB, 0)); } while (0)
#define PG8_WRB(slot) do { PG8_WAIT_V(4); _Pragma("unroll") for (int _i = 0; _i < 8; ++_i) { \
        u32x2 _w; _w.x = pk2(__uint_as_float(bq[_i].x), __uint_as_float(bq[_i].y)); _w.y = pk2(__uint_as_float(bq[_i].z), __uint_as_float(bq[_i].w)); \
        *(LAS u32x2*)(lds + PG8_SB(slot, 0) + bwr0 + PG8_ROWD(_i) * 512u) = _w; } } while (0)
#define PG8_TR(d, a, off) asm volatile("ds_read_b64_tr_b16 %0, %1 offset:%2" : "=v"(d) : "v"(a), "i"(off) : "memory")
#define PG8_LDBT(dst, b, bj) do { constexpr int _o = PG8_SB(b, 0) + (bj) * 256; s16x4 _t0, _t1, _t2, _t3, _t4, _t5, _t6, _t7; \
        PG8_TR(_t0, brdA, _o); PG8_TR(_t1, brdA, _o + 2048); PG8_TR(_t2, brdA, _o + 16384); PG8_TR(_t3, brdA, _o + 18432); PG8_TR(_t4, brdB, _o); PG8_TR(_t5, brdB, _o + 2048); PG8_TR(_t6, brdB, _o + 16384); PG8_TR(_t7, brdB, _o + 18432); \
        dst[0][0] = __builtin_shufflevector(_t0, _t1, 0, 1, 2, 3, 4, 5, 6, 7); dst[0][1] = __builtin_shufflevector(_t2, _t3, 0, 1, 2, 3, 4, 5, 6, 7); \
        dst[1][0] = __builtin_shufflevector(_t4, _t5, 0, 1, 2, 3, 4, 5, 6, 7); dst[1][1] = __builtin_shufflevector(_t6, _t7, 0, 1, 2, 3, 4, 5, 6, 7); } while (0)
#define PG8_TIEB(x) asm volatile("s_waitcnt lgkmcnt(0)" : "+v"(x[0][0]), "+v"(x[0][1]), "+v"(x[1][0]), "+v"(x[1][1]) :: "memory")
#define PG8_LDBTH(dst, n, b, bj) do { constexpr int _o = PG8_SB(b, 0) + (bj) * 256; const unsigned _a = (n) ? brdB : brdA; s16x4 _t0, _t1, _t2, _t3; \
        PG8_TR(_t0, _a, _o); PG8_TR(_t1, _a, _o + 2048); PG8_TR(_t2, _a, _o + 16384); PG8_TR(_t3, _a, _o + 18432); \
        dst[n][0] = __builtin_shufflevector(_t0, _t1, 0, 1, 2, 3, 4, 5, 6, 7); dst[n][1] = __builtin_shufflevector(_t2, _t3, 0, 1, 2, 3, 4, 5, 6, 7); } while (0)
#define PG8_TIEH(x, n, cnt) asm volatile("s_waitcnt lgkmcnt(" #cnt ")" : "+v"(x[n][0]), "+v"(x[n][1]) :: "memory")
#define PG8_MMAH(ai, bj, n, At, Bt) do { _Pragma("unroll") for (int m = 0; m < 4; ++m) _Pragma("unroll") for (int k = 0; k < 2; ++k) \
        acc[ai][bj][m][n] = __builtin_amdgcn_mfma_f32_16x16x32_bf16(Bt[n][k], At[m][k], acc[ai][bj][m][n], 0, 0, 0); } while (0)
#define PG8_MMA2(ai, bj0, bj1, b) do { __builtin_amdgcn_s_setprio(1); PG8_MMAH(ai, bj0, 0, At, B0); PG8_SCHED; PG8_LDBTH(B0, 0, b, bj1); PG8_SCHED; PG8_MMAH(ai, bj0, 1, At, B0); PG8_SCHED; PG8_LDBTH(B0, 1, b, bj1); PG8_SCHED; \
        PG8_TIEH(B0, 0, 4); PG8_MMAH(ai, bj1, 0, At, B0); PG8_SCHED; PG8_TIEH(B0, 1, 0); PG8_MMAH(ai, bj1, 1, At, B0); __builtin_amdgcn_s_setprio(0); } while (0)
#define PG8_SA(b, h) (((BF != 0 ? 4 : 0) + (b) * 2 + (h)) * HTB)
#define PG8_SB(b, h) (((BF != 0 ? 0 : 4) + (b) * 2 + (h)) * HTB)
#define PG8_STAGE_A(bufoff, kb, va) do { _Pragma("unroll") for (int _i = 0; _i < 2; ++_i) \
        __builtin_amdgcn_raw_ptr_buffer_load_lds(rsA, (LAS unsigned*)(lds + (bufoff) + ldsw + _i * 8192), 16, (va)[_i], (kb), 0, 0); } while (0)
#define PG8_STAGE_B(bufoff, bp, kb) do { _Pragma("unroll") for (int _i = 0; _i < 2; ++_i) \
        __builtin_amdgcn_raw_ptr_buffer_load_lds(rsB, (LAS unsigned*)(lds + (bufoff) + ldsw + _i * 8192), 16, voffB[_i], (bp) + (kb), 0, 0); } while (0)
#define PG8_LDA(dst, b, h) do { _Pragma("unroll") for (int m = 0; m < 4; ++m) _Pragma("unroll") for (int k = 0; k < 2; ++k) dst[m][k] = *(const LAS bf16x8*)(lds + PG8_SA(b, h) + aoff + m * 2048 + k * 1024); } while (0)
#define PG8_LDB(dst, b, h) do { _Pragma("unroll") for (int n = 0; n < 2; ++n) _Pragma("unroll") for (int k = 0; k < 2; ++k) dst[n][k] = *(const LAS bf16x8*)(lds + PG8_SB(b, h) + boff + n * 2048 + k * 1024); } while (0)
#define PG8_MMA(ai, bj, At, Bt) do { __builtin_amdgcn_s_setprio(1); _Pragma("unroll") for (int m = 0; m < 4; ++m) _Pragma("unroll") for (int n = 0; n < 2; ++n) _Pragma("unroll") for (int k = 0; k < 2; ++k) \
        acc[ai][bj][m][n] = __builtin_amdgcn_mfma_f32_16x16x32_bf16(Bt[n][k], At[m][k], acc[ai][bj][m][n], 0, 0, 0); __builtin_amdgcn_s_setprio(0); } while (0)
#define PG8_WAIT_V(n) asm volatile("s_waitcnt vmcnt(" #n ")" ::: "memory")
#define PG8_WAIT_L(n) asm volatile("s_waitcnt lgkmcnt(" #n ")" ::: "memory")
#define PG8_BAR __builtin_amdgcn_s_barrier()
#define PG8_SCHED __builtin_amdgcn_sched_barrier(0)
    Unit cur, nxt; int ui = 0;
    if (!S.next(0, cur)) return;
    f32x4 acc[2][2][4][2];
#pragma unroll
    for (int a = 0; a < 2; ++a)
#pragma unroll
        for (int b = 0; b < 2; ++b)
#pragma unroll
            for (int m = 0; m < 4; ++m)
#pragma unroll
                for (int n = 0; n < 2; ++n) acc[a][b][m][n] = (f32x4){0.f, 0.f, 0.f, 0.f};
    bf16x8 At[4][2], B0[2][2], B1[2][2];
    unsigned vAc[2][2];
#define PG8_SETVA(dst, unit, uidx) do { int _t = tid; if constexpr (BF != 0) asm volatile("" : "+v"(_t));   \
        _Pragma("unroll") for (int _i = 0; _i < 2; ++_i) { int _R, _C; stage_rc(_t * 16 + _i * 8192, _R, _C); \
        _Pragma("unroll") for (int _h = 0; _h < 2; ++_h) dst[_h][_i] = S.arow(unit, uidx, 128 * _h + _R) * K2 + (unsigned)_C * 2u; } } while (0)
    PG8_SETVA(vAc, cur, 0);
    unsigned cB = S.bbase(cur);
    if constexpr (BF == 0) {
        PG8_STAGE_B(PG8_SB(0, 0), cB, 0u); PG8_STAGE_B(PG8_SB(0, 1), cB + hstepB, 0u); PG8_STAGE_A(PG8_SA(0, 0), 0u, vAc[0]); PG8_STAGE_A(PG8_SA(0, 1), 0u, vAc[1]);
        if (wr == 1) PG8_BAR;
        PG8_WAIT_V(2); PG8_BAR;
        PG8_STAGE_B(PG8_SB(1, 0), cB, 128u); PG8_STAGE_A(PG8_SA(1, 0), 128u, vAc[0]); PG8_STAGE_B(PG8_SB(1, 1), cB + hstepB, 128u);
        PG8_WAIT_V(6); PG8_BAR;
    } else {
        PG8_LDBF(cB, 0u); PG8_STAGE_A(PG8_SA(0, 0), 0u, vAc[0]); PG8_STAGE_A(PG8_SA(0, 1), 0u, vAc[1]);
        if (wr == 1) PG8_BAR;
        PG8_WRB(0); PG8_WAIT_V(2); PG8_WAIT_L(0); PG8_BAR;
        PG8_LDBF(cB, 128u); PG8_STAGE_A(PG8_SA(1, 0), 128u, vAc[0]);
        PG8_WAIT_V(10); PG8_BAR;
    }
#define PG8_KTRIP(kb1, kb2, kb3, VA2, B2) do { if constexpr (BF != 0) { \
              \
            PG8_LDBT(B0, 0, 0); PG8_SCHED; PG8_LDA(At, 0, 0); PG8_STAGE_A(PG8_SA(1, 1), kb1, vAc[1]); \
            PG8_WAIT_V(12); PG8_TIEB(B0); PG8_BAR; PG8_MMA2(0, 0, 1, 0); PG8_BAR; PG8_SCHED; \
            PG8_WRB(1); PG8_SCHED; PG8_LDBF(B2, kb2); PG8_SCHED; PG8_LDA(At, 0, 1); PG8_STAGE_A(PG8_SA(0, 0), kb2, VA2[0]); \
            PG8_WAIT_V(12); PG8_WAIT_L(0); PG8_BAR; PG8_MMA2(1, 1, 0, 0); PG8_BAR; PG8_SCHED; \
            PG8_LDBT(B0, 1, 0); PG8_SCHED; PG8_LDA(At, 1, 0); PG8_STAGE_A(PG8_SA(0, 1), kb2, VA2[1]); \
            PG8_WAIT_V(12); PG8_TIEB(B0); PG8_BAR; PG8_MMA2(0, 0, 1, 1); PG8_BAR; PG8_SCHED; \
            PG8_WRB(0); PG8_SCHED; PG8_LDBF(B2, kb3); PG8_SCHED; PG8_LDA(At, 1, 1); PG8_STAGE_A(PG8_SA(1, 0), kb3, VA2[0]); \
            PG8_WAIT_V(12); PG8_WAIT_L(0); PG8_BAR; PG8_MMA2(1, 1, 0, 1); PG8_BAR; PG8_SCHED; } else { \
            PG8_LDB(B0, 0, 0); PG8_LDB(B1, 0, 1); PG8_SCHED; PG8_LDA(At, 0, 0); PG8_STAGE_A(PG8_SA(1, 1), kb1, vAc[1]); \
            PG8_WAIT_V(8); PG8_WAIT_L(0); PG8_BAR; PG8_MMA(0, 0, At, B0); PG8_MMA(0, 1, At, B1); PG8_BAR; PG8_SCHED; \
            PG8_LDA(At, 0, 1); PG8_STAGE_B(PG8_SB(0, 0), B2, kb2); PG8_STAGE_B(PG8_SB(0, 1), (B2) + hstepB, kb2); PG8_STAGE_A(PG8_SA(0, 0), kb2, VA2[0]); \
            PG8_WAIT_V(8); PG8_WAIT_L(0); PG8_BAR; PG8_MMA(1, 0, At, B0); PG8_MMA(1, 1, At, B1); PG8_BAR; PG8_SCHED; \
            PG8_LDB(B0, 1, 0); PG8_LDB(B1, 1, 1); PG8_SCHED; PG8_LDA(At, 1, 0); PG8_STAGE_A(PG8_SA(0, 1), kb2, VA2[1]); \
            PG8_WAIT_V(8); PG8_WAIT_L(0); PG8_BAR; PG8_MMA(0, 0, At, B0); PG8_MMA(0, 1, At, B1); PG8_BAR; PG8_SCHED; \
            PG8_LDA(At, 1, 1); PG8_STAGE_B(PG8_SB(1, 0), B2, kb3); PG8_STAGE_B(PG8_SB(1, 1), (B2) + hstepB, kb3); PG8_STAGE_A(PG8_SA(1, 0), kb3, VA2[0]); \
            PG8_WAIT_V(8); PG8_WAIT_L(0); PG8_BAR; PG8_MMA(1, 0, At, B0); PG8_MMA(1, 1, At, B1); PG8_BAR; PG8_SCHED; } } while (0)
    for (;;) {
        for (int t = 0; t < nt - 2; t += 2) { const unsigned kb1 = (unsigned)(t + 1) * 128u; PG8_KTRIP(kb1, kb1 + 128u, kb1 + 256u, vAc, cB); }
        const bool has_next = S.next(ui + 1, nxt);
        unsigned vAn[2][2]; unsigned nB = cB;
#pragma unroll
        for (int h = 0; h < 2; ++h)
#pragma unroll
            for (int i = 0; i < 2; ++i) vAn[h][i] = vAc[h][i];
        if (has_next) { nB = S.bbase(nxt); PG8_SETVA(vAn, nxt, ui + 1); }
        { const unsigned kb1 = (unsigned)(nt - 1) * 128u; PG8_KTRIP(kb1, 0u, 128u, vAn, nB); }
        if constexpr (ALIGN_EPI) { if (wr == 0) PG8_BAR; }
        if constexpr (BF != 0) { int t_ = tid; asm volatile("" : "+v"(t_)); E(acc, cur, ui, wr, wc, t_ & 15, (t_ & 63) >> 4); }
        else E(acc, cur, ui, wr, wc, fr, fq);
        if (!has_next) break;
#pragma unroll
        for (int a = 0; a < 2; ++a)
#pragma unroll
            for (int b = 0; b < 2; ++b)
#pragma unroll
                for (int m = 0; m < 4; ++m)
#pragma unroll
                    for (int n = 0; n < 2; ++n) acc[a][b][m][n] = (f32x4){0.f, 0.f, 0.f, 0.f};
        cur = nxt; cB = nB; ++ui;
#pragma unroll
        for (int h = 0; h < 2; ++h)
#pragma unroll
            for (int i = 0; i < 2; ++i) vAc[h][i] = vAn[h][i];
        if constexpr (ALIGN_EPI) { if (wr == 1) PG8_BAR; }
    }
    PG8_WAIT_V(0);
    if constexpr (!ALIGN_EPI) { if (wr == 0) PG8_BAR; }
    PG8_BAR;
#undef PG8_KTRIP
#undef PG8_LDBF
#undef PG8_WRB
#undef PG8_LDBT
#undef PG8_TR
#undef PG8_TIEB
#undef PG8_ROWD
#undef PG8_LDBTH
#undef PG8_TIEH
#undef PG8_MMAH
#undef PG8_MMA2
#undef PG8_SETVA
#undef PG8_SA
#undef PG8_SB
#undef PG8_STAGE_A
#undef PG8_STAGE_B
#undef PG8_LDA
#undef PG8_LDB
#undef PG8_MMA
#undef PG8_WAIT_V
#undef PG8_WAIT_L
#undef PG8_BAR
#undef PG8_SCHED
}

struct DenseSched {
    int K; const char* A; const char* Bt; int nM, nN, nwg, G, c; static constexpr const float* Bf0 = nullptr; static constexpr const float* Bf1 = nullptr;
    DI void init(const void* A_, const void* Bt_, int M, int N, int K_, int G_, int c_) { A = (const char*)A_; Bt = (const char*)Bt_; K = K_; nM = M / BM; nN = N / BM; nwg = nM * nN; G = G_; c = c_; }
    DI bool next(int i, Unit& u) const {
        const long L = (long)i * G + c; if (L >= nwg) return false;
        int wgid = (int)L; { const int q = nwg / NXCD, r = nwg % NXCD, xcd = wgid % NXCD, off = wgid / NXCD; wgid = (xcd < r ? xcd * (q + 1) : r * (q + 1) + (xcd - r) * q) + off; }
        const int nig = WGM * nN, gid = wgid / nig, fm = gid * WGM, gsz = (nM - fm) < WGM ? (nM - fm) : WGM;
        u.pm = fm + ((wgid % nig) % gsz); u.pn = (wgid % nig) / gsz; u.e = 0; u.aux = 0; return true;
    }
    DI unsigned arow(const Unit& u, int, int r) const { return (unsigned)(u.pm * BM + r); }
    DI unsigned bbase(const Unit& u) const { return (unsigned)u.pn * (unsigned)(BM * 2) * (unsigned)K; }
};
struct MoeSched {
    int K; const char* A; const char* Bt; const float* Bf0; const float* Bf1; unsigned bstride_e, bstride_pn; int npn, G, c; const LAS int* tile_e; const LAS int* tile_l; const LAS unsigned* rowtab; bool gather;
    int rt0, rt_end, rmax;
    int lin, L0, Lend, cl, Gl;
    DI bool unit_of(int i, int& rt, int& pn) const {
        if (i >= rmax) return false;
        if (lin) { if (cl < 0) return false; const int L = L0 + i * Gl + cl; rt = L / npn; pn = L - rt * npn; return L < Lend; }
        if (G % (8 * npn) == 0) { const int x = c & 7, j = c >> 3, per = G / (8 * npn); pn = j % npn; rt = rt0 + i * (G / npn) + per * x + j / npn; return rt < rt_end; }
        const int L = i * G + c; rt = rt0 + L / npn; pn = L % npn; return rt < rt_end;
    }
    DI bool next(int i, Unit& u) const {
        int rt, pn; if (!unit_of(i, rt, pn)) return false;
        u.pm = rt; u.pn = pn; u.e = __builtin_amdgcn_readfirstlane(tile_e[rt]); u.aux = __builtin_amdgcn_readfirstlane(tile_l[rt]); return true;
    }
    DI unsigned arow(const Unit& u, int ui, int r) const { return gather ? rowtab[ui * 256 + r] : (unsigned)(u.pm * BM + r); }
    DI unsigned bbase(const Unit& u) const { return (unsigned)u.e * bstride_e + (unsigned)u.pn * bstride_pn; }
};

struct EpiProj {
    static constexpr bool PERM = true;
    bf16* O; int ldc;
    DI void operator()(const f32x4 (&acc)[2][2][4][2], const Unit& u, int, int wr, int wc, int fr, int fq) const {
        const int row0 = u.pm * BM + wr * 64 + fr, col0 = u.pn * BM + wc * 32 + 8 * fq;
#pragma unroll
        for (int ai = 0; ai < 2; ++ai)
#pragma unroll
            for (int m = 0; m < 4; ++m) { bf16* rowp = O + (size_t)(row0 + ai * HALF + m * 16) * ldc + col0;
#pragma unroll
                for (int bj = 0; bj < 2; ++bj) { const f32x4 v0 = acc[ai][bj][m][0], v1 = acc[ai][bj][m][1];
                    u32x4 w; w.x = pk2(v0[0], v0[1]); w.y = pk2(v0[2], v0[3]); w.z = pk2(v1[0], v1[1]); w.w = pk2(v1[2], v1[3]);
                    *(u32x4*)(rowp + bj * HALF) = w; } }
    }
};
struct EpiDelta {
    static constexpr bool PERM = true;
    bf16* O; const float* g;
    DI void operator()(const f32x4 (&acc)[2][2][4][2], const Unit& u, int, int wr, int wc, int fr, int fq) const {
        const int row0 = u.pm * BM + wr * 64 + fr, col0 = u.pn * BM + wc * 32 + 8 * fq;
        const float* gb = g + (size_t)(u.pm >> 3) * (6 * D) + col0;
        f32x4 gv[2][2];
#pragma unroll
        for (int bj = 0; bj < 2; ++bj)
#pragma unroll
            for (int n = 0; n < 2; ++n) gv[bj][n] = *(const f32x4*)(gb + bj * HALF + 4 * n);
#pragma unroll
        for (int ai = 0; ai < 2; ++ai)
#pragma unroll
            for (int m = 0; m < 4; ++m) { bf16* rowp = O + (size_t)(row0 + ai * HALF + m * 16) * D + col0;
#pragma unroll
                for (int bj = 0; bj < 2; ++bj) { const f32x4 v0 = acc[ai][bj][m][0] * gv[bj][0], v1 = acc[ai][bj][m][1] * gv[bj][1];
                    u32x4 w; w.x = pk2(v0[0], v0[1]); w.y = pk2(v0[2], v0[3]); w.z = pk2(v1[0], v1[1]); w.w = pk2(v1[2], v1[3]);
                    *(u32x4*)(rowp + bj * HALF) = w; } }
    }
};
struct EpiSwiglu {
    static constexpr bool PERM = true;
    bf16* O;
    DI void operator()(const f32x4 (&acc)[2][2][4][2], const Unit& u, int, int wr, int wc, int fr, int fq) const {
        const int row0 = u.pm * BM + wr * 64 + fr, col0 = u.pn * HALF + wc * 32 + 8 * fq;
#pragma unroll
        for (int ai = 0; ai < 2; ++ai)
#pragma unroll
            for (int m = 0; m < 4; ++m) { bf16* rowp = O + (size_t)(row0 + ai * HALF + m * 16) * DE + col0;
                float hv[8];
#pragma unroll
                for (int n = 0; n < 2; ++n)
#pragma unroll
                    for (int j = 0; j < 4; ++j) { const float a = acc[ai][0][m][n][j], b = acc[ai][1][m][n][j]; hv[4 * n + j] = fsilu(a) * b; }
                u32x4 w; w.x = pk2(hv[0], hv[1]); w.y = pk2(hv[2], hv[3]); w.z = pk2(hv[4], hv[5]); w.w = pk2(hv[6], hv[7]);
                *(u32x4*)rowp = w; }
    }
};
struct EpiY2 {
    static constexpr bool PERM = true;
    bf16* Y; const LAS int* rowtab;
    DI void operator()(const f32x4 (&acc)[2][2][4][2], const Unit& u, int ui, int wr, int wc, int fr, int fq) const {
        const int col0 = u.pn * BM + wc * 32 + 8 * fq;
#pragma unroll
        for (int ai = 0; ai < 2; ++ai)
#pragma unroll
            for (int m = 0; m < 4; ++m) { const int r = ai * HALF + wr * 64 + m * 16 + fr; const int a = rowtab[(ui * 256 + r) * 2]; const float wgt = __int_as_float(rowtab[(ui * 256 + r) * 2 + 1]);
                if (a >= 0) { bf16* rowp = Y + (size_t)a * D + col0;
#pragma unroll
                    for (int bj = 0; bj < 2; ++bj) { const f32x4 v0 = acc[ai][bj][m][0] * wgt, v1 = acc[ai][bj][m][1] * wgt;
                        u32x4 w; w.x = pk2(v0[0], v0[1]); w.y = pk2(v0[2], v0[3]); w.z = pk2(v1[0], v1[1]); w.w = pk2(v1[2], v1[3]);
                        *(u32x4*)(rowp + bj * HALF) = w; } } }
    }
};
}

struct Args { const float* in[32]; float* out; unsigned char* ws; int ph_lo, ph_hi, li, qset; };
struct Frame {
    LAS unsigned char* lds; volatile LAS unsigned* MISC; unsigned* ctl;
    int tid, lane, wave, G, vcu, qset, skip;
    const float* const* in; float* out; unsigned char* ws;
};
enum { I_X = 0, I_C, I_ADAW, I_ADAB, I_N1G, I_WIN, I_GWA2, I_GBA, I_GNG, I_LCW, I_LCB, I_LWA, I_LBA, I_LWX, I_LBX, I_LLAM, I_DLQ1, I_DLK1, I_DLQ2, I_DLK2, I_DSUB, I_RELB, I_WOUT, I_N2G,
       I_RGW, I_RGB, I_REW, I_REB, I_W1, I_W3, I_W2, I_FING };


constexpr int par_size(int id) {
    return id == I_N1G ? 4096 : id == I_GWA2 ? 12288 : id == I_GBA ? 768 : id == I_GNG ? 1536 : id == I_LCW ? 4096 : id == I_LCB ? 1024 : id == I_LWA ? 65536 : id == I_LBA ? 1024 : id == I_LWX ? 65536 :
           id == I_LBX ? 1024 : id == I_LLAM ? 1024 : (id >= I_DLQ1 && id <= I_DLK2) ? 128 : id == I_DSUB ? 256 : id == I_RELB ? 192 : id == I_N2G ? 4096 : id == I_RGB ? 16 : id == I_REB ? 128 : id == I_FING ? 2048 : 0;
}
constexpr int par_off(int id) { int o = 0; for (int i = 0; i < id; ++i) o += par_size(i); return o; }
constexpr int PAR_TOTAL = par_off(32);
#define PARP(id) ((const float*)(F.ws + WS_PAR) + par_off(id))
struct CvItem { const float* src; bf16* dst; unsigned ldsrc, lddst; int nvalid; };
DI void cv_load(const CvItem& ci, f32x4 (&v)[8], int lane) {
    const int kq = lane >> 3, c = lane & 7;
    if (4 * c < ci.nvalid) {
#pragma unroll
        for (int i = 0; i < 8; ++i) v[i] = __builtin_nontemporal_load((const f32x4*)(ci.src + (size_t)(8 * kq + i) * ci.ldsrc + 4 * c));
    } else {
#pragma unroll
        for (int i = 0; i < 8; ++i) v[i] = (f32x4){0.f, 0.f, 0.f, 0.f};
    }
}
DI void cv_store(const CvItem& ci, const f32x4 (&v)[8], int lane) {
    const int kq = lane >> 3, c = lane & 7;
#pragma unroll
    for (int q = 0; q < 4; ++q) { u32x4 o; o.x = pk2(v[0][q], v[1][q]); o.y = pk2(v[2][q], v[3][q]); o.z = pk2(v[4][q], v[5][q]); o.w = pk2(v[6][q], v[7][q]);
        __builtin_nontemporal_store(o, (u32x4*)(ci.dst + (size_t)(4 * c + q) * ci.lddst + 8 * kq)); }
}
DI CvItem moe_item(Frame& F, int l, int r) {
    CvItem c; c.nvalid = 32;
    if (r < 65536) {
        const int e = r / 1024, r2 = r % 1024, kb = r2 / 32, nb = r2 % 32, n0 = nb * 32, jt = n0 >> 8, rr = n0 & 255;
        const float* W = (rr < 128) ? F.in[I_W1] : F.in[I_W3];
        c.src = W + ((size_t)(l * NE + e) * D + kb * 64) * DE + jt * 128 + (rr & 127); c.ldsrc = DE;
        c.dst = (bf16*)(F.ws + WS_W13) + ((size_t)(l * NE + e) * 1024 + n0) * D + kb * 64; c.lddst = D;
    } else {
        r -= 65536; const int e = r / 512, r2 = r % 512, kb = r2 / 64, nb = r2 % 64;
        c.src = F.in[I_W2] + ((size_t)(l * NE + e) * DE + kb * 64) * D + nb * 32; c.ldsrc = D;
        c.dst = (bf16*)(F.ws + WS_W2) + ((size_t)(l * NE + e) * D + nb * 32) * DE + kb * 64; c.lddst = DE;
    }
    return c;
}
DI void moe_convert_wg(Frame& F, int l, int it) {
    const int r0 = it * 64 + F.wave, lane = F.lane;
    f32x4 va[8], vb[8], vc[8];
#define CV_L(buf, j) cv_load(moe_item(F, l, r0 + 8 * (j)), buf, lane)
#define CV_S(buf, j) cv_store(moe_item(F, l, r0 + 8 * (j)), buf, lane)
    CV_L(va, 0); CV_L(vb, 1); CV_L(vc, 2);
    CV_S(va, 0); CV_L(va, 3);
    CV_S(vb, 1); CV_L(vb, 4);
    CV_S(vc, 2); CV_L(vc, 5);
    CV_S(va, 3); CV_L(va, 6);
    CV_S(vb, 4); CV_L(vb, 7);
    CV_S(vc, 5); CV_S(va, 6); CV_S(vb, 7);
#undef CV_L
#undef CV_S
}
DI void p0_prologue(Frame& F) {
    const int tid = F.tid;
    {
        LAS float* SC = (LAS float*)F.lds;
        LAS float* RED = (LAS float*)(F.lds + 65536);
        const float* cin = F.in[I_C];
        for (int idx = tid; idx < NB * D; idx += 512) { const float c = cin[idx]; SC[idx] = fsilu(c); }
        __syncthreads();
        for (int tile = blockIdx.x; tile < 256; tile += F.G) {
            const int l = tile >> 7, col0 = (tile & 127) * 96;
            const int cg = tid % 24, rs = tid / 24;
            f32x4 acc[NB];
#pragma unroll
            for (int b = 0; b < NB; ++b) acc[b] = (f32x4){0.f, 0.f, 0.f, 0.f};
            if (tid < 504) {
                const float* wp = F.in[I_ADAW] + (size_t)l * D * (6 * D) + col0 + 4 * cg;
#pragma unroll 4
                for (int k = rs; k < D; k += 21) { const f32x4 w = __builtin_nontemporal_load((const f32x4*)(wp + (size_t)k * (6 * D)));
#pragma unroll
                    for (int b = 0; b < NB; ++b) acc[b] += SC[b * D + k] * w; }
#pragma unroll
                for (int b = 0; b < NB; ++b) *(LAS f32x4*)(RED + (rs * NB + b) * 96 + cg * 4) = acc[b];
            }
            __syncthreads();
            for (int idx = tid; idx < NB * 96; idx += 512) { const int b = idx / 96, cc = idx % 96; float s = F.in[I_ADAB][(size_t)l * 6 * D + col0 + cc];
                for (int r = 0; r < 21; ++r) s += RED[(r * NB + b) * 96 + cc];
                ((float*)(F.ws + WS_MOD))[(size_t)(l * NB + b) * (6 * D) + col0 + cc] = s; }
            __syncthreads();
        }
    }
    {
        const int gt = F.vcu * 512 + tid, NT_ = F.G * 512;
        float* PAR = (float*)(F.ws + WS_PAR);
#define PAR_COPY(id) for (int idx = gt; idx < par_size(id); idx += NT_) PAR[par_off(id) + idx] = F.in[id][idx];
        PAR_COPY(I_N1G) PAR_COPY(I_GWA2) PAR_COPY(I_GBA) PAR_COPY(I_GNG) PAR_COPY(I_LCW) PAR_COPY(I_LCB) PAR_COPY(I_LWA) PAR_COPY(I_LBA) PAR_COPY(I_LWX) PAR_COPY(I_LBX) PAR_COPY(I_LLAM)
        PAR_COPY(I_DLQ1) PAR_COPY(I_DLK1) PAR_COPY(I_DLQ2) PAR_COPY(I_DLK2) PAR_COPY(I_DSUB) PAR_COPY(I_RELB) PAR_COPY(I_N2G) PAR_COPY(I_RGB) PAR_COPY(I_REB) PAR_COPY(I_FING)
#undef PAR_COPY
    }
    {
        const int gt = F.vcu * 512 + tid, NT_ = F.G * 512;
        bf16* WR = (bf16*)(F.ws + WS_WR);
        for (int idx = gt; idx < NL * 80 * D; idx += NT_) { const int l = idx / (80 * D), rem = idx % (80 * D), n = rem / D, k = rem % D;
            float w = 0.f; if (n < 8) w = F.in[I_RGW][((size_t)l * D + k) * 8 + n]; else if (n < 72) w = F.in[I_REW][((size_t)l * D + k) * 64 + (n - 8)];
            const unsigned hi = pk2(w, 0.f) & 0xffffu; const float rem_ = w - bflo(hi); const unsigned lo = pk2(rem_, 0.f) & 0xffffu;
            WR[((size_t)(l * 2 + 0) * 80 + n) * D + k] = (bf16)hi; WR[((size_t)(l * 2 + 1) * 80 + n) * D + k] = (bf16)lo; }
    }
    {
        const int gw = F.vcu * 8 + F.wave, NGW = F.G * 8, lane = F.lane;
        constexpr int I_A = 32 * 184, I_B = 32 * 64, I_L = I_A + I_B;
        for (int it = gw; it < NL * I_L; it += NGW) {
            const int l = it / I_L; int r = it % I_L; CvItem ci;
            if (r < I_A) {
                const int kb = r / 184, nb = r % 184, n0 = nb * 32; int src0, nv;
                if (n0 < 2304) { src0 = n0; nv = 32; } else if (n0 < 5632) { src0 = n0 + 16; nv = 32; } else if (n0 == 5632) { src0 = 2304; nv = 16; } else { src0 = 0; nv = 0; }
                ci.src = F.in[I_WIN] + ((size_t)l * D + kb * 64) * INW + src0; ci.ldsrc = INW; ci.nvalid = nv; ci.dst = (bf16*)(F.ws + WS_WIN) + ((size_t)l * PLD + n0) * D + kb * 64; ci.lddst = D;
            } else {
                r -= I_A; const int kb = r / 64, nb = r % 64;
                ci.src = F.in[I_WOUT] + ((size_t)l * D + kb * 64) * D + nb * 32; ci.ldsrc = D; ci.nvalid = 32; ci.dst = (bf16*)(F.ws + WS_WOUT) + ((size_t)l * D + nb * 32) * D + kb * 64; ci.lddst = D;
            }
            f32x4 v[8]; cv_load(ci, v, lane); cv_store(ci, v, lane);
        }
    }
}

template <int MODE>
DI void p_norm(Frame& F) {
    const int gw = F.vcu * 8 + F.wave, NGW = F.G * 8, lane = F.lane;
    const float* MOD = (const float*)(F.ws + WS_MOD);
    float* H = (float*)(F.ws + WS_H);
    bf16* U = (bf16*)(F.ws + WS_U);
    const bf16* Y2 = (const bf16*)(F.ws + WS_Y2);
    constexpr int L = (MODE == 1) ? 1 : 0;
    constexpr int LP = (MODE == 1) ? 0 : 1;
    if (MODE != 2) {
        const bf16* WRH = (const bf16*)(F.ws + WS_WR) + (size_t)(L * 2 + 0) * 80 * D; const bf16* WRL = (const bf16*)(F.ws + WS_WR) + (size_t)(L * 2 + 1) * 80 * D;
        for (int o = gw; o < NB * 72; o += NGW) { const int b = o / 72, n = o % 72; const float* sh = MOD + (size_t)(L * NB + b) * 6 * D + 3 * D; float a = 0.f;
#pragma unroll
            for (int j = 0; j < 4; ++j) { const int k = 8 * lane + 512 * j; const u32x4 wh = *(const u32x4*)(WRH + (size_t)n * D + k), wl = *(const u32x4*)(WRL + (size_t)n * D + k);
                const f32x4 s0 = *(const f32x4*)(sh + k), s1 = *(const f32x4*)(sh + k + 4);
                a += s0[0] * (bflo(wh.x) + bflo(wl.x)) + s0[1] * (bfhi(wh.x) + bfhi(wl.x)) + s0[2] * (bflo(wh.y) + bflo(wl.y)) + s0[3] * (bfhi(wh.y) + bfhi(wl.y))
                   + s1[0] * (bflo(wh.z) + bflo(wl.z)) + s1[1] * (bfhi(wh.z) + bfhi(wl.z)) + s1[2] * (bflo(wh.w) + bflo(wl.w)) + s1[3] * (bfhi(wh.w) + bfhi(wl.w)); }
            a = wave_sum(a);
            if (lane == 0) ((float*)(F.ws + WS_CB))[(L * NB + b) * 80 + n] = a + ((n < 8) ? PARP(I_RGB)[L * 8 + n] : PARP(I_REB)[L * 64 + n - 8]); }
    }
    for (int row0 = gw * 8; row0 < T; row0 += NGW * 8) {
        const int b = row0 / SEQ;
        f32x4 gs[8], sh[8], g2[8];
#pragma unroll
        for (int j = 0; j < 8; ++j) { const int idx = 4 * lane + 256 * j;
            if (MODE == 2) { gs[j] = *(const f32x4*)(PARP(I_FING) + idx); sh[j] = (f32x4){0.f, 0.f, 0.f, 0.f}; }
            else { const f32x4 g = *(const f32x4*)(PARP(I_N1G) + (size_t)L * D + idx), sc = *(const f32x4*)(MOD + (size_t)(L * NB + b) * 6 * D + D + idx);
                gs[j] = g * (sc + 1.0f); sh[j] = *(const f32x4*)(MOD + (size_t)(L * NB + b) * 6 * D + idx); }
            if (MODE != 0) g2[j] = *(const f32x4*)(MOD + (size_t)(LP * NB + b) * 6 * D + 5 * D + idx); }
        for (int rr = 0; rr < 8; ++rr) {
            const int r = row0 + rr;
            f32x4 x[8]; float ss = 0.f;
#pragma unroll
            for (int j = 0; j < 8; ++j) { const int idx = 4 * lane + 256 * j;
                if (MODE == 0) x[j] = __builtin_nontemporal_load((const f32x4*)(F.in[I_X] + (size_t)r * D + idx));
                else { x[j] = *(const f32x4*)(H + (size_t)r * D + idx);
                    const u32x2 y0 = __builtin_nontemporal_load((const u32x2*)(Y2 + (size_t)(2 * r) * D + idx)), y1 = __builtin_nontemporal_load((const u32x2*)(Y2 + (size_t)(2 * r + 1) * D + idx));
                    f32x4 y; y[0] = bflo(y0.x) + bflo(y1.x); y[1] = bfhi(y0.x) + bfhi(y1.x); y[2] = bflo(y0.y) + bflo(y1.y); y[3] = bfhi(y0.y) + bfhi(y1.y);
                    x[j] += g2[j] * y; }
                ss += (x[j][0] * x[j][0] + x[j][1] * x[j][1]) + (x[j][2] * x[j][2] + x[j][3] * x[j][3]); }
            const float rs = __builtin_amdgcn_rsqf(wave_sum(ss) * (1.0f / D) + EPS);
#pragma unroll
            for (int j = 0; j < 8; ++j) { const int idx = 4 * lane + 256 * j;
                if (MODE == 2) { __builtin_nontemporal_store(x[j] * rs * gs[j], (f32x4*)(F.out + (size_t)r * D + idx)); }
                else { if (MODE != 0) *(f32x4*)(H + (size_t)r * D + idx) = x[j];
                    const f32x4 u = x[j] * rs * gs[j] + sh[j]; u32x2 w; w.x = pk2(u[0], u[1]); w.y = pk2(u[2], u[3]);
                    *(u32x2*)(U + (size_t)r * D + idx) = w; } }
        }
    }
}

DI void p_norm2_router(Frame& F, int l) {
    const int tid = F.tid, lane = F.lane, w = F.wave;
    const float* MOD = (const float*)(F.ws + WS_MOD);
    float* H = (float*)(F.ws + WS_H);
    const float* HIN = (l == 0) ? F.in[I_X] : (const float*)(F.ws + WS_H);
    const bf16* DELTA = (const bf16*)(F.ws + WS_DELTA);
    bf16* U = (bf16*)(F.ws + WS_U);
    const bf16* WRH = (const bf16*)(F.ws + WS_WR) + (size_t)(l * 2 + 0) * 80 * D;
    const bf16* WRL = (const bf16*)(F.ws + WS_WR) + (size_t)(l * 2 + 1) * 80 * D;
    int* LIST = (int*)(F.ws + WS_LIST);
    float* WT = (float*)(F.ws + WS_WT);
    unsigned* CNT = F.ctl + CW_CNT + 64 * l + 128 * F.qset;
    LAS float* PART = (LAS float*)F.lds;
    LAS float* SSQ = (LAS float*)(F.lds + 81920);
    LAS float* CBP = (LAS float*)(F.lds + 83968);
    LAS float* CB = (LAS float*)(F.lds + 102400);
    LAS float* LG = (LAS float*)(F.lds + 102912);
    LAS float* RS = (LAS float*)(F.lds + 121344);
    LAS unsigned* HIST = (LAS unsigned*)(F.lds + 121600);
    LAS unsigned* BASE = (LAS unsigned*)(F.lds + 121856);
    const float* G2 = PARP(I_N2G) + (size_t)l * D;
    for (int step = blockIdx.x; step < T / 64; step += F.G) {
        const int row0 = step * 64, b = row0 / SEQ;
        const float* SC = MOD + (size_t)(l * NB + b) * 6 * D + 4 * D;
        const float* SH = MOD + (size_t)(l * NB + b) * 6 * D + 3 * D;
        if (tid < 64) HIST[tid] = 0u;
        if (tid < 72) CB[tid] = ((const float*)(F.ws + WS_CB))[(l * NB + b) * 80 + tid];
        { const int r = lane & 15, kg = lane >> 4;
          f32x4 acc[4][5]; float ssq[4] = {0.f, 0.f, 0.f, 0.f};
#pragma unroll
          for (int rb = 0; rb < 4; ++rb)
#pragma unroll
              for (int nb = 0; nb < 5; ++nb) acc[rb][nb] = (f32x4){0.f, 0.f, 0.f, 0.f};
          const size_t ho0 = (size_t)(row0 + r) * D + 256 * w + 8 * kg;
#pragma unroll 1
          for (int kk = 0; kk < 8; ++kk) {
              const int k = 256 * w + 32 * kk + 8 * kg;
              f32x4 gs0, gs1;
              { const f32x4 g0 = *(const f32x4*)(G2 + k), g1 = *(const f32x4*)(G2 + k + 4), c0 = *(const f32x4*)(SC + k), c1 = *(const f32x4*)(SC + k + 4); gs0 = g0 * (c0 + 1.0f); gs1 = g1 * (c1 + 1.0f); }
              bf16x8 bh[5], bl[5];
#pragma unroll
              for (int nb = 0; nb < 5; ++nb) { bh[nb] = *(const bf16x8*)(WRH + (size_t)(nb * 16 + r) * D + k); bl[nb] = *(const bf16x8*)(WRL + (size_t)(nb * 16 + r) * D + k); }
#pragma unroll
              for (int rb = 0; rb < 4; ++rb) {
                  const size_t ho = ho0 + (size_t)(16 * rb) * D + 32 * kk; const u32x4 dl = *(const u32x4*)(DELTA + ho);
                  f32x4 x0 = *(const f32x4*)(HIN + ho), x1 = *(const f32x4*)(HIN + ho + 4);
                  x0[0] += bflo(dl.x); x0[1] += bfhi(dl.x); x0[2] += bflo(dl.y); x0[3] += bfhi(dl.y); x1[0] += bflo(dl.z); x1[1] += bfhi(dl.z); x1[2] += bflo(dl.w); x1[3] += bfhi(dl.w);
                  *(f32x4*)(H + ho) = x0; *(f32x4*)(H + ho + 4) = x1;
                  ssq[rb] += (x0[0] * x0[0] + x0[1] * x0[1]) + (x0[2] * x0[2] + x0[3] * x0[3]) + (x1[0] * x1[0] + x1[1] * x1[1]) + (x1[2] * x1[2] + x1[3] * x1[3]);
                  const f32x4 v0 = x0 * gs0, v1 = x1 * gs1;
                  u32x4 hi, lo;
                  hi.x = pk2(v0[0], v0[1]); hi.y = pk2(v0[2], v0[3]); hi.z = pk2(v1[0], v1[1]); hi.w = pk2(v1[2], v1[3]);
                  lo.x = pk2(v0[0] - bflo(hi.x), v0[1] - bfhi(hi.x)); lo.y = pk2(v0[2] - bflo(hi.y), v0[3] - bfhi(hi.y)); lo.z = pk2(v1[0] - bflo(hi.z), v1[1] - bfhi(hi.z)); lo.w = pk2(v1[2] - bflo(hi.w), v1[3] - bfhi(hi.w));
                  const bf16x8 ah = __builtin_bit_cast(bf16x8, hi), al = __builtin_bit_cast(bf16x8, lo);
#pragma unroll
                  for (int nb = 0; nb < 5; ++nb) {
                      acc[rb][nb] = __builtin_amdgcn_mfma_f32_16x16x32_bf16(ah, bh[nb], acc[rb][nb], 0, 0, 0);
                      acc[rb][nb] = __builtin_amdgcn_mfma_f32_16x16x32_bf16(ah, bl[nb], acc[rb][nb], 0, 0, 0);
                      acc[rb][nb] = __builtin_amdgcn_mfma_f32_16x16x32_bf16(al, bh[nb], acc[rb][nb], 0, 0, 0); } } }
#pragma unroll
          for (int rb = 0; rb < 4; ++rb) { float s = ssq[rb]; s += __shfl_xor(s, 16); s += __shfl_xor(s, 32); if (kg == 0) SSQ[w * 64 + 16 * rb + r] = s; }
          if (w >= 4) {
#pragma unroll
              for (int rb = 0; rb < 4; ++rb)
#pragma unroll
                  for (int nb = 0; nb < 5; ++nb)
#pragma unroll
                      for (int j = 0; j < 4; ++j) PART[((w - 4) * 64 + 16 * rb + 4 * kg + j) * 80 + nb * 16 + r] = acc[rb][nb][j]; }
          __syncthreads();
          if (w < 4) {
#pragma unroll
              for (int rb = 0; rb < 4; ++rb)
#pragma unroll
                  for (int nb = 0; nb < 5; ++nb)
#pragma unroll
                      for (int j = 0; j < 4; ++j) { const int pi = (w * 64 + 16 * rb + 4 * kg + j) * 80 + nb * 16 + r; PART[pi] += acc[rb][nb][j]; } } }
        __syncthreads();
        for (int idx = tid; idx < 64 * 72; idx += 512) { const int row = idx / 72, n = idx % 72;
            float s = 0.f, ss = 0.f;
#pragma unroll
            for (int q = 0; q < 4; ++q) s += PART[(q * 64 + row) * 80 + n];
#pragma unroll
            for (int q = 0; q < 8; ++q) ss += SSQ[q * 64 + row];
            const float rs = __builtin_amdgcn_rsqf(ss * (1.0f / D) + EPS);
            LG[row * 72 + n] = rs * s + CB[n]; if (n == 0) RS[row] = rs; }
        __syncthreads();
        int e0 = 0, e1 = 0; unsigned rk0 = 0, rk1 = 0; float wt0 = 0.f, wt1 = 0.f;
        if (tid < 64) {
            const LAS float* lg = LG + tid * 72;
            int gi = 0; float gm = lg[0];
#pragma unroll
            for (int j = 1; j < 8; ++j) if (lg[j] > gm) { gm = lg[j]; gi = j; }
            float gsum = 0.f;
#pragma unroll
            for (int j = 0; j < 8; ++j) gsum += __expf(lg[j] - gm);
            const float gw = 1.0f / gsum;
            const LAS float* el = lg + 8 + gi * 8;
            int i0 = 0; float v0 = el[0];
#pragma unroll
            for (int j = 1; j < 8; ++j) if (el[j] > v0) { v0 = el[j]; i0 = j; }
            int i1 = -1; float v1 = -3.0e38f;
#pragma unroll
            for (int j = 0; j < 8; ++j) if (j != i0 && el[j] > v1) { v1 = el[j]; i1 = j; }
            const float ex = __expf(v1 - v0), w0 = 1.0f / (1.0f + ex), w1 = ex * w0;
            e0 = gi * 8 + i0; e1 = gi * 8 + i1; wt0 = gw * w0; wt1 = gw * w1;
            rk0 = __hip_atomic_fetch_add(HIST + e0, 1u, __ATOMIC_RELAXED, __HIP_MEMORY_SCOPE_WORKGROUP); rk1 = __hip_atomic_fetch_add(HIST + e1, 1u, __ATOMIC_RELAXED, __HIP_MEMORY_SCOPE_WORKGROUP);
        }
        __syncthreads();
        if (tid < 64) { int tt = tid; asm volatile("" : "+v"(tt)); const unsigned n = HIST[tt]; BASE[tt] = n ? atomicAdd(CNT + tt, n) : 0u; }
        __syncthreads();
        if (tid < 64) { const int tok = row0 + tid;
            LIST[e0 * 16384 + BASE[e0] + rk0] = tok * 2; LIST[e1 * 16384 + BASE[e1] + rk1] = tok * 2 + 1;
            WT[tok * 2] = wt0; WT[tok * 2 + 1] = wt1; }
        { f32x4 gs[8], sh[8];
#pragma unroll
          for (int j = 0; j < 8; ++j) { const int idx = 4 * lane + 256 * j; gs[j] = *(const f32x4*)(G2 + idx) * (*(const f32x4*)(SC + idx) + 1.0f); sh[j] = *(const f32x4*)(SH + idx); }
          for (int i = 0; i < 8; ++i) { const int rl = 8 * w + i; const float rs = RS[rl];
#pragma unroll
              for (int j = 0; j < 8; ++j) { const int idx = 4 * lane + 256 * j; const f32x4 x = *(const f32x4*)(H + (size_t)(row0 + rl) * D + idx);
                  const f32x4 u = x * rs * gs[j] + sh[j]; u32x2 wv; wv.x = pk2(u[0], u[1]); wv.y = pk2(u[2], u[3]);
                  *(u32x2*)(U + (size_t)(row0 + rl) * D + idx) = wv; } } }
        __syncthreads();
    }
}

DI int moe_tiles(Frame& F, int l) {
    LAS int* TE = (LAS int*)(F.lds + TILETAB_OFF); LAS int* TL = TE + 192; LAS int* CN = TE + 384;
    __syncthreads();
    if (F.tid < 64) CN[F.tid] = (int)__hip_atomic_load(F.ctl + CW_CNT + 64 * l + 128 * F.qset + F.tid, __ATOMIC_RELAXED, __HIP_MEMORY_SCOPE_AGENT);
    __syncthreads();
    if (F.tid == 0) { int nt = 0; for (int e = 0; e < 64; ++e) { const int n = (CN[e] + 255) >> 8; for (int j = 0; j < n && nt < 192; ++j) { TE[nt] = e; TL[nt] = j; ++nt; } } CN[64] = nt; }
    __syncthreads();
    return CN[64];
}


DI unsigned offb(unsigned row, unsigned ch) { return 256u * row + 16u * (ch ^ (((row & 3u) << 2) | ((row >> 2) & 3u))); }
DI int swap23(int r) { return (r & ~12) | ((r & 4) << 1) | ((r & 8) >> 1); }
DI int t5_bucket(int rel) {
    const int ret = rel > 0 ? 16 : 0; const int n = rel < 0 ? -rel : rel;
    if (n < 8) return ret + n;
    const float v = logf((float)n * 0.125f) / 2.7725887f * 8.0f;
    int large = 8 + (int)(v + 1e-5f); if (large > 15) large = 15;
    return ret + large;
}
DI int dequeue(Frame& F, unsigned* q) {
    __syncthreads();
    if (F.tid == 0) F.MISC[2] = atomicAdd(q, 1u);
    __syncthreads();
    return (int)F.MISC[2];
}
DI s16x4 tr_read(const LAS unsigned char* p) { return __builtin_bit_cast(s16x4, __builtin_amdgcn_ds_read_tr16_b64_v4i16((LAS s16x4*)p)); }
DI bf16x8 cat8(s16x4 lo, s16x4 hi) { return __builtin_shufflevector(lo, hi, 0, 1, 2, 3, 4, 5, 6, 7); }
DI bf16x8 pack8(float a0, float a1, float a2, float a3, float a4, float a5, float a6, float a7) { u32x4 p; p.x = pk2(a0, a1); p.y = pk2(a2, a3); p.z = pk2(a4, a5); p.w = pk2(a6, a7); return __builtin_bit_cast(bf16x8, p); }
#define MFMA32(a, b, c) __builtin_amdgcn_mfma_f32_32x32x16_bf16((a), (b), (c), 0, 0, 0)
DI float vmax(float a, float b) { float r; asm("v_max_f32 %0, %1, %2" : "=v"(r) : "v"(a), "v"(b)); return r; }
DI float vmax3(float a, float b, float c) { float r; asm("v_max3_f32 %0, %1, %2, %3" : "=v"(r) : "v"(a), "v"(b), "v"(c)); return r; }

DI void attn_unit(Frame& F, int l, int b, int hh, int qb, float lam, float cfin) {
    int tid = F.tid, lane = F.lane; const int w = F.wave;
    asm volatile("" : "+v"(tid), "+v"(lane));
    const int map = w >> 2, wq = w & 3;
    const bf16* PROJ = (const bf16*)(F.ws + WS_PROJ);
    bf16* MIX = (bf16*)(F.ws + WS_MIX);
    LAS unsigned char* lds = F.lds;
    constexpr int TABOFF = 98304;
    LAS float* TAB2 = (LAS float*)(lds + TABOFF);
    const int tokbase = b * SEQ;
    const int q0 = qb * 128 + wq * 32, cq = q0 >> 6, ntiles = 2 * qb + 2;
    if (tid < 255) TAB2[tid] = PARP(I_RELB)[t5_bucket(tid - 191) * 6 + hh] * LOG2E;
    LAS float* SGL = (LAS float*)(lds + TABOFF + 1024);
    if (tid >= 256 && tid < 384) SGL[tid - 256] = PARP(I_DSUB)[l * 128 + tid - 256];
    const float far2 = PARP(I_RELB)[15 * 6 + hh] * LOG2E;
    const int h_ = lane >> 5, blk = (lane >> 4) & 1, qq = (lane & 15) >> 2, pp = lane & 3;
    bf16x8 Qf[4];
    { const bf16* qp = PROJ + (size_t)(tokbase + q0 + (lane & 31)) * PLD + C_DQ + hh * 128 + map * 64 + 8 * h_;
#pragma unroll
      for (int s = 0; s < 4; ++s) Qf[s] = *(const bf16x8*)(qp + 16 * s); }
    unsigned srcK[2], srcV[2];
#pragma unroll
    for (int pi = 0; pi < 2; ++pi) { const int p = 2 * w + pi, row = 4 * p + (lane >> 4), pc = lane & 15, ch = pc ^ (((row & 3) << 2) | ((row >> 2) & 3));
        srcK[pi] = (unsigned)((tokbase + row) * PLD + C_DK + hh * 128 + 8 * ch);
        srcV[pi] = (unsigned)((tokbase + swap23(row)) * PLD + C_DV + hh * 128 + 8 * ch); }
#define ATT_STAGE(kt) do { const unsigned ko = (unsigned)(kt) * 64u * PLD; const int st_ = ((kt) % 3) * 32768; _Pragma("unroll") for (int pi = 0; pi < 2; ++pi) { \
        __builtin_amdgcn_global_load_lds((const unsigned*)(PROJ + (size_t)(srcK[pi] + ko)), (LAS unsigned*)(lds + st_ + (2 * w + pi) * 1024), 16, 0, 0); \
        __builtin_amdgcn_global_load_lds((const unsigned*)(PROJ + (size_t)(srcV[pi] + ko)), (LAS unsigned*)(lds + st_ + 16384 + (2 * w + pi) * 1024), 16, 0, 0); } } while (0)
    unsigned kad[4], vad[2][4];
#pragma unroll
    for (int s = 0; s < 4; ++s) kad[s] = offb(lane & 31, 8 * map + 2 * s + h_);
#pragma unroll
    for (int t = 0; t < 2; ++t)
#pragma unroll
        for (int c = 0; c < 4; ++c) vad[t][c] = offb(8 * h_ + 4 * t + qq, 4 * c + 2 * blk + (pp >> 1)) + 8 * (pp & 1);
    f32x16 O[4];
#pragma unroll
    for (int c = 0; c < 4; ++c)
#pragma unroll
        for (int r = 0; r < 16; ++r) O[c][r] = 0.f;
    float m = -1.0e30f, lsum = 0.f;
    constexpr float C1 = 0.125f * LOG2E, THR = 8.0f;
    f32x16 S0, S1;
    bf16x8 Pf[4];
#define ATT_QK(kt) do { const LAS unsigned char* Kb = lds + ((kt) % 3) * 32768; \
        const LAS unsigned char* kp[4]; _Pragma("unroll") for (int s4 = 0; s4 < 4; ++s4) { kp[s4] = Kb + kad[s4]; asm volatile("" : "+v"(kp[s4])); } \
        _Pragma("unroll") for (int r = 0; r < 16; ++r) { S0[r] = 0.f; S1[r] = 0.f; } \
        bf16x8 kf[4][2]; _Pragma("unroll") for (int s4 = 0; s4 < 4; ++s4) { kf[s4][0] = *(const LAS bf16x8*)(kp[s4]); kf[s4][1] = *(const LAS bf16x8*)(kp[s4] + 8192); } \
        _Pragma("unroll") for (int s4 = 0; s4 < 4; ++s4) { S0 = MFMA32(kf[s4][0], Qf[s4], S0); S1 = MFMA32(kf[s4][1], Qf[s4], S1); } } while (0)
#define ATT_PV(kt) do { const LAS unsigned char* Vb = lds + ((kt) % 3) * 32768 + 16384; \
        _Pragma("unroll") for (int c2 = 0; c2 < 4; c2 += 2) { bf16x8 vf[2][4]; \
            _Pragma("unroll") for (int cc = 0; cc < 2; ++cc) { const LAS unsigned char* vp0 = Vb + vad[0][c2 + cc]; const LAS unsigned char* vp1 = Vb + vad[1][c2 + cc]; asm volatile("" : "+v"(vp0), "+v"(vp1)); \
                _Pragma("unroll") for (int ks = 0; ks < 4; ++ks) vf[cc][ks] = cat8(tr_read(vp0 + 4096 * ks), tr_read(vp1 + 4096 * ks)); } \
            _Pragma("unroll") for (int cc = 0; cc < 2; ++cc) _Pragma("unroll") for (int ks = 0; ks < 4; ++ks) O[c2 + cc] = MFMA32(vf[cc][ks], Pf[ks], O[c2 + cc]); } } while (0)
#define ATT_SM(kt, PN) do { \
        const bool nearT = (kt) >= cq - 2; float mx; \
        if (nearT) { const int idx0 = 64 * (kt) - q0 - (lane & 31) + 4 * h_ + 191; \
            _Pragma("unroll") for (int r = 0; r < 16; ++r) { const int cr = (r & 3) + 8 * (r >> 2); S0[r] = S0[r] * C1 + TAB2[idx0 + cr]; S1[r] = S1[r] * C1 + TAB2[idx0 + 32 + cr]; } } \
        mx = vmax(S0[0], S1[0]); \
        _Pragma("unroll") for (int r = 1; r < 16; ++r) mx = vmax3(mx, S0[r], S1[r]); \
        if (!nearT) mx = mx * C1 + far2; \
        mx = vmax(mx, __shfl_xor(mx, 32)); \
        float alpha = 1.0f; const bool resc = __any(mx > m + THR); \
        if (resc) { const float mn = vmax(m, mx); alpha = __builtin_amdgcn_exp2f(m - mn); m = mn; } \
        float rsum = 0.f; \
        if (nearT) { _Pragma("unroll") for (int r = 0; r < 16; ++r) { S0[r] = __builtin_amdgcn_exp2f(S0[r] - m); S1[r] = __builtin_amdgcn_exp2f(S1[r] - m); rsum += S0[r] + S1[r]; } } \
        else { const float nb = far2 - m; _Pragma("unroll") for (int r = 0; r < 16; ++r) { S0[r] = __builtin_amdgcn_exp2f(__builtin_fmaf(S0[r], C1, nb)); S1[r] = __builtin_amdgcn_exp2f(__builtin_fmaf(S1[r], C1, nb)); rsum += S0[r] + S1[r]; } } \
        PN[0] = pack8(S0[0], S0[1], S0[2], S0[3], S0[4], S0[5], S0[6], S0[7]); PN[1] = pack8(S0[8], S0[9], S0[10], S0[11], S0[12], S0[13], S0[14], S0[15]); \
        PN[2] = pack8(S1[0], S1[1], S1[2], S1[3], S1[4], S1[5], S1[6], S1[7]); PN[3] = pack8(S1[8], S1[9], S1[10], S1[11], S1[12], S1[13], S1[14], S1[15]); \
        lsum = lsum * alpha + rsum; \
        if (resc) { _Pragma("unroll") for (int c = 0; c < 4; ++c) _Pragma("unroll") for (int r = 0; r < 16; ++r) O[c][r] *= alpha; } } while (0)
    ATT_STAGE(0); ATT_STAGE(1);
    asm volatile("s_waitcnt vmcnt(4)" ::: "memory"); LBAR();
    for (int kt = 0; kt < ntiles; ++kt) {
        const bool more = kt + 2 < ntiles;
        if (more) ATT_STAGE(kt + 2);
        if (kt <= cq) { ATT_QK(kt); ATT_SM(kt, Pf); ATT_PV(kt); }
        if (more) asm volatile("s_waitcnt vmcnt(4)" ::: "memory"); else asm volatile("s_waitcnt vmcnt(0)" ::: "memory");
        LBAR();
    }
#undef ATT_STAGE
#undef ATT_QK
#undef ATT_PV
#undef ATT_SM
    const float ltot = lsum + __shfl_xor(lsum, 32), inv = 1.0f / ltot;
    LAS float* COMB = (LAS float*)lds;
    if (map == 1) {
#pragma unroll
        for (int c = 0; c < 4; ++c)
#pragma unroll
            for (int r = 0; r < 16; ++r) COMB[(wq * 64 + c * 16 + r) * 64 + lane] = O[c][r] * inv;
    }
    __syncthreads();
    if (map == 0) {
        float ss = 0.f;
#pragma unroll
        for (int c = 0; c < 4; ++c)
#pragma unroll
            for (int r = 0; r < 16; ++r) { const float o = O[c][r] * inv - lam * COMB[(wq * 64 + c * 16 + r) * 64 + lane]; O[c][r] = o; ss += o * o; }
        ss += __shfl_xor(ss, 32);
        const float rms = cfin * __builtin_amdgcn_rsqf(ss * (1.0f / 128.0f) + EPS);
        bf16* op = MIX + (size_t)(tokbase + q0 + (lane & 31)) * D + 1280 + hh * 128 + 4 * h_;
        const LAS float* sg = SGL + 4 * h_;
#pragma unroll
        for (int c = 0; c < 4; ++c)
#pragma unroll
            for (int g = 0; g < 4; ++g) { const f32x4 gv = *(const LAS f32x4*)(sg + 32 * c + 8 * g);
                u32x2 wv; wv.x = pk2(O[c][4 * g] * rms * gv[0], O[c][4 * g + 1] * rms * gv[1]); wv.y = pk2(O[c][4 * g + 2] * rms * gv[2], O[c][4 * g + 3] * rms * gv[3]);
                *(u32x2*)(op + 32 * c + 8 * g) = wv; }
    }
    __syncthreads();
}

constexpr int GL_G = 0, GL_QN = 16384, GL_KF = 25600, GL_KN = 34816, GL_OP = 0, GL_QF = 44032, GL_KD = 53248, GL_AM = 62464, GL_VV = 71680, GL_SS = 89088, GL_ALR = 106496, GL_DEC = 110592, GL_SEG = 110848, GL_GL = 112896, GL_GNG = 113664, GL_ALRB = 134144, GL_WA2H = 108544, GL_WA2L = 114688, GL_Z = 116736;
DI void gla_unit(Frame& F, int l, int b, int hh) {
    const int tid = F.tid, lane = F.lane, w = F.wave;
    const bf16* PROJ = (const bf16*)(F.ws + WS_PROJ);
    bf16* MIX = (bf16*)(F.ws + WS_MIX);
    LAS unsigned char* lds = F.lds;
    LAS float* G = (LAS float*)(lds + GL_G); LAS float* OP = (LAS float*)(lds + GL_OP); LAS float* ALR = (LAS float*)(lds + GL_ALR);
    LAS float* DEC = (LAS float*)(lds + GL_DEC); LAS float* SEG = (LAS float*)(lds + GL_SEG); LAS float* GLL = (LAS float*)(lds + GL_GL);
    const int tokbase = b * SEQ;
    const int ta = tid >> 3, dg = tid & 7;
    const int cd = tid & 63, seg = tid >> 6;
    const int h_ = lane >> 5, blk = (lane >> 4) & 1, qq = (lane & 15) >> 2, pp = lane & 3;
    for (int i = tid; i < 1024; i += 512) { const int ch = i >> 4, r = i & 15; const float wv = PARP(I_GWA2)[((size_t)l * 16 + r) * 384 + hh * 64 + ch];
        const unsigned hi = pk2(wv, 0.f) & 0xffffu; const float res = wv - __uint_as_float(hi << 16);
        *(LAS bf16*)(lds + GL_WA2H + i * 2) = (bf16)hi; *(LAS bf16*)(lds + GL_WA2L + i * 2) = (bf16)(pk2(res, 0.f) & 0xffffu); }
    LAS float* Zf = (LAS float*)(lds + GL_Z);
    const int t2 = tid - 256;
    const bool a_lane = t2 >= 0 && t2 < 128;
#define GLA_ZSTAGE() do { if (w < 4) { const int tb_ = w >> 1, cb_ = w & 1; f32x16 z_; _Pragma("unroll") for (int r = 0; r < 16; ++r) z_[r] = 0.f; \
        const bf16x8 bA_ = *(const LAS bf16x8*)(lds + GL_ALRB + (32 * tb_ + (lane & 31)) * 32 + 16 * h_); \
        z_ = MFMA32(*(const LAS bf16x8*)(lds + GL_WA2H + (32 * cb_ + (lane & 31)) * 32 + 16 * h_), bA_, z_); \
        z_ = MFMA32(*(const LAS bf16x8*)(lds + GL_WA2L + (32 * cb_ + (lane & 31)) * 32 + 16 * h_), bA_, z_); \
        _Pragma("unroll") for (int g = 0; g < 4; ++g) *(LAS f32x4*)(Zf + (32 * tb_ + (lane & 31)) * 68 + 32 * cb_ + 8 * g + 4 * h_) = (f32x4){z_[4 * g], z_[4 * g + 1], z_[4 * g + 2], z_[4 * g + 3]}; } } while (0)
    LAS float* GNL = (LAS float*)(lds + GL_GNG);
    if (tid < 128) GNL[tid] = PARP(I_GNG)[l * 768 + hh * 128 + tid];
    const float ba = PARP(I_GBA)[l * 384 + hh * 64 + cd];
    f32x16 Sacc;
#pragma unroll
    for (int r = 0; r < 16; ++r) Sacc[r] = 0.f;
    const int sdb = w >> 2, svb = w & 3;
    for (int i = tid; i < 128 * 144 / 4; i += 512) ((LAS unsigned*)(lds + GL_SS))[i] = 0u;
    u32x4 nq, nk, nv0, nv1, nog0, nog1, na;
    {
        const bf16* rp = PROJ + (size_t)(tokbase + ta) * PLD;
        nq = *(const u32x4*)(rp + C_GQ + hh * 64 + 8 * dg); nk = *(const u32x4*)(rp + C_GK + hh * 64 + 8 * dg);
        nv0 = *(const u32x4*)(rp + C_GV + hh * 128 + 16 * dg); nv1 = *(const u32x4*)(rp + C_GV + hh * 128 + 16 * dg + 8);
        nog0 = *(const u32x4*)(rp + C_GOG + hh * 128 + 16 * dg); nog1 = *(const u32x4*)(rp + C_GOG + hh * 128 + 16 * dg + 8);
        na = a_lane ? *(const u32x4*)(PROJ + (size_t)(tokbase + (t2 >> 1)) * PLD + C_GA + 8 * (t2 & 1)) : (u32x4){0u, 0u, 0u, 0u};
    }
#define GLA_ALR_WRITE() do { if (a_lane) *(LAS u32x4*)(lds + GL_ALRB + t2 * 16) = na; } while (0)
    GLA_ALR_WRITE();
    LBAR();
    GLA_ZSTAGE();
    LBAR();
    for (int n = 0; n < 32; ++n) {
        const int tok0 = tokbase + 64 * n;
        const u32x4 cq_ = nq, ck_ = nk, cv0 = nv0, cv1 = nv1;
        float g8[8]; float run = 0.f;
#pragma unroll
        for (int tt = 0; tt < 8; ++tt) { const float x = ba + Zf[(8 * seg + tt) * 68 + cd];
            const float ls = fminf(x, 0.f) - __logf(1.0f + __expf(-fabsf(x)));
            run += ls * (1.0f / 16.0f); g8[tt] = run; }
        SEG[seg * 64 + cd] = run;
        LBAR();
        { float off = 0.f;
#pragma unroll
          for (int s2 = 0; s2 < 8; ++s2) off += (s2 < seg) ? SEG[s2 * 64 + cd] : 0.f;
#pragma unroll
          for (int tt = 0; tt < 8; ++tt) G[(8 * seg + tt) * 64 + cd] = g8[tt] + off;
          if (seg == 7) DEC[cd] = __expf(g8[7] + off); }
        if (n + 1 < 32) { const bf16* rp = PROJ + (size_t)(tok0 + 64 + ta) * PLD;
            nq = *(const u32x4*)(rp + C_GQ + hh * 64 + 8 * dg); nk = *(const u32x4*)(rp + C_GK + hh * 64 + 8 * dg);
            nv0 = *(const u32x4*)(rp + C_GV + hh * 128 + 16 * dg); nv1 = *(const u32x4*)(rp + C_GV + hh * 128 + 16 * dg + 8);
            if (a_lane) na = *(const u32x4*)(PROJ + (size_t)(tok0 + 64 + (t2 >> 1)) * PLD + C_GA + 8 * (t2 & 1)); }
        LBAR();
        {
            const float qv[8] = {bflo(cq_.x), bfhi(cq_.x), bflo(cq_.y), bfhi(cq_.y), bflo(cq_.z), bfhi(cq_.z), bflo(cq_.w), bfhi(cq_.w)};
            const float kv[8] = {bflo(ck_.x), bfhi(ck_.x), bflo(ck_.y), bfhi(ck_.y), bflo(ck_.z), bfhi(ck_.z), bflo(ck_.w), bfhi(ck_.w)};
            float qf[8], qn[8], kf[8], kn[8], kd[8];
#pragma unroll
            for (int j = 0; j < 8; ++j) { const float g = G[ta * 64 + 8 * dg + j]; const float eg = __expf(g), eng = __expf(-g), ed = DEC[8 * dg + j] * eng;
                qf[j] = qv[j] * 0.125f * eg; qn[j] = qv[j] * 0.125f * eng; kf[j] = kv[j] * eg; kn[j] = kv[j] * eng; kd[j] = kv[j] * ed; }
            const int to = ta * 144 + 16 * dg;
            *(LAS bf16x8*)(lds + GL_QF + to) = pack8(qf[0], qf[1], qf[2], qf[3], qf[4], qf[5], qf[6], qf[7]);
            *(LAS bf16x8*)(lds + GL_QN + to) = pack8(qn[0], qn[1], qn[2], qn[3], qn[4], qn[5], qn[6], qn[7]);
            *(LAS bf16x8*)(lds + GL_KF + to) = pack8(kf[0], kf[1], kf[2], kf[3], kf[4], kf[5], kf[6], kf[7]);
            *(LAS bf16x8*)(lds + GL_KN + to) = pack8(kn[0], kn[1], kn[2], kn[3], kn[4], kn[5], kn[6], kn[7]);
            *(LAS bf16x8*)(lds + GL_KD + to) = pack8(kd[0], kd[1], kd[2], kd[3], kd[4], kd[5], kd[6], kd[7]);
            *(LAS u32x4*)(lds + GL_VV + ta * 272 + 32 * dg) = cv0; *(LAS u32x4*)(lds + GL_VV + ta * 272 + 32 * dg + 16) = cv1;
        }
        LBAR();
        if (w < 4) {
            const int ib = w >> 1, jb = w & 1;
            f32x16 cf, cb_;
#pragma unroll
            for (int r = 0; r < 16; ++r) { cf[r] = 0.f; cb_[r] = 0.f; }
            const int ra = (32 * jb + (lane & 31)) * 144 + 16 * h_, rb = (32 * ib + (lane & 31)) * 144 + 16 * h_;
            if (jb <= ib) {
#pragma unroll
                for (int s = 0; s < 4; ++s) cf = MFMA32(*(const LAS bf16x8*)(lds + GL_KN + ra + 32 * s), *(const LAS bf16x8*)(lds + GL_QF + rb + 32 * s), cf); }
            if (jb >= ib) {
#pragma unroll
                for (int s = 0; s < 4; ++s) cb_ = MFMA32(*(const LAS bf16x8*)(lds + GL_KF + ra + 32 * s), *(const LAS bf16x8*)(lds + GL_QN + rb + 32 * s), cb_); }
            const int i_ = 32 * ib + (lane & 31);
#pragma unroll
            for (int g = 0; g < 4; ++g) { float v[4];
#pragma unroll
                for (int j = 0; j < 4; ++j) { const int jj = 32 * jb + 8 * g + 4 * h_ + j; v[j] = (jj <= i_) ? cf[4 * g + j] : cb_[4 * g + j]; }
                u32x2 wv; wv.x = pk2(v[0], v[1]); wv.y = pk2(v[2], v[3]);
                *(LAS u32x2*)(lds + GL_AM + i_ * 144 + (32 * jb + 8 * g + 4 * h_) * 2) = wv; }
        } else { GLA_ALR_WRITE(); }
        LBAR();
        {
            const int ib = w >> 2, vb = w & 3;
            bf16x8 vvf[4];
#pragma unroll
            for (int ks = 0; ks < 4; ++ks) { const LAS unsigned char* p0 = lds + GL_VV + (16 * ks + 8 * h_ + qq) * 272 + (32 * vb + 16 * blk + 4 * pp) * 2; vvf[ks] = cat8(tr_read(p0), tr_read(p0 + 4 * 272)); }
            f32x16 o;
#pragma unroll
            for (int r = 0; r < 16; ++r) o[r] = 0.f;
            const int ra = (32 * ib + (lane & 31)) * 144 + 16 * h_;
#pragma unroll
            for (int ks = 0; ks < 4; ++ks) o = MFMA32(*(const LAS bf16x8*)(lds + GL_AM + ra + 32 * ks), vvf[ks], o);
#pragma unroll
            for (int ks = 0; ks < 4; ++ks) o = MFMA32(*(const LAS bf16x8*)(lds + GL_QF + ra + 32 * ks), *(const LAS bf16x8*)(lds + GL_SS + (32 * vb + (lane & 31)) * 144 + 16 * h_ + 32 * ks), o);
#pragma unroll
            for (int r = 0; r < 16; ++r) Sacc[r] *= DEC[32 * sdb + (r & 3) + 8 * (r >> 2) + 4 * h_];
#pragma unroll
            for (int ks = 0; ks < 4; ++ks) { const LAS unsigned char* p0 = lds + GL_KD + (16 * ks + 8 * h_ + qq) * 144 + (32 * sdb + 16 * blk + 4 * pp) * 2;
                Sacc = MFMA32(cat8(tr_read(p0), tr_read(p0 + 4 * 144)), vvf[ks], Sacc); }
            GLA_ZSTAGE();
            LBAR();
#pragma unroll
            for (int r = 0; r < 16; ++r) { const int rr = (r & 3) + 8 * (r >> 2) + 4 * h_;
                OP[(32 * ib + rr) * 132 + 32 * vb + (lane & 31)] = o[r]; }
#pragma unroll
            for (int g = 0; g < 4; ++g) { u32x2 sv; sv.x = pk2(Sacc[4 * g], Sacc[4 * g + 1]); sv.y = pk2(Sacc[4 * g + 2], Sacc[4 * g + 3]);
                *(LAS u32x2*)(lds + GL_SS + (32 * svb + (lane & 31)) * 144 + (32 * sdb + 8 * g + 4 * h_) * 2) = sv; }
        }
        LBAR();
        {
            f32x4 ov[4]; float ss = 0.f;
#pragma unroll
            for (int j = 0; j < 4; ++j) { ov[j] = *(const LAS f32x4*)(OP + ta * 132 + 16 * dg + 4 * j); ss += (ov[j][0] * ov[j][0] + ov[j][1] * ov[j][1]) + (ov[j][2] * ov[j][2] + ov[j][3] * ov[j][3]); }
            ss += __shfl_xor(ss, 1); ss += __shfl_xor(ss, 2); ss += __shfl_xor(ss, 4);
            const float rms = __builtin_amdgcn_rsqf(ss * (1.0f / 128.0f) + EPS);
            const LAS float* ng = GNL + 16 * dg;
            const unsigned ogw[8] = {nog0.x, nog0.y, nog0.z, nog0.w, nog1.x, nog1.y, nog1.z, nog1.w};
            unsigned ow[8];
#pragma unroll
            for (int j = 0; j < 4; ++j) { const f32x4 gv = *(const LAS f32x4*)(ng + 4 * j);
                const float a0 = ov[j][0] * rms * gv[0] * fsilu(bflo(ogw[2 * j])), a1 = ov[j][1] * rms * gv[1] * fsilu(bfhi(ogw[2 * j]));
                const float a2 = ov[j][2] * rms * gv[2] * fsilu(bflo(ogw[2 * j + 1])), a3 = ov[j][3] * rms * gv[3] * fsilu(bfhi(ogw[2 * j + 1]));
                ow[2 * j] = pk2(a0, a1); ow[2 * j + 1] = pk2(a2, a3); }
            bf16* op = MIX + (size_t)(tok0 + ta) * D + hh * 128 + 16 * dg;
            *(u32x4*)op = (u32x4){ow[0], ow[1], ow[2], ow[3]}; *(u32x4*)(op + 8) = (u32x4){ow[4], ow[5], ow[6], ow[7]};
            if (n + 1 < 32) { const bf16* rp = PROJ + (size_t)(tok0 + 64 + ta) * PLD;
                nog0 = *(const u32x4*)(rp + C_GOG + hh * 128 + 16 * dg); nog1 = *(const u32x4*)(rp + C_GOG + hh * 128 + 16 * dg + 8); }
        }
        LBAR();
    }
}

constexpr int LR_XR = 0, LR_XC = 17408, LR_XCB = 33792, LR_WAB = 43008, LR_WXB = 52224, LR_RI = 61440, LR_SP = 95232, LR_SH = 97280, LR_HC = 99328;
#undef GLA_ALR_WRITE
#undef GLA_ZSTAGE
DI void lru_unit(Frame& F, int l, int b, int nb) {
    const int tid = F.tid, lane = F.lane, w = F.wave;
    const bf16* PROJ = (const bf16*)(F.ws + WS_PROJ);
    bf16* MIX = (bf16*)(F.ws + WS_MIX);
    LAS unsigned char* lds = F.lds;
    LAS float* XR = (LAS float*)(lds + LR_XR); LAS float* XC = (LAS float*)(lds + LR_XC); LAS float* RI = (LAS float*)(lds + LR_RI);
    LAS float* SP = (LAS float*)(lds + LR_SP); LAS float* SH = (LAS float*)(lds + LR_SH); LAS float* HC = (LAS float*)(lds + LR_HC);
    const int tokbase = b * SEQ, ch0 = nb * 64;
    const int ta = tid >> 3, cg = tid & 7;
    const int cc = tid & 63, seg = tid >> 6;
    const int h_ = lane >> 5, blk = (lane >> 4) & 1, qq = (lane & 15) >> 2, pp = lane & 3;
    float cw[4][8], cb[8];
#pragma unroll
    for (int j = 0; j < 8; ++j) { cb[j] = PARP(I_LCB)[l * 512 + ch0 + 8 * cg + j];
#pragma unroll
        for (int i = 0; i < 4; ++i) cw[i][j] = PARP(I_LCW)[((size_t)l * 4 + i) * 512 + ch0 + 8 * cg + j]; }
    const float bac = PARP(I_LBA)[l * 512 + ch0 + cc], bxc = PARP(I_LBX)[l * 512 + ch0 + cc];
    const float lamc = PARP(I_LLAM)[l * 512 + ch0 + cc]; const float c8 = -8.0f * LOG2E * log1pf(__expf(-lamc));
    for (int i = tid; i < 64 * 64; i += 512) { const int d = i >> 6, e = i & 63;
        *(LAS bf16*)(lds + LR_WAB + d * 144 + e * 2) = (bf16)(pk2(PARP(I_LWA)[(((size_t)l * 8 + nb) * 64 + d) * 64 + e], 0.f) & 0xffffu);
        *(LAS bf16*)(lds + LR_WXB + d * 144 + e * 2) = (bf16)(pk2(PARP(I_LWX)[(((size_t)l * 8 + nb) * 64 + d) * 64 + e], 0.f) & 0xffffu); }
    if (tid < 192) XR[tid] = 0.f;
    if (tid < 64) HC[tid] = 0.f;
    u32x4 nx, ny;
    { const bf16* rp = PROJ + (size_t)(tokbase + ta) * PLD; nx = *(const u32x4*)(rp + C_LX + ch0 + 8 * cg); ny = *(const u32x4*)(rp + C_LY + ch0 + 8 * cg); }
    LBAR();
    for (int n = 0; n < 32; ++n) {
        const int tok0 = tokbase + 64 * n, par = n & 1;
        { LAS float* xp = XR + (3 + ta) * 64 + 8 * cg;
          *(LAS f32x4*)xp = (f32x4){bflo(nx.x), bfhi(nx.x), bflo(nx.y), bfhi(nx.y)}; *(LAS f32x4*)(xp + 4) = (f32x4){bflo(nx.z), bfhi(nx.z), bflo(nx.w), bfhi(nx.w)}; }
        if (n + 1 < 32) nx = *(const u32x4*)(PROJ + (size_t)(tok0 + 64 + ta) * PLD + C_LX + ch0 + 8 * cg);
        LBAR();
        { float xc[8];
#pragma unroll
          for (int j = 0; j < 8; ++j) xc[j] = cb[j];
#pragma unroll
          for (int i = 0; i < 4; ++i) { const f32x4 a = *(const LAS f32x4*)(XR + (ta + i) * 64 + 8 * cg), c2 = *(const LAS f32x4*)(XR + (ta + i) * 64 + 8 * cg + 4);
              xc[0] += a[0] * cw[i][0]; xc[1] += a[1] * cw[i][1]; xc[2] += a[2] * cw[i][2]; xc[3] += a[3] * cw[i][3];
              xc[4] += c2[0] * cw[i][4]; xc[5] += c2[1] * cw[i][5]; xc[6] += c2[2] * cw[i][6]; xc[7] += c2[3] * cw[i][7]; }
          *(LAS f32x4*)(XC + ta * 64 + 8 * cg) = (f32x4){xc[0], xc[1], xc[2], xc[3]}; *(LAS f32x4*)(XC + ta * 64 + 8 * cg + 4) = (f32x4){xc[4], xc[5], xc[6], xc[7]};
          *(LAS bf16x8*)(lds + LR_XCB + ta * 144 + 16 * cg) = pack8(xc[0], xc[1], xc[2], xc[3], xc[4], xc[5], xc[6], xc[7]); }
        LBAR();
        if (tid < 192) XR[tid] = XR[64 * 64 + tid];
        { const int mat = w >> 2, tb = (w >> 1) & 1, eb = w & 1;
          const int wo = mat ? LR_WXB : LR_WAB;
          f32x16 c;
#pragma unroll
          for (int r = 0; r < 16; ++r) c[r] = 0.f;
          const int ra = (32 * tb + (lane & 31)) * 144 + 16 * h_;
#pragma unroll
          for (int ks = 0; ks < 4; ++ks) { const LAS unsigned char* p0 = lds + wo + (16 * ks + 8 * h_ + qq) * 144 + (32 * eb + 16 * blk + 4 * pp) * 2;
              c = MFMA32(*(const LAS bf16x8*)(lds + LR_XCB + ra + 32 * ks), cat8(tr_read(p0), tr_read(p0 + 4 * 144)), c); }
#pragma unroll
          for (int r = 0; r < 16; ++r) RI[(mat * 64 + 32 * tb + (r & 3) + 8 * (r >> 2) + 4 * h_) * 66 + 32 * eb + (lane & 31)] = c[r]; }
        LBAR();
        float hloc[8], pcum[8];
        { float Hh = 0.f, P = 1.f;
#pragma unroll
          for (int tt = 0; tt < 8; ++tt) { const int t = 8 * seg + tt;
              const float rg = fsigmoid(RI[t * 66 + cc] + bac), ig = fsigmoid(RI[(64 + t) * 66 + cc] + bxc), xc = XC[t * 64 + cc];
              const float a = __builtin_amdgcn_exp2f(rg * c8), om = fmaxf(1.0f - a * a, 0.0f), bb = __builtin_amdgcn_sqrtf(om) * (ig * xc);
              Hh = a * Hh + bb; P *= a; hloc[tt] = Hh; pcum[tt] = P; }
          SP[seg * 64 + cc] = P; SH[seg * 64 + cc] = Hh; }
        LBAR();
        { float hin = HC[par * 64 + cc]; float sp[7], sh7[7];
#pragma unroll
          for (int s2 = 0; s2 < 7; ++s2) { sp[s2] = SP[s2 * 64 + cc]; sh7[s2] = SH[s2 * 64 + cc]; }
#pragma unroll
          for (int s2 = 0; s2 < 7; ++s2) { const float nh = sp[s2] * hin + sh7[s2]; hin = (s2 < seg) ? nh : hin; }
#pragma unroll
          for (int tt = 0; tt < 8; ++tt) XC[(8 * seg + tt) * 64 + cc] = hloc[tt] + pcum[tt] * hin;
          if (seg == 7) HC[(par ^ 1) * 64 + cc] = hloc[7] + pcum[7] * hin; }
        LBAR();
        { const f32x4 h0 = *(const LAS f32x4*)(XC + ta * 64 + 8 * cg), h1 = *(const LAS f32x4*)(XC + ta * 64 + 8 * cg + 4);
          u32x4 o; o.x = pk2(h0[0] * fgelu_tanh(bflo(ny.x)), h0[1] * fgelu_tanh(bfhi(ny.x))); o.y = pk2(h0[2] * fgelu_tanh(bflo(ny.y)), h0[3] * fgelu_tanh(bfhi(ny.y)));
          o.z = pk2(h1[0] * fgelu_tanh(bflo(ny.z)), h1[1] * fgelu_tanh(bfhi(ny.z))); o.w = pk2(h1[2] * fgelu_tanh(bflo(ny.w)), h1[3] * fgelu_tanh(bfhi(ny.w)));
          *(u32x4*)(MIX + (size_t)(tok0 + ta) * D + 768 + ch0 + 8 * cg) = o;
          if (n + 1 < 32) ny = *(const u32x4*)(PROJ + (size_t)(tok0 + 64 + ta) * PLD + C_LY + ch0 + 8 * cg); }
        LBAR();
    }
}

DI void p_mixers(Frame& F, int l) {
    const float lam_init = 0.8f - 0.6f * expf(-0.3f * (float)l);
    if (F.wave == 0) {
        float a = (F.lane < 64) ? PARP(I_DLQ1)[l * 64 + F.lane] * PARP(I_DLK1)[l * 64 + F.lane] : 0.f, c = PARP(I_DLQ2)[l * 64 + F.lane] * PARP(I_DLK2)[l * 64 + F.lane];
        a = wave_sum(a); c = wave_sum(c);
        if (F.lane == 0) F.MISC[4] = __float_as_uint(expf(a) - expf(c) + lam_init);
    }
    __syncthreads();
    const float lam = __uint_as_float(F.MISC[4]);
    unsigned* q = F.ctl + CW_Q + 64 * 4 * l + 512 * F.qset;
#define CONVERT_LOOP() do { if (!(F.skip & 8)) for (;;) { const int it = dequeue(F, q + 192); if (it >= 1024) break; moe_convert_wg(F, l, it); } } while (0)
    const bool streamer = ((blockIdx.x >> 3) & 7) < 3;
    if (streamer) CONVERT_LOOP();
    if (!(F.skip & 1)) for (;;) { const int it = dequeue(F, q); if (it >= 48) break; gla_unit(F, l, it / 6, it % 6); }
    if (!(F.skip & 2)) for (;;) { const int it = dequeue(F, q + 64); if (it >= 64) break; lru_unit(F, l, it >> 3, it & 7); }
    if (!(F.skip & 4)) for (;;) { const int it = dequeue(F, q + 128); if (it >= 768) break; const int qb = 15 - it / 48, bh = it % 48; attn_unit(F, l, bh / 6, bh % 6, qb, lam, 1.0f - lam_init); }
    if (!streamer && !(F.skip & 16)) CONVERT_LOOP();
#undef CONVERT_LOOP
}

#define REFRESH() do { int t_ = threadIdx.x; asm volatile("" : "+v"(t_)); F.tid = t_; F.lane = t_ & 63; F.wave = __builtin_amdgcn_readfirstlane(t_ >> 6); } while (0)
#define IN(k) (lo <= (k) && (k) < hi)
#define SEAM(k) do { if (IN(k) && IN((k) + 1)) xcd_barrier(bar); } while (0)
template <int L>
DI void layer_phases(Frame& F, const XcdBarrier& bar, const int lo, const int hi) {
    constexpr int l = L, pb = 1 + 7 * L;
    if (IN(pb)) { REFRESH(); p_norm<L>(F); SEAM(pb); }
    if (IN(pb + 1)) {
        REFRESH();
        pg8::DenseSched S; S.init(F.ws + WS_U, F.ws + WS_WIN + (size_t)l * PLD * D * 2, T, PLD, D, F.G, (int)blockIdx.x);
        pg8::EpiProj E{(bf16*)(F.ws + WS_PROJ), PLD};
        pg8::gemm_phase<pg8::EpiProj, pg8::DenseSched>(F.lds, S, E);
        SEAM(pb + 1);
    }
    if (IN(pb + 2)) { REFRESH(); p_mixers(F, l); SEAM(pb + 2); }
    if (IN(pb + 3)) {
        REFRESH();
        pg8::DenseSched S; S.init(F.ws + WS_MIX, F.ws + WS_WOUT + (size_t)l * D * D * 2, T, D, D, F.G, (int)blockIdx.x);
        pg8::EpiDelta E{(bf16*)(F.ws + WS_DELTA), (const float*)(F.ws + WS_MOD) + (size_t)l * NB * 6 * D + 2 * D};
        pg8::gemm_phase<pg8::EpiDelta, pg8::DenseSched>(F.lds, S, E);
        SEAM(pb + 3);
    }
    if (IN(pb + 4)) { REFRESH(); p_norm2_router(F, l); SEAM(pb + 4); }
#define MOE_SPLIT() const int n1 = ntile * 4, R2 = n1 / F.G, rem = n1 - R2 * F.G, n_idle = F.G - rem; \
        int E_rt = (rem > 0) ? (3 * n_idle) / 8 : 0; { const int cap = R2 * (F.G / 4); if (E_rt > cap) E_rt = cap; }
    if (IN(pb + 5)) {
        REFRESH();
        const int ntile = moe_tiles(F, l);
        const LAS int* TE = (const LAS int*)(F.lds + TILETAB_OFF); const LAS int* TL = TE + 192; const LAS int* CN = TE + 384;
        LAS unsigned* RT = (LAS unsigned*)(F.lds + ROWTAB_OFF); LAS int* RT2 = (LAS int*)(F.lds + ROWTAB_OFF);
        const int* LIST = (const int*)(F.ws + WS_LIST); const float* WT = (const float*)(F.ws + WS_WT);
        MOE_SPLIT();
        const int c = (int)blockIdx.x;
        pg8::MoeSched S; S.K = D; S.A = (const char*)(F.ws + WS_U); S.Bt = (const char*)(F.ws + WS_W13) + (size_t)l * NE * 1024 * D * 2; S.Bf0 = nullptr; S.Bf1 = nullptr; S.bstride_e = 1024u * D * 2u; S.bstride_pn = 256u * 2u * D;
        S.npn = 4; S.G = F.G; S.c = c; S.tile_e = TE; S.tile_l = TL; S.rowtab = RT; S.gather = true;
        S.rt0 = 0; S.rt_end = ntile; S.rmax = R2; S.lin = 0; S.L0 = 0; S.Lend = 0; S.cl = 0; S.Gl = 1;
        pg8::EpiSwiglu E{(bf16*)(F.ws + WS_HID)};
#define FILL_RT() do { for (int ui = 0; ui < 12; ++ui) { int rt, pn; if (!S.unit_of(ui, rt, pn)) break; const int e = TE[rt], tl = TL[rt]; \
            for (int r = F.tid; r < 256; r += 512) { const int slot = tl * 256 + r; RT[ui * 256 + r] = (slot < CN[e]) ? (unsigned)(LIST[e * 16384 + slot] >> 1) : 0u; } } __syncthreads(); } while (0)
#define FILL_RT2(S2) do { for (int ui = 0; ui < 6; ++ui) { int rt, pn; if (!(S2).unit_of(ui, rt, pn)) break; const int e = TE[rt], tl = TL[rt]; \
            for (int r = F.tid; r < 256; r += 512) { const int slot = tl * 256 + r; int a = -1, wb = 0; if (slot < CN[e]) { a = LIST[e * 16384 + slot]; wb = __float_as_int(WT[a]); } \
                RT2[(ui * 256 + r) * 2] = a; RT2[(ui * 256 + r) * 2 + 1] = wb; } } __syncthreads(); } while (0)
        FILL_RT();
        pg8::gemm_phase<pg8::EpiSwiglu, pg8::MoeSched>(F.lds, S, E);
        if (rem > 0) {
            xcd_barrier(bar);
            const int rtB = ntile - R2 * (F.G / 4), perB = (rtB + 7) >> 3;
#define PB_RT(cc) (R2 * (F.G / 4) + perB * ((cc) & 7) + ((cc) >> 5))
#define PB_BUSY(cc) ((((cc) >> 5) < perB) && (PB_RT(cc) < ntile))
            __syncthreads();
            if (F.tid == 0) F.MISC[6] = 0u;
            __syncthreads();
            if (F.tid < c && !PB_BUSY(F.tid)) __hip_atomic_fetch_add((LAS unsigned*)(F.lds + MISC_OFF) + 6, 1u, __ATOMIC_RELAXED, __HIP_MEMORY_SCOPE_WORKGROUP);
            __syncthreads();
            const int idle_rank = (int)F.MISC[6];
            if (PB_BUSY(c)) {
                S.rmax = 1; S.lin = 1; S.L0 = PB_RT(c) * 4 + ((c >> 3) & 3); S.Lend = S.L0 + 1; S.cl = 0; S.Gl = 1;
                __syncthreads(); FILL_RT();
                pg8::gemm_phase<pg8::EpiSwiglu, pg8::MoeSched>(F.lds, S, E);
            } else if (E_rt > 0) {
                pg8::MoeSched S2; S2.K = DE; S2.A = (const char*)(F.ws + WS_HID); S2.Bt = (const char*)(F.ws + WS_W2); S2.Bf0 = F.in[I_W2] + (size_t)l * NE * DE * D; S2.Bf1 = nullptr; S2.bstride_e = (unsigned)D * DE * 4u; S2.bstride_pn = 1024u;
                S2.npn = 8; S2.G = F.G; S2.c = c; S2.tile_e = TE; S2.tile_l = TL; S2.rowtab = nullptr; S2.gather = false;
                S2.rt0 = 0; S2.rt_end = E_rt; S2.rmax = 3; S2.lin = 1; S2.L0 = 0; S2.Lend = 8 * E_rt; S2.cl = idle_rank; S2.Gl = n_idle;
                __syncthreads(); FILL_RT2(S2);
                pg8::EpiY2 E2{(bf16*)(F.ws + WS_Y2), RT2};
                pg8::gemm_phase<pg8::EpiY2, pg8::MoeSched, true, 2>(F.lds, S2, E2);
            }
        }
        SEAM(pb + 5);
    }
    if (IN(pb + 6)) {
        REFRESH();
        const int ntile = moe_tiles(F, l);
        const LAS int* TE = (const LAS int*)(F.lds + TILETAB_OFF); const LAS int* TL = TE + 192; const LAS int* CN = TE + 384;
        LAS int* RT2 = (LAS int*)(F.lds + ROWTAB_OFF);
        const int* LIST = (const int*)(F.ws + WS_LIST); const float* WT = (const float*)(F.ws + WS_WT);
        MOE_SPLIT();
        pg8::MoeSched S; S.K = DE; S.A = (const char*)(F.ws + WS_HID); S.Bt = (const char*)(F.ws + WS_W2); S.Bf0 = F.in[I_W2] + (size_t)l * NE * DE * D; S.Bf1 = nullptr; S.bstride_e = (unsigned)D * DE * 4u; S.bstride_pn = 1024u;
        S.npn = 8; S.G = F.G; S.c = (int)blockIdx.x; S.tile_e = TE; S.tile_l = TL; S.rowtab = nullptr; S.gather = false;
        S.rt0 = E_rt; S.rt_end = ntile; S.rmax = 6; S.lin = 0; S.L0 = 0; S.Lend = 0; S.cl = 0; S.Gl = 1;
        FILL_RT2(S);
        pg8::EpiY2 E{(bf16*)(F.ws + WS_Y2), RT2};
        pg8::gemm_phase<pg8::EpiY2, pg8::MoeSched, true, 2>(F.lds, S, E);
        SEAM(pb + 6);
    }
#undef MOE_SPLIT
#undef PB_RT
#undef PB_BUSY
#undef FILL_RT
#undef FILL_RT2
}
__global__ void __launch_bounds__(512, 2) mega(Args args) {
    extern __shared__ __attribute__((aligned(16))) unsigned char lds_raw[];
    Frame F;
    F.lds = (LAS unsigned char*)lds_raw; F.MISC = (volatile LAS unsigned*)(F.lds + MISC_OFF);
    F.tid = threadIdx.x; F.lane = F.tid & 63; F.wave = __builtin_amdgcn_readfirstlane(F.tid >> 6);
    F.G = gridDim.x; { const int bx = blockIdx.x; F.vcu = (F.G % 8 == 0) ? (bx % 8) * (F.G / 8) + bx / 8 : bx; }
    F.in = args.in; F.out = args.out; F.ws = args.ws; F.ctl = (unsigned*)(args.ws + WS_CTL); F.qset = args.qset & 255; F.skip = args.qset >> 8;
    if (F.tid < 64) F.MISC[F.tid] = 0u;
    __syncthreads();
    const int lo = args.ph_lo, hi = args.ph_hi;
    XcdBarrier bar; bar.bar = F.ctl + CW_BAR + args.li * XCD_BAR_WORDS; bar.x = 0; bar.st = F.MISC;
    bar = xcd_barrier_post(F.ctl + CW_BAR + args.li * XCD_BAR_WORDS, F.MISC);
    if (IN(0)) { p0_prologue(F); SEAM(0); }
    layer_phases<0>(F, bar, lo, hi);
    layer_phases<1>(F, bar, lo, hi);
    if (IN(15)) { REFRESH(); p_norm<2>(F); }
}
#undef IN
#undef SEAM

extern "C" void kernel_launch(void* const* d_in, const int* in_sizes, int n_in, void* d_out, int out_size, void* d_ws, size_t ws_size, hipStream_t stream) {
    static int grid = 0;
    if (grid == 0) {
        if (n_in != 32 || out_size != T * D || ws_size < WS_END) { fprintf(stderr, "kernel_launch: unexpected shapes (n_in %d, out %d, ws %zu)\n", n_in, out_size, ws_size); grid = -1; return; }
        int dev = 0, cus = 0, per_cu = 0;
        if (hipGetDevice(&dev) != hipSuccess || hipDeviceGetAttribute(&cus, hipDeviceAttributeMultiprocessorCount, dev) != hipSuccess) { grid = -1; return; }
        if (hipFuncSetAttribute((const void*)mega, hipFuncAttributeMaxDynamicSharedMemorySize, LDS_BYTES) != hipSuccess) { fprintf(stderr, "kernel_launch: hipFuncSetAttribute failed\n"); grid = -1; return; }
        if (hipOccupancyMaxActiveBlocksPerMultiprocessor(&per_cu, (const void*)mega, 512, LDS_BYTES) != hipSuccess || per_cu < 1) fprintf(stderr, "kernel_launch: occupancy query reports %d\n", per_cu);
        (void)hipGetLastError();
        grid = cus;
    }
    if (grid < 0) return;
    if (hipMemsetAsync((char*)d_ws + WS_CTL, 0, CTL_BYTES, stream) != hipSuccess) return;
    Args a{};
    for (int i = 0; i < 32; ++i) a.in[i] = (const float*)d_in[i];
    a.out = (float*)d_out; a.ws = (unsigned char*)d_ws;
    static const int plan[][3] = { PLAN };
    for (int li = 0; li < (int)(sizeof(plan) / sizeof(plan[0])); ++li) { a.ph_lo = plan[li][0]; a.ph_hi = plan[li][1]; a.li = li; a.qset = plan[li][2];
        hipLaunchKernelGGL(mega, dim3(grid), dim3(512), LDS_BYTES, stream, a); }
}
```

```cpp
#include <hip/hip_runtime.h>
#include <cstdio>
#include <cstdint>

#define PLAN {0, 16, 0}

#define GAS __attribute__((address_space(1)))
#define LAS __attribute__((address_space(3)))
typedef unsigned short bf16;
typedef short bf16x8 __attribute__((ext_vector_type(8)));
typedef short s16x4 __attribute__((ext_vector_type(4)));
typedef float f32x2 __attribute__((ext_vector_type(2)));
typedef float f32x4 __attribute__((ext_vector_type(4)));
typedef float f32x16 __attribute__((ext_vector_type(16)));
typedef unsigned u32x2 __attribute__((ext_vector_type(2)));
typedef unsigned u32x4 __attribute__((ext_vector_type(4)));
typedef __bf16 bf16x2_t __attribute__((ext_vector_type(2)));
#define DI __device__ __forceinline__

constexpr int NB = 8, SEQ = 2048, D = 2048, T = NB * SEQ, NL = 2;
constexpr int INW = 5648, PLD = 5888;
constexpr int C_GQ = 0, C_GK = 384, C_GV = 768, C_GOG = 1536, C_LY = 2304, C_LX = 2816, C_DQ = 3328, C_DK = 4096, C_DV = 4864, C_GA = 5632;
constexpr int NE = 64, DE = 512;
constexpr float EPS = 1e-6f, LOG2E = 1.4426950408889634f;
constexpr int NPH = 16;

constexpr size_t MiB = 1u << 20;
constexpr size_t WS_CTL = 0, CTL_BYTES = 65536;
constexpr size_t WS_MOD = 1 * MiB;
constexpr size_t WS_WR = 2 * MiB;
constexpr size_t WS_LIST = 4 * MiB;
constexpr size_t WS_WT = 8 * MiB;
constexpr size_t WS_CB = 8 * MiB + 512 * 1024;
constexpr size_t WS_PAR = 9 * MiB;
constexpr size_t WS_WIN = 16 * MiB;
constexpr size_t WS_WOUT = 64 * MiB;
constexpr size_t WS_W13 = 80 * MiB;
constexpr size_t WS_W2 = 592 * MiB;
constexpr size_t WS_H = 848 * MiB;
constexpr size_t WS_U = 976 * MiB;
constexpr size_t WS_PROJ = 1040 * MiB;
constexpr size_t WS_MIX = 1224 * MiB;
constexpr size_t WS_HID = 1288 * MiB;
constexpr size_t WS_Y2 = 1336 * MiB;
constexpr size_t WS_DELTA = 1464 * MiB;
constexpr size_t WS_END = 1528 * MiB;
constexpr int CW_FLAG = 0;
constexpr int CW_Q = 64;
constexpr int CW_CNT = 2048;
constexpr int CW_BAR = 4096;

constexpr int RING_BYTES = 131072;
constexpr int ROWTAB_OFF = 131072;
constexpr int TILETAB_OFF = 143360;
constexpr int MISC_OFF = 145408;
constexpr int LDS_BYTES = 147456;

DI unsigned pk2(float lo, float hi) { f32x2 v = {lo, hi}; return __builtin_bit_cast(unsigned, __builtin_convertvector(v, bf16x2_t)); }
DI float bflo(unsigned w) { return __uint_as_float(w << 16); }
DI float bfhi(unsigned w) { return __uint_as_float(w & 0xffff0000u); }
DI float bf2f(bf16 v) { return __uint_as_float((unsigned)v << 16); }
DI float wave_sum(float v) {
#pragma unroll
    for (int o = 1; o < 64; o <<= 1) v += __shfl_xor(v, o);
    return v;
}
DI float frcp(float x) { return __builtin_amdgcn_rcpf(x); }
DI float fsigmoid(float x) { return frcp(1.f + __builtin_amdgcn_exp2f(-1.4426950408889634f * x)); }
DI float fsilu(float x) { return x * frcp(1.f + __builtin_amdgcn_exp2f(-1.4426950408889634f * x)); }
DI float fgelu_tanh(float x) { const float u2 = (2.0f * 0.7978845608028654f * 1.4426950408889634f) * (x + 0.044715f * x * x * x); return x * frcp(1.f + __builtin_amdgcn_exp2f(-u2)); }
#define LDS_WAIT() asm volatile("s_waitcnt lgkmcnt(0)" ::: "memory")
#define VM_WAIT() asm volatile("s_waitcnt vmcnt(0)" ::: "memory")
#define LBAR() do { asm volatile("s_waitcnt lgkmcnt(0)" ::: "memory"); __builtin_amdgcn_s_barrier(); asm volatile("" ::: "memory"); } while (0)

#define XB_TMO      128
#define XB_XCNT(j)  (256  + 64 * (j))
#define XB_XSUB(j)  (1280 + 64 * (j))
#define XB_XGEN(j)  (2304 + 64 * (j))
#define XB_TOP      3328
#define XB_TOPGEN   3392
#define XCD_BAR_WORDS 3456
#define XB_SPIN_CAP (1u << 18)
DI unsigned xb_ld(unsigned* p)              { return __hip_atomic_load(p, __ATOMIC_RELAXED, __HIP_MEMORY_SCOPE_AGENT); }
DI unsigned xb_add(unsigned* p, unsigned v) { return __hip_atomic_fetch_add(p, v, __ATOMIC_RELAXED, __HIP_MEMORY_SCOPE_AGENT); }
DI unsigned xb_xcc_id() { return (unsigned)__builtin_amdgcn_s_getreg((3 << 11) | 20) & 0xFu; }
#define XB_SPIN(cond, bar) do { unsigned _sp = 0; while (cond) { __builtin_amdgcn_s_sleep(1); \
    if ((++_sp & 255u) == 0u) { if (xb_ld(&(bar)[XB_TMO])) break; if (_sp > XB_SPIN_CAP) { atomicAdd(&(bar)[XB_TMO], 1u); break; } } } } while (0)
struct XcdBarrier { unsigned* bar; unsigned x; volatile LAS unsigned* st; };
DI XcdBarrier xcd_barrier_post(unsigned* bar, volatile LAS unsigned* st) {
    XcdBarrier b; b.bar = bar; b.x = xb_xcc_id(); b.st = st;
    if (threadIdx.x == 0) (void)xb_add(&bar[XB_XCNT(b.x)], 1u);
    return b;
}
DI void xcd_barrier_complete(unsigned* bar, unsigned x, unsigned& nloc, unsigned& nx) {
    const unsigned G = gridDim.x * gridDim.y * gridDim.z;
    unsigned sum, cnt, mine, sp = 0u;
    for (;;) {
        sum = 0u; cnt = 0u; mine = 0u;
#pragma unroll
        for (unsigned j = 0; j < 16; ++j) { const unsigned c = xb_ld(&bar[XB_XCNT(j)]); sum += c; cnt += (c > 0u) ? 1u : 0u; mine = (j == x) ? c : mine; }
        if (sum == G) break;
        __builtin_amdgcn_s_sleep(1);
        if ((++sp & 255u) == 0u) { if (xb_ld(&bar[XB_TMO])) break; if (sp > XB_SPIN_CAP) { atomicAdd(&bar[XB_TMO], 1u); break; } }
    }
    nloc = mine > 0u ? mine : 1u; nx = cnt > 0u ? cnt : 1u;
}
DI void xcd_barrier(const XcdBarrier& b) {
    asm volatile("s_waitcnt vmcnt(0)" ::: "memory");
    __syncthreads();
    if (threadIdx.x == 0) {
        unsigned* bar = b.bar;
        __builtin_amdgcn_s_waitcnt(0);
        unsigned nloc = b.st[0], nx = b.st[1];
        if (nloc == 0u) { xcd_barrier_complete(bar, b.x, nloc, nx); b.st[0] = nloc; b.st[1] = nx; }
        const unsigned old = xb_add(&bar[XB_XSUB(b.x)], 1u);
        const unsigned gen = old / nloc;
        if (old + 1u == (gen + 1u) * nloc) {
            __builtin_amdgcn_fence(__ATOMIC_RELEASE, "agent");
            asm volatile("s_waitcnt vmcnt(0)" ::: "memory");
            const unsigned og = xb_add(&bar[XB_TOP], 1u);
            const unsigned tg = og / nx;
            if (og + 1u == (tg + 1u) * nx) xb_add(&bar[XB_TOPGEN], 1u);
            else XB_SPIN(xb_ld(&bar[XB_TOPGEN]) == tg, bar);
            __builtin_amdgcn_fence(__ATOMIC_ACQUIRE, "agent");
            xb_add(&bar[XB_XGEN(b.x)], 1u);
            asm volatile("s_waitcnt vmcnt(0)" ::: "memory");
        } else {
            XB_SPIN(xb_ld(&bar[XB_XGEN(b.x)]) == gen, bar);
            __builtin_amdgcn_fence(__ATOMIC_ACQUIRE, "agent");
            asm volatile("s_waitcnt vmcnt(0)" ::: "memory");
        }
    }
    __syncthreads();
}

namespace pg8 {
constexpr int BM = 256, BK = 64, HALF = 128, HTB = HALF * BK * 2, STAGE_BYTES = 8 * HTB, NXCD = 8, WGM = 8;
__host__ __device__ __forceinline__ int lds_byte(int r, int c) { const int st = (r >> 4) * 2 + (c >> 5), rr = r & 15, cc = c & 31, ob = rr * 64 + cc * 2; return st * 1024 + (ob ^ (((ob >> 9) & 1) << 5)); }
__host__ __device__ __forceinline__ void stage_rc(int b, int& R, int& C) { const int st = b / 1024, sb = b % 1024, swz = sb ^ (((sb >> 9) & 1) << 5); R = (st >> 1) * 16 + swz / 64; C = (st & 1) * 32 + (swz % 64) / 2; }
__host__ __device__ __forceinline__ int perm32(int rho) { const int n = rho >> 4, i = rho & 15; return 8 * (i >> 2) + 4 * n + (i & 3); }

struct Unit { int pm, pn, e, aux; };

DI s16x4 tr_read_b(const LAS unsigned char* p) { return __builtin_bit_cast(s16x4, __builtin_amdgcn_ds_read_tr16_b64_v4i16((LAS s16x4*)p)); }
template <class Epi, class Sched, bool ALIGN_EPI = true, int BF = 0>
DI void gemm_phase(LAS unsigned char* lds, const Sched& S, const Epi& E) {
    int tid_ = threadIdx.x; asm volatile("" : "+v"(tid_));
    const int tid = tid_, wid = __builtin_amdgcn_readfirstlane(tid >> 6), lane = tid & 63, wr = wid >> 2, wc = wid & 3, fr = lane & 15, fq = lane >> 4;
    const int K = S.K, nt = K / BK;
    const unsigned K2 = (unsigned)K * 2u;
    unsigned voffB[2];
#pragma unroll
    for (int i = 0; i < 2; ++i) { int R, C; stage_rc(tid * 16 + i * 8192, R, C); const int Rb = Epi::PERM ? ((R & ~31) + perm32(R & 31)) : R;
        voffB[i] = (unsigned)(Rb * K + C) * 2u; }
    const unsigned hstepB = (unsigned)HALF * K * 2u;
    const unsigned ldsw = (unsigned)wid * 1024u;
    const int aoff = lds_byte(wr * 64 + fr, fq * 8), boff = lds_byte(wc * 32 + fr, fq * 8);
    const __amdgpu_buffer_rsrc_t rsA = __builtin_amdgcn_make_buffer_rsrc((void*)S.A, 0, 0x7fffffff, 0x00020000);
    const __amdgpu_buffer_rsrc_t rsB = __builtin_amdgcn_make_buffer_rsrc((void*)S.Bt, 0, 0x7fffffff, 0x00020000);
    const __amdgpu_buffer_rsrc_t rsF = __builtin_amdgcn_make_buffer_rsrc((void*)((BF == 1 && (wid & 1)) ? S.Bf1 : S.Bf0), 0, 0x7fffffff, 0x00020000);
    constexpr unsigned KBMUL = (BF == 1) ? 1024u : 4096u, ROWB = (BF == 1) ? 2048u : 8192u;
    unsigned voffF = 0, wrowoff = 0, bwr0 = 0, brd0 = 0; const unsigned ldsbase = (unsigned)(unsigned long long)lds;
    u32x4 bq[8];
    if constexpr (BF == 2) {
        const unsigned r0 = ((unsigned)wid & 3u) + 8u * ((unsigned)wid >> 2);
        voffF = (unsigned)lane * 16u; wrowoff = r0 * ROWB;
        const unsigned seg = 8u * (lane >> 3) + 4u * (lane & 1) + ((lane >> 1) & 3);
        bwr0 = r0 * 512u + ((seg ^ (((r0 & 3u) << 2) | (((r0 >> 3) & 1u) << 4))) << 3);
    } else if constexpr (BF == 1) {
        const unsigned rh = lane >> 5, c = lane & 31, kq = (unsigned)wid >> 1, hs = (unsigned)wid & 1u;
        const unsigned r0w = 2u * (kq & 1u) + 8u * (kq >> 1), r0 = r0w + rh;
        voffF = rh * ROWB + c * 16u; wrowoff = r0w * ROWB;
        const unsigned seg = 32u * hs + 8u * (c >> 3) + 4u * (c & 1) + ((c >> 1) & 3);
        bwr0 = r0 * 512u + ((seg ^ (((r0 & 3u) << 2) | (((r0 >> 3) & 1u) << 4))) << 3);
    }
    if constexpr (BF != 0) {
        const unsigned segb = 8u * wc, mask = (((unsigned)fr >> 2) << 2) | (((unsigned)fq & 1u) << 4);
        brd0 = (unsigned)(8 * fq + (fr >> 2)) * 512u + (((segb ^ mask) | ((unsigned)fr & 3u)) << 3);
    }
    const unsigned brdA = ldsbase + brd0, brdB = ldsbase + (brd0 ^ 32u);
#define PG8_ROWD(i) ((unsigned)(((i) & 1) * 4 + ((i) >> 1) * 16))
#define PG8_LDBF(bp, kb) do { const unsigned _s = (bp) + (kb) * KBMUL + wrowoff; _Pragma("unroll") for (int _i = 0; _i < 8; ++_i) \
        bq[_i] = __builtin_bit_cast(u32x4, __builtin_amdgcn_raw_buffer_load_b128(rsF, voffF, _s + PG8_ROWD(_i) * ROWB, 0)); } while (0)
#define PG8_WRB(slot) do { PG8_WAIT_V(4); _Pragma("unroll") for (int _i = 0; _i < 8; ++_i) { \
        u32x2 _w; _w.x = pk2(__uint_as_float(bq[_i].x), __uint_as_float(bq[_i].y)); _w.y = pk2(__uint_as_float(bq[_i].z), __uint_as_float(bq[_i].w)); \
        *(LAS u32x2*)(lds + PG8_SB(slot, 0) + bwr0 + PG8_ROWD(_i) * 512u) = _w; } } while (0)
#define PG8_TR(d, a, off) asm volatile("ds_read_b64_tr_b16 %0, %1 offset:%2" : "=v"(d) : "v"(a), "i"(off) : "memory")
#define PG8_LDBT(dst, b, bj) do { constexpr int _o = PG8_SB(b, 0) + (bj) * 256; s16x4 _t0, _t1, _t2, _t3, _t4, _t5, _t6, _t7; \
        PG8_TR(_t0, brdA, _o); PG8_TR(_t1, brdA, _o + 2048); PG8_TR(_t2, brdA, _o + 16384); PG8_TR(_t3, brdA, _o + 18432); PG8_TR(_t4, brdB, _o); PG8_TR(_t5, brdB, _o + 2048); PG8_TR(_t6, brdB, _o + 16384); PG8_TR(_t7, brdB, _o + 18432); \
        dst[0][0] = __builtin_shufflevector(_t0, _t1, 0, 1, 2, 3, 4, 5, 6, 7); dst[0][1] = __builtin_shufflevector(_t2, _t3, 0, 1, 2, 3, 4, 5, 6, 7); \
        dst[1][0] = __builtin_shufflevector(_t4, _t5, 0, 1, 2, 3, 4, 5, 6, 7); dst[1][1] = __builtin_shufflevector(_t6, _t7, 0, 1, 2, 3, 4, 5, 6, 7); } while (0)
#define PG8_TIEB(x) asm volatile("s_waitcnt lgkmcnt(0)" : "+v"(x[0][0]), "+v"(x[0][1]), "+v"(x[1][0]), "+v"(x[1][1]) :: "memory")
#define PG8_LDBTH(dst, n, b, bj) do { constexpr int _o = PG8_SB(b, 0) + (bj) * 256; const unsigned _a = (n) ? brdB : brdA; s16x4 _t0, _t1, _t2, _t3; \
        PG8_TR(_t0, _a, _o); PG8_TR(_t1, _a, _o + 2048); PG8_TR(_t2, _a, _o + 16384); PG8_TR(_t3, _a, _o + 18432); \
        dst[n][0] = __builtin_shufflevector(_t0, _t1, 0, 1, 2, 3, 4, 5, 6, 7); dst[n][1] = __builtin_shufflevector(_t2, _t3, 0, 1, 2, 3, 4, 5, 6, 7); } while (0)
#define PG8_TIEH(x, n, cnt) asm volatile("s_waitcnt lgkmcnt(" #cnt ")" : "+v"(x[n][0]), "+v"(x[n][1]) :: "memory")
#define PG8_MMAH(ai, bj, n, At, Bt) do { _Pragma("unroll") for (int m = 0; m < 4; ++m) _Pragma("unroll") for (int k = 0; k < 2; ++k) \
        acc[ai][bj][m][n] = __builtin_amdgcn_mfma_f32_16x16x32_bf16(Bt[n][k], At[m][k], acc[ai][bj][m][n], 0, 0, 0); } while (0)
#define PG8_MMA2(ai, bj0, bj1, b) do { __builtin_amdgcn_s_setprio(1); PG8_MMAH(ai, bj0, 0, At, B0); PG8_SCHED; PG8_LDBTH(B0, 0, b, bj1); PG8_SCHED; PG8_MMAH(ai, bj0, 1, At, B0); PG8_SCHED; PG8_LDBTH(B0, 1, b, bj1); PG8_SCHED; \
        PG8_TIEH(B0, 0, 4); PG8_MMAH(ai, bj1, 0, At, B0); PG8_SCHED; PG8_TIEH(B0, 1, 0); PG8_MMAH(ai, bj1, 1, At, B0); __builtin_amdgcn_s_setprio(0); } while (0)
#define PG8_SA(b, h) (((BF != 0 ? 4 : 0) + (b) * 2 + (h)) * HTB)
#define PG8_SB(b, h) (((BF != 0 ? 0 : 4) + (b) * 2 + (h)) * HTB)
#define PG8_STAGE_A(bufoff, kb, va) do { _Pragma("unroll") for (int _i = 0; _i < 2; ++_i) \
        __builtin_amdgcn_raw_ptr_buffer_load_lds(rsA, (LAS unsigned*)(lds + (bufoff) + ldsw + _i * 8192), 16, (va)[_i], (kb), 0, 0); } while (0)
#define PG8_STAGE_B(bufoff, bp, kb) do { _Pragma("unroll") for (int _i = 0; _i < 2; ++_i) \
        __builtin_amdgcn_raw_ptr_buffer_load_lds(rsB, (LAS unsigned*)(lds + (bufoff) + ldsw + _i * 8192), 16, voffB[_i], (bp) + (kb), 0, 0); } while (0)
#define PG8_LDA(dst, b, h) do { _Pragma("unroll") for (int m = 0; m < 4; ++m) _Pragma("unroll") for (int k = 0; k < 2; ++k) dst[m][k] = *(const LAS bf16x8*)(lds + PG8_SA(b, h) + aoff + m * 2048 + k * 1024); } while (0)
#define PG8_LDB(dst, b, h) do { _Pragma("unroll") for (int n = 0; n < 2; ++n) _Pragma("unroll") for (int k = 0; k < 2; ++k) dst[n][k] = *(const LAS bf16x8*)(lds + PG8_SB(b, h) + boff + n * 2048 + k * 1024); } while (0)
#define PG8_MMA(ai, bj, At, Bt) do { __builtin_amdgcn_s_setprio(1); _Pragma("unroll") for (int m = 0; m < 4; ++m) _Pragma("unroll") for (int n = 0; n < 2; ++n) _Pragma("unroll") for (int k = 0; k < 2; ++k) \
        acc[ai][bj][m][n] = __builtin_amdgcn_mfma_f32_16x16x32_bf16(Bt[n][k], At[m][k], acc[ai][bj][m][n], 0, 0, 0); __builtin_amdgcn_s_setprio(0); } while (0)
#define PG8_WAIT_V(n) asm volatile("s_waitcnt vmcnt(" #n ")" ::: "memory")
#define PG8_WAIT_L(n) asm volatile("s_waitcnt lgkmcnt(" #n ")" ::: "memory")
#define PG8_BAR __builtin_amdgcn_s_barrier()
#define PG8_SCHED __builtin_amdgcn_sched_barrier(0)
    Unit cur, nxt; int ui = 0;
    if (!S.next(0, cur)) return;
    f32x4 acc[2][2][4][2];
#pragma unroll
    for (int a = 0; a < 2; ++a)
#pragma unroll
        for (int b = 0; b < 2; ++b)
#pragma unroll
            for (int m = 0; m < 4; ++m)
#pragma unroll
                for (int n = 0; n < 2; ++n) acc[a][b][m][n] = (f32x4){0.f, 0.f, 0.f, 0.f};
    bf16x8 At[4][2], B0[2][2], B1[2][2];
    unsigned vAc[2][2];
#define PG8_SETVA(dst, unit, uidx) do { int _t = tid; if constexpr (BF != 0) asm volatile("" : "+v"(_t));   \
        _Pragma("unroll") for (int _i = 0; _i < 2; ++_i) { int _R, _C; stage_rc(_t * 16 + _i * 8192, _R, _C); \
        _Pragma("unroll") for (int _h = 0; _h < 2; ++_h) dst[_h][_i] = S.arow(unit, uidx, 128 * _h + _R) * K2 + (unsigned)_C * 2u; } } while (0)
    PG8_SETVA(vAc, cur, 0);
    unsigned cB = S.bbase(cur);
    if constexpr (BF == 0) {
        PG8_STAGE_B(PG8_SB(0, 0), cB, 0u); PG8_STAGE_B(PG8_SB(0, 1), cB + hstepB, 0u); PG8_STAGE_A(PG8_SA(0, 0), 0u, vAc[0]); PG8_STAGE_A(PG8_SA(0, 1), 0u, vAc[1]);
        if (wr == 1) PG8_BAR;
        PG8_WAIT_V(2); PG8_BAR;
        PG8_STAGE_B(PG8_SB(1, 0), cB, 128u); PG8_STAGE_A(PG8_SA(1, 0), 128u, vAc[0]); PG8_STAGE_B(PG8_SB(1, 1), cB + hstepB, 128u);
        PG8_WAIT_V(6); PG8_BAR;
    } else {
        PG8_LDBF(cB, 0u); PG8_STAGE_A(PG8_SA(0, 0), 0u, vAc[0]); PG8_STAGE_A(PG8_SA(0, 1), 0u, vAc[1]);
        if (wr == 1) PG8_BAR;
        PG8_WRB(0); PG8_WAIT_V(2); PG8_WAIT_L(0); PG8_BAR;
        PG8_LDBF(cB, 128u); PG8_STAGE_A(PG8_SA(1, 0), 128u, vAc[0]);
        PG8_WAIT_V(10); PG8_BAR;
    }
#define PG8_KTRIP(kb1, kb2, kb3, VA2, B2) do { if constexpr (BF != 0) { \
              \
            PG8_LDBT(B0, 0, 0); PG8_SCHED; PG8_LDA(At, 0, 0); PG8_STAGE_A(PG8_SA(1, 1), kb1, vAc[1]); \
            PG8_WAIT_V(12); PG8_TIEB(B0); PG8_BAR; PG8_MMA2(0, 0, 1, 0); PG8_BAR; PG8_SCHED; \
            PG8_WRB(1); PG8_SCHED; PG8_LDBF(B2, kb2); PG8_SCHED; PG8_LDA(At, 0, 1); PG8_STAGE_A(PG8_SA(0, 0), kb2, VA2[0]); \
            PG8_WAIT_V(12); PG8_WAIT_L(0); PG8_BAR; PG8_MMA2(1, 1, 0, 0); PG8_BAR; PG8_SCHED; \
            PG8_LDBT(B0, 1, 0); PG8_SCHED; PG8_LDA(At, 1, 0); PG8_STAGE_A(PG8_SA(0, 1), kb2, VA2[1]); \
            PG8_WAIT_V(12); PG8_TIEB(B0); PG8_BAR; PG8_MMA2(0, 0, 1, 1); PG8_BAR; PG8_SCHED; \
            PG8_WRB(0); PG8_SCHED; PG8_LDBF(B2, kb3); PG8_SCHED; PG8_LDA(At, 1, 1); PG8_STAGE_A(PG8_SA(1, 0), kb3, VA2[0]); \
            PG8_WAIT_V(12); PG8_WAIT_L(0); PG8_BAR; PG8_MMA2(1, 1, 0, 1); PG8_BAR; PG8_SCHED; } else { \
            PG8_LDB(B0, 0, 0); PG8_LDB(B1, 0, 1); PG8_SCHED; PG8_LDA(At, 0, 0); PG8_STAGE_A(PG8_SA(1, 1), kb1, vAc[1]); \
            PG8_WAIT_V(8); PG8_WAIT_L(0); PG8_BAR; PG8_MMA(0, 0, At, B0); PG8_MMA(0, 1, At, B1); PG8_BAR; PG8_SCHED; \
            PG8_LDA(At, 0, 1); PG8_STAGE_B(PG8_SB(0, 0), B2, kb2); PG8_STAGE_B(PG8_SB(0, 1), (B2) + hstepB, kb2); PG8_STAGE_A(PG8_SA(0, 0), kb2, VA2[0]); \
            PG8_WAIT_V(8); PG8_WAIT_L(0); PG8_BAR; PG8_MMA(1, 0, At, B0); PG8_MMA(1, 1, At, B1); PG8_BAR; PG8_SCHED; \
            PG8_LDB(B0, 1, 0); PG8_LDB(B1, 1, 1); PG8_SCHED; PG8_LDA(At, 1, 0); PG8_STAGE_A(PG8_SA(0, 1), kb2, VA2[1]); \
            PG8_WAIT_V(8); PG8_WAIT_L(0); PG8_BAR; PG8_MMA(0, 0, At, B0); PG8_MMA(0, 1, At, B1); PG8_BAR; PG8_SCHED; \
            PG8_LDA(At, 1, 1); PG8_STAGE_B(PG8_SB(1, 0), B2, kb3); PG8_STAGE_B(PG8_SB(1, 1), (B2) + hstepB, kb3); PG8_STAGE_A(PG8_SA(1, 0), kb3, VA2[0]); \
            PG8_WAIT_V(8); PG8_WAIT_L(0); PG8_BAR; PG8_MMA(1, 0, At, B0); PG8_MMA(1, 1, At, B1); PG8_BAR; PG8_SCHED; } } while (0)
    for (;;) {
        for (int t = 0; t < nt - 2; t += 2) { const unsigned kb1 = (unsigned)(t + 1) * 128u; PG8_KTRIP(kb1, kb1 + 128u, kb1 + 256u, vAc, cB); }
        const bool has_next = S.next(ui + 1, nxt);
        unsigned vAn[2][2]; unsigned nB = cB;
#pragma unroll
        for (int h = 0; h < 2; ++h)
#pragma unroll
            for (int i = 0; i < 2; ++i) vAn[h][i] = vAc[h][i];
        if (has_next) { nB = S.bbase(nxt); PG8_SETVA(vAn, nxt, ui + 1); }
        { const unsigned kb1 = (unsigned)(nt - 1) * 128u; PG8_KTRIP(kb1, 0u, 128u, vAn, nB); }
        if constexpr (ALIGN_EPI) { if (wr == 0) PG8_BAR; }
        if constexpr (BF != 0) { int t_ = tid; asm volatile("" : "+v"(t_)); E(acc, cur, ui, wr, wc, t_ & 15, (t_ & 63) >> 4); }
        else E(acc, cur, ui, wr, wc, fr, fq);
        if (!has_next) break;
#pragma unroll
        for (int a = 0; a < 2; ++a)
#pragma unroll
            for (int b = 0; b < 2; ++b)
#pragma unroll
                for (int m = 0; m < 4; ++m)
#pragma unroll
                    for (int n = 0; n < 2; ++n) acc[a][b][m][n] = (f32x4){0.f, 0.f, 0.f, 0.f};
        cur = nxt; cB = nB; ++ui;
#pragma unroll
        for (int h = 0; h < 2; ++h)
#pragma unroll
            for (int i = 0; i < 2; ++i) vAc[h][i] = vAn[h][i];
        if constexpr (ALIGN_EPI) { if (wr == 1) PG8_BAR; }
    }
    PG8_WAIT_V(0);
    if constexpr (!ALIGN_EPI) { if (wr == 0) PG8_BAR; }
    PG8_BAR;
#undef PG8_KTRIP
#undef PG8_LDBF
#undef PG8_WRB
#undef PG8_LDBT
#undef PG8_TR
#undef PG8_TIEB
#undef PG8_ROWD
#undef PG8_LDBTH
#undef PG8_TIEH
#undef PG8_MMAH
#undef PG8_MMA2
#undef PG8_SETVA
#undef PG8_SA
#undef PG8_SB
#undef PG8_STAGE_A
#undef PG8_STAGE_B
#undef PG8_LDA
#undef PG8_LDB
#undef PG8_MMA
#undef PG8_WAIT_V
#undef PG8_WAIT_L
#undef PG8_BAR
#undef PG8_SCHED
}

struct DenseSched {
    int K; const char* A; const char* Bt; int nM, nN, nwg, G, c; static constexpr const float* Bf0 = nullptr; static constexpr const float* Bf1 = nullptr;
    DI void init(const void* A_, const void* Bt_, int M, int N, int K_, int G_, int c_) { A = (const char*)A_; Bt = (const char*)Bt_; K = K_; nM = M / BM; nN = N / BM; nwg = nM * nN; G = G_; c = c_; }
    DI bool next(int i, Unit& u) const {
        const long L = (long)i * G + c; if (L >= nwg) return false;
        int wgid = (int)L; { const int q = nwg / NXCD, r = nwg % NXCD, xcd = wgid % NXCD, off = wgid / NXCD; wgid = (xcd < r ? xcd * (q + 1) : r * (q + 1) + (xcd - r) * q) + off; }
        const int nig = WGM * nN, gid = wgid / nig, fm = gid * WGM, gsz = (nM - fm) < WGM ? (nM - fm) : WGM;
        u.pm = fm + ((wgid % nig) % gsz); u.pn = (wgid % nig) / gsz; u.e = 0; u.aux = 0; return true;
    }
    DI unsigned arow(const Unit& u, int, int r) const { return (unsigned)(u.pm * BM + r); }
    DI unsigned bbase(const Unit& u) const { return (unsigned)u.pn * (unsigned)(BM * 2) * (unsigned)K; }
};
struct MoeSched {
    int K; const char* A; const char* Bt; const float* Bf0; const float* Bf1; unsigned bstride_e, bstride_pn; int npn, G, c; const LAS int* tile_e; const LAS int* tile_l; const LAS unsigned* rowtab; bool gather;
    int rt0, rt_end, rmax;
    int lin, L0, Lend, cl, Gl;
    DI bool unit_of(int i, int& rt, int& pn) const {
        if (i >= rmax) return false;
        if (lin) { if (cl < 0) return false; const int L = L0 + i * Gl + cl; rt = L / npn; pn = L - rt * npn; return L < Lend; }
        if (G % (8 * npn) == 0) { const int x = c & 7, j = c >> 3, per = G / (8 * npn); pn = j % npn; rt = rt0 + i * (G / npn) + per * x + j / npn; return rt < rt_end; }
        const int L = i * G + c; rt = rt0 + L / npn; pn = L % npn; return rt < rt_end;
    }
    DI bool next(int i, Unit& u) const {
        int rt, pn; if (!unit_of(i, rt, pn)) return false;
        u.pm = rt; u.pn = pn; u.e = __builtin_amdgcn_readfirstlane(tile_e[rt]); u.aux = __builtin_amdgcn_readfirstlane(tile_l[rt]); return true;
    }
    DI unsigned arow(const Unit& u, int ui, int r) const { return gather ? rowtab[ui * 256 + r] : (unsigned)(u.pm * BM + r); }
    DI unsigned bbase(const Unit& u) const { return (unsigned)u.e * bstride_e + (unsigned)u.pn * bstride_pn; }
};

struct EpiProj {
    static constexpr bool PERM = true;
    bf16* O; int ldc;
    DI void operator()(const f32x4 (&acc)[2][2][4][2], const Unit& u, int, int wr, int wc, int fr, int fq) const {
        const int row0 = u.pm * BM + wr * 64 + fr, col0 = u.pn * BM + wc * 32 + 8 * fq;
        const bool gate = u.pn >= 6 && u.pn < 9;
#pragma unroll
        for (int ai = 0; ai < 2; ++ai)
#pragma unroll
            for (int m = 0; m < 4; ++m) { bf16* rowp = O + (size_t)(row0 + ai * HALF + m * 16) * ldc + col0;
#pragma unroll
                for (int bj = 0; bj < 2; ++bj) { f32x4 v0 = acc[ai][bj][m][0], v1 = acc[ai][bj][m][1];
                    if (gate) {
#pragma unroll
                        for (int j = 0; j < 4; ++j) { v0[j] = fsilu(v0[j]); v1[j] = fsilu(v1[j]); } }
                    u32x4 w; w.x = pk2(v0[0], v0[1]); w.y = pk2(v0[2], v0[3]); w.z = pk2(v1[0], v1[1]); w.w = pk2(v1[2], v1[3]);
                    *(u32x4*)(rowp + bj * HALF) = w; } }
    }
};
struct EpiDelta {
    static constexpr bool PERM = true;
    bf16* O; const float* g;
    DI void operator()(const f32x4 (&acc)[2][2][4][2], const Unit& u, int, int wr, int wc, int fr, int fq) const {
        const int row0 = u.pm * BM + wr * 64 + fr, col0 = u.pn * BM + wc * 32 + 8 * fq;
        const float* gb = g + (size_t)(u.pm >> 3) * (6 * D) + col0;
        f32x4 gv[2][2];
#pragma unroll
        for (int bj = 0; bj < 2; ++bj)
#pragma unroll
            for (int n = 0; n < 2; ++n) gv[bj][n] = *(const f32x4*)(gb + bj * HALF + 4 * n);
#pragma unroll
        for (int ai = 0; ai < 2; ++ai)
#pragma unroll
            for (int m = 0; m < 4; ++m) { bf16* rowp = O + (size_t)(row0 + ai * HALF + m * 16) * D + col0;
#pragma unroll
                for (int bj = 0; bj < 2; ++bj) { const f32x4 v0 = acc[ai][bj][m][0] * gv[bj][0], v1 = acc[ai][bj][m][1] * gv[bj][1];
                    u32x4 w; w.x = pk2(v0[0], v0[1]); w.y = pk2(v0[2], v0[3]); w.z = pk2(v1[0], v1[1]); w.w = pk2(v1[2], v1[3]);
                    *(u32x4*)(rowp + bj * HALF) = w; } }
    }
};
struct EpiSwiglu {
    static constexpr bool PERM = true;
    bf16* O;
    DI void operator()(const f32x4 (&acc)[2][2][4][2], const Unit& u, int, int wr, int wc, int fr, int fq) const {
        const int row0 = u.pm * BM + wr * 64 + fr, col0 = u.pn * HALF + wc * 32 + 8 * fq;
#pragma unroll
        for (int ai = 0; ai < 2; ++ai)
#pragma unroll
            for (int m = 0; m < 4; ++m) { bf16* rowp = O + (size_t)(row0 + ai * HALF + m * 16) * DE + col0;
                float hv[8];
#pragma unroll
                for (int n = 0; n < 2; ++n)
#pragma unroll
                    for (int j = 0; j < 4; ++j) { const float a = acc[ai][0][m][n][j], b = acc[ai][1][m][n][j]; hv[4 * n + j] = fsilu(a) * b; }
                u32x4 w; w.x = pk2(hv[0], hv[1]); w.y = pk2(hv[2], hv[3]); w.z = pk2(hv[4], hv[5]); w.w = pk2(hv[6], hv[7]);
                *(u32x4*)rowp = w; }
    }
};
struct EpiY2 {
    static constexpr bool PERM = true;
    bf16* Y; const LAS int* rowtab;
    DI void operator()(const f32x4 (&acc)[2][2][4][2], const Unit& u, int ui, int wr, int wc, int fr, int fq) const {
        const int col0 = u.pn * BM + wc * 32 + 8 * fq;
#pragma unroll
        for (int ai = 0; ai < 2; ++ai)
#pragma unroll
            for (int m = 0; m < 4; ++m) { const int r = ai * HALF + wr * 64 + m * 16 + fr; const int a = rowtab[(ui * 256 + r) * 2]; const float wgt = __int_as_float(rowtab[(ui * 256 + r) * 2 + 1]);
                if (a >= 0) { bf16* rowp = Y + (size_t)a * D + col0;
#pragma unroll
                    for (int bj = 0; bj < 2; ++bj) { const f32x4 v0 = acc[ai][bj][m][0] * wgt, v1 = acc[ai][bj][m][1] * wgt;
                        u32x4 w; w.x = pk2(v0[0], v0[1]); w.y = pk2(v0[2], v0[3]); w.z = pk2(v1[0], v1[1]); w.w = pk2(v1[2], v1[3]);
                        *(u32x4*)(rowp + bj * HALF) = w; } } }
    }
};
}

struct Args { const float* in[32]; float* out; unsigned char* ws; int ph_lo, ph_hi, li, qset; };
struct Frame {
    LAS unsigned char* lds; volatile LAS unsigned* MISC; unsigned* ctl;
    int tid, lane, wave, G, vcu, qset, skip;
    const float* const* in; float* out; unsigned char* ws;
};
enum { I_X = 0, I_C, I_ADAW, I_ADAB, I_N1G, I_WIN, I_GWA2, I_GBA, I_GNG, I_LCW, I_LCB, I_LWA, I_LBA, I_LWX, I_LBX, I_LLAM, I_DLQ1, I_DLK1, I_DLQ2, I_DLK2, I_DSUB, I_RELB, I_WOUT, I_N2G,
       I_RGW, I_RGB, I_REW, I_REB, I_W1, I_W3, I_W2, I_FING };


constexpr int par_size(int id) {
    return id == I_N1G ? 4096 : id == I_GWA2 ? 12288 : id == I_GBA ? 768 : id == I_GNG ? 1536 : id == I_LCW ? 4096 : id == I_LCB ? 1024 : id == I_LWA ? 65536 : id == I_LBA ? 1024 : id == I_LWX ? 65536 :
           id == I_LBX ? 1024 : id == I_LLAM ? 1024 : (id >= I_DLQ1 && id <= I_DLK2) ? 128 : id == I_DSUB ? 256 : id == I_RELB ? 192 : id == I_N2G ? 4096 : id == I_RGB ? 16 : id == I_REB ? 128 : id == I_FING ? 2048 : 0;
}
constexpr int par_off(int id) { int o = 0; for (int i = 0; i < id; ++i) o += par_size(i); return o; }
constexpr int PAR_TOTAL = par_off(32);
#define PARP(id) ((const float*)(F.ws + WS_PAR) + par_off(id))
struct CvItem { const float* src; bf16* dst; unsigned ldsrc, lddst; int nvalid; };
DI void cv_load(const CvItem& ci, f32x4 (&v)[8], int lane) {
    const int kq = lane >> 3, c = lane & 7;
    if (4 * c < ci.nvalid) {
#pragma unroll
        for (int i = 0; i < 8; ++i) v[i] = __builtin_nontemporal_load((const f32x4*)(ci.src + (size_t)(8 * kq + i) * ci.ldsrc + 4 * c));
    } else {
#pragma unroll
        for (int i = 0; i < 8; ++i) v[i] = (f32x4){0.f, 0.f, 0.f, 0.f};
    }
}
DI void cv_store(const CvItem& ci, const f32x4 (&v)[8], int lane) {
    const int kq = lane >> 3, c = lane & 7;
#pragma unroll
    for (int q = 0; q < 4; ++q) { u32x4 o; o.x = pk2(v[0][q], v[1][q]); o.y = pk2(v[2][q], v[3][q]); o.z = pk2(v[4][q], v[5][q]); o.w = pk2(v[6][q], v[7][q]);
        __builtin_nontemporal_store(o, (u32x4*)(ci.dst + (size_t)(4 * c + q) * ci.lddst + 8 * kq)); }
}
DI CvItem moe_item(Frame& F, int l, int r) {
    CvItem c; c.nvalid = 32;
    if (r < 65536) {
        const int e = r / 1024, r2 = r % 1024, kb = r2 / 32, nb = r2 % 32, n0 = nb * 32, jt = n0 >> 8, rr = n0 & 255;
        const float* W = (rr < 128) ? F.in[I_W1] : F.in[I_W3];
        c.src = W + ((size_t)(l * NE + e) * D + kb * 64) * DE + jt * 128 + (rr & 127); c.ldsrc = DE;
        c.dst = (bf16*)(F.ws + WS_W13) + ((size_t)(l * NE + e) * 1024 + n0) * D + kb * 64; c.lddst = D;
    } else {
        r -= 65536; const int e = r / 512, r2 = r % 512, kb = r2 / 64, nb = r2 % 64;
        c.src = F.in[I_W2] + ((size_t)(l * NE + e) * DE + kb * 64) * D + nb * 32; c.ldsrc = D;
        c.dst = (bf16*)(F.ws + WS_W2) + ((size_t)(l * NE + e) * D + nb * 32) * DE + kb * 64; c.lddst = DE;
    }
    return c;
}
DI void moe_convert_wg(Frame& F, int l, int it) {
    const int r0 = it * 64 + F.wave, lane = F.lane;
    f32x4 va[8], vb[8], vc[8];
#define CV_L(buf, j) cv_load(moe_item(F, l, r0 + 8 * (j)), buf, lane)
#define CV_S(buf, j) cv_store(moe_item(F, l, r0 + 8 * (j)), buf, lane)
    CV_L(va, 0); CV_L(vb, 1); CV_L(vc, 2);
    CV_S(va, 0); CV_L(va, 3);
    CV_S(vb, 1); CV_L(vb, 4);
    CV_S(vc, 2); CV_L(vc, 5);
    CV_S(va, 3); CV_L(va, 6);
    CV_S(vb, 4); CV_L(vb, 7);
    CV_S(vc, 5); CV_S(va, 6); CV_S(vb, 7);
#undef CV_L
#undef CV_S
}
DI void p0_prologue(Frame& F) {
    const int tid = F.tid;
    {
        LAS float* SC = (LAS float*)F.lds;
        LAS float* RED = (LAS float*)(F.lds + 65536);
        const float* cin = F.in[I_C];
        for (int idx = tid; idx < NB * D; idx += 512) { const float c = cin[idx]; SC[idx] = fsilu(c); }
        __syncthreads();
        for (int tile = blockIdx.x; tile < 256; tile += F.G) {
            const int l = tile >> 7, col0 = (tile & 127) * 96;
            const int cg = tid % 24, rs = tid / 24;
            f32x4 acc[NB];
#pragma unroll
            for (int b = 0; b < NB; ++b) acc[b] = (f32x4){0.f, 0.f, 0.f, 0.f};
            if (tid < 504) {
                const float* wp = F.in[I_ADAW] + (size_t)l * D * (6 * D) + col0 + 4 * cg;
#pragma unroll 4
                for (int k = rs; k < D; k += 21) { const f32x4 w = __builtin_nontemporal_load((const f32x4*)(wp + (size_t)k * (6 * D)));
#pragma unroll
                    for (int b = 0; b < NB; ++b) acc[b] += SC[b * D + k] * w; }
#pragma unroll
                for (int b = 0; b < NB; ++b) *(LAS f32x4*)(RED + (rs * NB + b) * 96 + cg * 4) = acc[b];
            }
            __syncthreads();
            for (int idx = tid; idx < NB * 96; idx += 512) { const int b = idx / 96, cc = idx % 96; float s = F.in[I_ADAB][(size_t)l * 6 * D + col0 + cc];
                for (int r = 0; r < 21; ++r) s += RED[(r * NB + b) * 96 + cc];
                ((float*)(F.ws + WS_MOD))[(size_t)(l * NB + b) * (6 * D) + col0 + cc] = s; }
            __syncthreads();
        }
    }
    {
        const int gt = F.vcu * 512 + tid, NT_ = F.G * 512;
        float* PAR = (float*)(F.ws + WS_PAR);
#define PAR_COPY(id) for (int idx = gt; idx < par_size(id); idx += NT_) PAR[par_off(id) + idx] = F.in[id][idx];
        PAR_COPY(I_N1G) PAR_COPY(I_GWA2) PAR_COPY(I_GBA) PAR_COPY(I_GNG) PAR_COPY(I_LCW) PAR_COPY(I_LCB) PAR_COPY(I_LWA) PAR_COPY(I_LBA) PAR_COPY(I_LWX) PAR_COPY(I_LBX) PAR_COPY(I_LLAM)
        PAR_COPY(I_DLQ1) PAR_COPY(I_DLK1) PAR_COPY(I_DLQ2) PAR_COPY(I_DLK2) PAR_COPY(I_DSUB) PAR_COPY(I_RELB) PAR_COPY(I_N2G) PAR_COPY(I_RGB) PAR_COPY(I_REB) PAR_COPY(I_FING)
#undef PAR_COPY
    }
    {
        const int gt = F.vcu * 512 + tid, NT_ = F.G * 512;
        bf16* WR = (bf16*)(F.ws + WS_WR);
        for (int idx = gt; idx < NL * 80 * D; idx += NT_) { const int l = idx / (80 * D), rem = idx % (80 * D), n = rem / D, k = rem % D;
            float w = 0.f; if (n < 8) w = F.in[I_RGW][((size_t)l * D + k) * 8 + n]; else if (n < 72) w = F.in[I_REW][((size_t)l * D + k) * 64 + (n - 8)];
            const unsigned hi = pk2(w, 0.f) & 0xffffu; const float rem_ = w - bflo(hi); const unsigned lo = pk2(rem_, 0.f) & 0xffffu;
            WR[((size_t)(l * 2 + 0) * 80 + n) * D + k] = (bf16)hi; WR[((size_t)(l * 2 + 1) * 80 + n) * D + k] = (bf16)lo; }
    }
    {
        const int gw = F.vcu * 8 + F.wave, NGW = F.G * 8, lane = F.lane;
        constexpr int I_A = 32 * 184, I_B = 32 * 64, I_L = I_A + I_B;
        for (int it = gw; it < NL * I_L; it += NGW) {
            const int l = it / I_L; int r = it % I_L; CvItem ci;
            if (r < I_A) {
                const int kb = r / 184, nb = r % 184, n0 = nb * 32; int src0, nv;
                if (n0 < 2304) { src0 = n0; nv = 32; } else if (n0 < 5632) { src0 = n0 + 16; nv = 32; } else if (n0 == 5632) { src0 = 2304; nv = 16; } else { src0 = 0; nv = 0; }
                ci.src = F.in[I_WIN] + ((size_t)l * D + kb * 64) * INW + src0; ci.ldsrc = INW; ci.nvalid = nv; ci.dst = (bf16*)(F.ws + WS_WIN) + ((size_t)l * PLD + n0) * D + kb * 64; ci.lddst = D;
            } else {
                r -= I_A; const int kb = r / 64, nb = r % 64;
                ci.src = F.in[I_WOUT] + ((size_t)l * D + kb * 64) * D + nb * 32; ci.ldsrc = D; ci.nvalid = 32; ci.dst = (bf16*)(F.ws + WS_WOUT) + ((size_t)l * D + nb * 32) * D + kb * 64; ci.lddst = D;
            }
            f32x4 v[8]; cv_load(ci, v, lane); cv_store(ci, v, lane);
        }
    }
}

template <int MODE>
DI void p_norm(Frame& F) {
    const int gw = F.vcu * 8 + F.wave, NGW = F.G * 8, lane = F.lane;
    const float* MOD = (const float*)(F.ws + WS_MOD);
    float* H = (float*)(F.ws + WS_H);
    bf16* U = (bf16*)(F.ws + WS_U);
    const bf16* Y2 = (const bf16*)(F.ws + WS_Y2);
    constexpr int L = (MODE == 1) ? 1 : 0;
    constexpr int LP = (MODE == 1) ? 0 : 1;
    if (MODE != 2) {
        const bf16* WRH = (const bf16*)(F.ws + WS_WR) + (size_t)(L * 2 + 0) * 80 * D; const bf16* WRL = (const bf16*)(F.ws + WS_WR) + (size_t)(L * 2 + 1) * 80 * D;
        for (int o = gw; o < NB * 72; o += NGW) { const int b = o / 72, n = o % 72; const float* sh = MOD + (size_t)(L * NB + b) * 6 * D + 3 * D; float a = 0.f;
#pragma unroll
            for (int j = 0; j < 4; ++j) { const int k = 8 * lane + 512 * j; const u32x4 wh = *(const u32x4*)(WRH + (size_t)n * D + k), wl = *(const u32x4*)(WRL + (size_t)n * D + k);
                const f32x4 s0 = *(const f32x4*)(sh + k), s1 = *(const f32x4*)(sh + k + 4);
                a += s0[0] * (bflo(wh.x) + bflo(wl.x)) + s0[1] * (bfhi(wh.x) + bfhi(wl.x)) + s0[2] * (bflo(wh.y) + bflo(wl.y)) + s0[3] * (bfhi(wh.y) + bfhi(wl.y))
                   + s1[0] * (bflo(wh.z) + bflo(wl.z)) + s1[1] * (bfhi(wh.z) + bfhi(wl.z)) + s1[2] * (bflo(wh.w) + bflo(wl.w)) + s1[3] * (bfhi(wh.w) + bfhi(wl.w)); }
            a = wave_sum(a);
            if (lane == 0) ((float*)(F.ws + WS_CB))[(L * NB + b) * 80 + n] = a + ((n < 8) ? PARP(I_RGB)[L * 8 + n] : PARP(I_REB)[L * 64 + n - 8]); }
    }
    for (int row0 = gw * 8; row0 < T; row0 += NGW * 8) {
        const int b = row0 / SEQ;
        f32x4 gs[8], sh[8], g2[8];
#pragma unroll
        for (int j = 0; j < 8; ++j) { const int idx = 4 * lane + 256 * j;
            if (MODE == 2) { gs[j] = *(const f32x4*)(PARP(I_FING) + idx); sh[j] = (f32x4){0.f, 0.f, 0.f, 0.f}; }
            else { const f32x4 g = *(const f32x4*)(PARP(I_N1G) + (size_t)L * D + idx), sc = *(const f32x4*)(MOD + (size_t)(L * NB + b) * 6 * D + D + idx);
                gs[j] = g * (sc + 1.0f); sh[j] = *(const f32x4*)(MOD + (size_t)(L * NB + b) * 6 * D + idx); }
            if (MODE != 0) g2[j] = *(const f32x4*)(MOD + (size_t)(LP * NB + b) * 6 * D + 5 * D + idx); }
        for (int rr = 0; rr < 8; ++rr) {
            const int r = row0 + rr;
            f32x4 x[8]; float ss = 0.f;
#pragma unroll
            for (int j = 0; j < 8; ++j) { const int idx = 4 * lane + 256 * j;
                if (MODE == 0) x[j] = __builtin_nontemporal_load((const f32x4*)(F.in[I_X] + (size_t)r * D + idx));
                else { x[j] = *(const f32x4*)(H + (size_t)r * D + idx);
                    const u32x2 y0 = __builtin_nontemporal_load((const u32x2*)(Y2 + (size_t)(2 * r) * D + idx)), y1 = __builtin_nontemporal_load((const u32x2*)(Y2 + (size_t)(2 * r + 1) * D + idx));
                    f32x4 y; y[0] = bflo(y0.x) + bflo(y1.x); y[1] = bfhi(y0.x) + bfhi(y1.x); y[2] = bflo(y0.y) + bflo(y1.y); y[3] = bfhi(y0.y) + bfhi(y1.y);
                    x[j] += g2[j] * y; }
                ss += (x[j][0] * x[j][0] + x[j][1] * x[j][1]) + (x[j][2] * x[j][2] + x[j][3] * x[j][3]); }
            const float rs = __builtin_amdgcn_rsqf(wave_sum(ss) * (1.0f / D) + EPS);
#pragma unroll
            for (int j = 0; j < 8; ++j) { const int idx = 4 * lane + 256 * j;
                if (MODE == 2) { __builtin_nontemporal_store(x[j] * rs * gs[j], (f32x4*)(F.out + (size_t)r * D + idx)); }
                else { if (MODE != 0) *(f32x4*)(H + (size_t)r * D + idx) = x[j];
                    const f32x4 u = x[j] * rs * gs[j] + sh[j]; u32x2 w; w.x = pk2(u[0], u[1]); w.y = pk2(u[2], u[3]);
                    *(u32x2*)(U + (size_t)r * D + idx) = w; } }
        }
    }
}

DI void p_norm2_router(Frame& F, int l) {
    const int tid = F.tid, lane = F.lane, w = F.wave;
    const float* MOD = (const float*)(F.ws + WS_MOD);
    float* H = (float*)(F.ws + WS_H);
    const float* HIN = (l == 0) ? F.in[I_X] : (const float*)(F.ws + WS_H);
    const bf16* DELTA = (const bf16*)(F.ws + WS_DELTA);
    bf16* U = (bf16*)(F.ws + WS_U);
    const bf16* WRH = (const bf16*)(F.ws + WS_WR) + (size_t)(l * 2 + 0) * 80 * D;
    const bf16* WRL = (const bf16*)(F.ws + WS_WR) + (size_t)(l * 2 + 1) * 80 * D;
    int* LIST = (int*)(F.ws + WS_LIST);
    float* WT = (float*)(F.ws + WS_WT);
    unsigned* CNT = F.ctl + CW_CNT + 64 * l + 128 * F.qset;
    LAS float* PART = (LAS float*)F.lds;
    LAS float* SSQ = (LAS float*)(F.lds + 81920);
    LAS float* CBP = (LAS float*)(F.lds + 83968);
    LAS float* CB = (LAS float*)(F.lds + 102400);
    LAS float* LG = (LAS float*)(F.lds + 102912);
    LAS float* RS = (LAS float*)(F.lds + 121344);
    LAS unsigned* HIST = (LAS unsigned*)(F.lds + 121600);
    LAS unsigned* BASE = (LAS unsigned*)(F.lds + 121856);
    const float* G2 = PARP(I_N2G) + (size_t)l * D;
    for (int step = blockIdx.x; step < T / 64; step += F.G) {
        const int row0 = step * 64, b = row0 / SEQ;
        const float* SC = MOD + (size_t)(l * NB + b) * 6 * D + 4 * D;
        const float* SH = MOD + (size_t)(l * NB + b) * 6 * D + 3 * D;
        if (tid < 64) HIST[tid] = 0u;
        if (tid < 72) CB[tid] = ((const float*)(F.ws + WS_CB))[(l * NB + b) * 80 + tid];
        { const int r = lane & 15, kg = lane >> 4;
          f32x4 acc[4][5]; float ssq[4] = {0.f, 0.f, 0.f, 0.f};
#pragma unroll
          for (int rb = 0; rb < 4; ++rb)
#pragma unroll
              for (int nb = 0; nb < 5; ++nb) acc[rb][nb] = (f32x4){0.f, 0.f, 0.f, 0.f};
          const size_t ho0 = (size_t)(row0 + r) * D + 256 * w + 8 * kg;
#pragma unroll 1
          for (int kk = 0; kk < 8; ++kk) {
              const int k = 256 * w + 32 * kk + 8 * kg;
              f32x4 gs0, gs1;
              { const f32x4 g0 = *(const f32x4*)(G2 + k), g1 = *(const f32x4*)(G2 + k + 4), c0 = *(const f32x4*)(SC + k), c1 = *(const f32x4*)(SC + k + 4); gs0 = g0 * (c0 + 1.0f); gs1 = g1 * (c1 + 1.0f); }
              bf16x8 bh[5], bl[5];
#pragma unroll
              for (int nb = 0; nb < 5; ++nb) { bh[nb] = *(const bf16x8*)(WRH + (size_t)(nb * 16 + r) * D + k); bl[nb] = *(const bf16x8*)(WRL + (size_t)(nb * 16 + r) * D + k); }
#pragma unroll
              for (int rb = 0; rb < 4; ++rb) {
                  const size_t ho = ho0 + (size_t)(16 * rb) * D + 32 * kk; const u32x4 dl = *(const u32x4*)(DELTA + ho);
                  f32x4 x0 = *(const f32x4*)(HIN + ho), x1 = *(const f32x4*)(HIN + ho + 4);
                  x0[0] += bflo(dl.x); x0[1] += bfhi(dl.x); x0[2] += bflo(dl.y); x0[3] += bfhi(dl.y); x1[0] += bflo(dl.z); x1[1] += bfhi(dl.z); x1[2] += bflo(dl.w); x1[3] += bfhi(dl.w);
                  *(f32x4*)(H + ho) = x0; *(f32x4*)(H + ho + 4) = x1;
                  ssq[rb] += (x0[0] * x0[0] + x0[1] * x0[1]) + (x0[2] * x0[2] + x0[3] * x0[3]) + (x1[0] * x1[0] + x1[1] * x1[1]) + (x1[2] * x1[2] + x1[3] * x1[3]);
                  const f32x4 v0 = x0 * gs0, v1 = x1 * gs1;
                  u32x4 hi, lo;
                  hi.x = pk2(v0[0], v0[1]); hi.y = pk2(v0[2], v0[3]); hi.z = pk2(v1[0], v1[1]); hi.w = pk2(v1[2], v1[3]);
                  lo.x = pk2(v0[0] - bflo(hi.x), v0[1] - bfhi(hi.x)); lo.y = pk2(v0[2] - bflo(hi.y), v0[3] - bfhi(hi.y)); lo.z = pk2(v1[0] - bflo(hi.z), v1[1] - bfhi(hi.z)); lo.w = pk2(v1[2] - bflo(hi.w), v1[3] - bfhi(hi.w));
                  const bf16x8 ah = __builtin_bit_cast(bf16x8, hi), al = __builtin_bit_cast(bf16x8, lo);
#pragma unroll
                  for (int nb = 0; nb < 5; ++nb) {
                      acc[rb][nb] = __builtin_amdgcn_mfma_f32_16x16x32_bf16(ah, bh[nb], acc[rb][nb], 0, 0, 0);
                      acc[rb][nb] = __builtin_amdgcn_mfma_f32_16x16x32_bf16(ah, bl[nb], acc[rb][nb], 0, 0, 0);
                      acc[rb][nb] = __builtin_amdgcn_mfma_f32_16x16x32_bf16(al, bh[nb], acc[rb][nb], 0, 0, 0); } } }
#pragma unroll
          for (int rb = 0; rb < 4; ++rb) { float s = ssq[rb]; s += __shfl_xor(s, 16); s += __shfl_xor(s, 32); if (kg == 0) SSQ[w * 64 + 16 * rb + r] = s; }
          if (w >= 4) {
#pragma unroll
              for (int rb = 0; rb < 4; ++rb)
#pragma unroll
                  for (int nb = 0; nb < 5; ++nb)
#pragma unroll
                      for (int j = 0; j < 4; ++j) PART[((w - 4) * 64 + 16 * rb + 4 * kg + j) * 80 + nb * 16 + r] = acc[rb][nb][j]; }
          __syncthreads();
          if (w < 4) {
#pragma unroll
              for (int rb = 0; rb < 4; ++rb)
#pragma unroll
                  for (int nb = 0; nb < 5; ++nb)
#pragma unroll
                      for (int j = 0; j < 4; ++j) { const int pi = (w * 64 + 16 * rb + 4 * kg + j) * 80 + nb * 16 + r; PART[pi] += acc[rb][nb][j]; } } }
        __syncthreads();
        for (int idx = tid; idx < 64 * 72; idx += 512) { const int row = idx / 72, n = idx % 72;
            float s = 0.f, ss = 0.f;
#pragma unroll
            for (int q = 0; q < 4; ++q) s += PART[(q * 64 + row) * 80 + n];
#pragma unroll
            for (int q = 0; q < 8; ++q) ss += SSQ[q * 64 + row];
            const float rs = __builtin_amdgcn_rsqf(ss * (1.0f / D) + EPS);
            LG[row * 72 + n] = rs * s + CB[n]; if (n == 0) RS[row] = rs; }
        __syncthreads();
        int e0 = 0, e1 = 0; unsigned rk0 = 0, rk1 = 0; float wt0 = 0.f, wt1 = 0.f;
        if (tid < 64) {
            const LAS float* lg = LG + tid * 72;
            int gi = 0; float gm = lg[0];
#pragma unroll
            for (int j = 1; j < 8; ++j) if (lg[j] > gm) { gm = lg[j]; gi = j; }
            float gsum = 0.f;
#pragma unroll
            for (int j = 0; j < 8; ++j) gsum += __expf(lg[j] - gm);
            const float gw = 1.0f / gsum;
            const LAS float* el = lg + 8 + gi * 8;
            int i0 = 0; float v0 = el[0];
#pragma unroll
            for (int j = 1; j < 8; ++j) if (el[j] > v0) { v0 = el[j]; i0 = j; }
            int i1 = -1; float v1 = -3.0e38f;
#pragma unroll
            for (int j = 0; j < 8; ++j) if (j != i0 && el[j] > v1) { v1 = el[j]; i1 = j; }
            const float ex = __expf(v1 - v0), w0 = 1.0f / (1.0f + ex), w1 = ex * w0;
            e0 = gi * 8 + i0; e1 = gi * 8 + i1; wt0 = gw * w0; wt1 = gw * w1;
            rk0 = __hip_atomic_fetch_add(HIST + e0, 1u, __ATOMIC_RELAXED, __HIP_MEMORY_SCOPE_WORKGROUP); rk1 = __hip_atomic_fetch_add(HIST + e1, 1u, __ATOMIC_RELAXED, __HIP_MEMORY_SCOPE_WORKGROUP);
        }
        __syncthreads();
        if (tid < 64) { int tt = tid; asm volatile("" : "+v"(tt)); const unsigned n = HIST[tt]; BASE[tt] = n ? atomicAdd(CNT + tt, n) : 0u; }
        __syncthreads();
        if (tid < 64) { const int tok = row0 + tid;
            LIST[e0 * 16384 + BASE[e0] + rk0] = tok * 2; LIST[e1 * 16384 + BASE[e1] + rk1] = tok * 2 + 1;
            WT[tok * 2] = wt0; WT[tok * 2 + 1] = wt1; }
        { f32x4 gs[8], sh[8];
#pragma unroll
          for (int j = 0; j < 8; ++j) { const int idx = 4 * lane + 256 * j; gs[j] = *(const f32x4*)(G2 + idx) * (*(const f32x4*)(SC + idx) + 1.0f); sh[j] = *(const f32x4*)(SH + idx); }
          for (int i = 0; i < 8; ++i) { const int rl = 8 * w + i; const float rs = RS[rl];
#pragma unroll
              for (int j = 0; j < 8; ++j) { const int idx = 4 * lane + 256 * j; const f32x4 x = *(const f32x4*)(H + (size_t)(row0 + rl) * D + idx);
                  const f32x4 u = x * rs * gs[j] + sh[j]; u32x2 wv; wv.x = pk2(u[0], u[1]); wv.y = pk2(u[2], u[3]);
                  *(u32x2*)(U + (size_t)(row0 + rl) * D + idx) = wv; } } }
        __syncthreads();
    }
}

DI int moe_tiles(Frame& F, int l) {
    LAS int* TE = (LAS int*)(F.lds + TILETAB_OFF); LAS int* TL = TE + 192; LAS int* CN = TE + 384;
    __syncthreads();
    if (F.tid < 64) CN[F.tid] = (int)__hip_atomic_load(F.ctl + CW_CNT + 64 * l + 128 * F.qset + F.tid, __ATOMIC_RELAXED, __HIP_MEMORY_SCOPE_AGENT);
    __syncthreads();
    if (F.tid == 0) { int nt = 0; for (int e = 0; e < 64; ++e) { const int n = (CN[e] + 255) >> 8; for (int j = 0; j < n && nt < 192; ++j) { TE[nt] = e; TL[nt] = j; ++nt; } } CN[64] = nt; }
    __syncthreads();
    return CN[64];
}


DI unsigned offb(unsigned row, unsigned ch) { return 256u * row + 16u * (ch ^ (((row & 3u) << 2) | ((row >> 2) & 3u))); }
DI int swap23(int r) { return (r & ~12) | ((r & 4) << 1) | ((r & 8) >> 1); }
DI int t5_bucket(int rel) {
    const int ret = rel > 0 ? 16 : 0; const int n = rel < 0 ? -rel : rel;
    if (n < 8) return ret + n;
    const float v = logf((float)n * 0.125f) / 2.7725887f * 8.0f;
    int large = 8 + (int)(v + 1e-5f); if (large > 15) large = 15;
    return ret + large;
}
DI int dequeue(Frame& F, unsigned* q) {
    __syncthreads();
    if (F.tid == 0) F.MISC[2] = atomicAdd(q, 1u);
    __syncthreads();
    return (int)F.MISC[2];
}
DI s16x4 tr_read(const LAS unsigned char* p) { return __builtin_bit_cast(s16x4, __builtin_amdgcn_ds_read_tr16_b64_v4i16((LAS s16x4*)p)); }
DI bf16x8 cat8(s16x4 lo, s16x4 hi) { return __builtin_shufflevector(lo, hi, 0, 1, 2, 3, 4, 5, 6, 7); }
DI bf16x8 pack8(float a0, float a1, float a2, float a3, float a4, float a5, float a6, float a7) { u32x4 p; p.x = pk2(a0, a1); p.y = pk2(a2, a3); p.z = pk2(a4, a5); p.w = pk2(a6, a7); return __builtin_bit_cast(bf16x8, p); }
#define MFMA32(a, b, c) __builtin_amdgcn_mfma_f32_32x32x16_bf16((a), (b), (c), 0, 0, 0)
DI float vmax(float a, float b) { float r; asm("v_max_f32 %0, %1, %2" : "=v"(r) : "v"(a), "v"(b)); return r; }
DI float vmax3(float a, float b, float c) { float r; asm("v_max3_f32 %0, %1, %2, %3" : "=v"(r) : "v"(a), "v"(b), "v"(c)); return r; }

DI void attn_unit(Frame& F, int l, int b, int hh, int qb, float lam, float cfin) {
    int tid = F.tid, lane = F.lane; const int w = F.wave;
    asm volatile("" : "+v"(tid), "+v"(lane));
    const int map = w >> 2, wq = w & 3;
    const bf16* PROJ = (const bf16*)(F.ws + WS_PROJ);
    bf16* MIX = (bf16*)(F.ws + WS_MIX);
    LAS unsigned char* lds = F.lds;
    constexpr int TABOFF = 98304;
    LAS float* TAB2 = (LAS float*)(lds + TABOFF);
    const int tokbase = b * SEQ;
    const int q0 = qb * 128 + wq * 32, cq = q0 >> 6, ntiles = 2 * qb + 2;
    if (tid < 255) TAB2[tid] = PARP(I_RELB)[t5_bucket(tid - 191) * 6 + hh] * LOG2E;
    LAS float* SGL = (LAS float*)(lds + TABOFF + 1024);
    if (tid >= 256 && tid < 384) SGL[tid - 256] = PARP(I_DSUB)[l * 128 + tid - 256];
    const float far2 = PARP(I_RELB)[15 * 6 + hh] * LOG2E;
    const int h_ = lane >> 5, blk = (lane >> 4) & 1, qq = (lane & 15) >> 2, pp = lane & 3;
    bf16x8 Qf[4];
    { const bf16* qp = PROJ + (size_t)(tokbase + q0 + (lane & 31)) * PLD + C_DQ + hh * 128 + map * 64 + 8 * h_;
#pragma unroll
      for (int s = 0; s < 4; ++s) Qf[s] = *(const bf16x8*)(qp + 16 * s); }
    unsigned srcK[2], srcV[2];
#pragma unroll
    for (int pi = 0; pi < 2; ++pi) { const int p = 2 * w + pi, row = 4 * p + (lane >> 4), pc = lane & 15, ch = pc ^ (((row & 3) << 2) | ((row >> 2) & 3));
        srcK[pi] = (unsigned)((tokbase + row) * PLD + C_DK + hh * 128 + 8 * ch);
        srcV[pi] = (unsigned)((tokbase + swap23(row)) * PLD + C_DV + hh * 128 + 8 * ch); }
#define ATT_STAGE(kt) do { const unsigned ko = (unsigned)(kt) * 64u * PLD; const int st_ = ((kt) % 3) * 32768; _Pragma("unroll") for (int pi = 0; pi < 2; ++pi) { \
        __builtin_amdgcn_global_load_lds((const unsigned*)(PROJ + (size_t)(srcK[pi] + ko)), (LAS unsigned*)(lds + st_ + (2 * w + pi) * 1024), 16, 0, 0); \
        __builtin_amdgcn_global_load_lds((const unsigned*)(PROJ + (size_t)(srcV[pi] + ko)), (LAS unsigned*)(lds + st_ + 16384 + (2 * w + pi) * 1024), 16, 0, 0); } } while (0)
    unsigned kad[4], vad[2][4];
#pragma unroll
    for (int s = 0; s < 4; ++s) kad[s] = offb(lane & 31, 8 * map + 2 * s + h_);
#pragma unroll
    for (int t = 0; t < 2; ++t)
#pragma unroll
        for (int c = 0; c < 4; ++c) vad[t][c] = offb(8 * h_ + 4 * t + qq, 4 * c + 2 * blk + (pp >> 1)) + 8 * (pp & 1);
    f32x16 O[4];
#pragma unroll
    for (int c = 0; c < 4; ++c)
#pragma unroll
        for (int r = 0; r < 16; ++r) O[c][r] = 0.f;
    float m = -1.0e30f, lsum = 0.f;
    constexpr float C1 = 0.125f * LOG2E, THR = 8.0f;
    f32x16 S0, S1;
    bf16x8 Pf[4];
#define ATT_QK(kt) do { const LAS unsigned char* Kb = lds + ((kt) % 3) * 32768; \
        const LAS unsigned char* kp[4]; _Pragma("unroll") for (int s4 = 0; s4 < 4; ++s4) { kp[s4] = Kb + kad[s4]; asm volatile("" : "+v"(kp[s4])); } \
        _Pragma("unroll") for (int r = 0; r < 16; ++r) { S0[r] = 0.f; S1[r] = 0.f; } \
        bf16x8 kf[4][2]; _Pragma("unroll") for (int s4 = 0; s4 < 4; ++s4) { kf[s4][0] = *(const LAS bf16x8*)(kp[s4]); kf[s4][1] = *(const LAS bf16x8*)(kp[s4] + 8192); } \
        _Pragma("unroll") for (int s4 = 0; s4 < 4; ++s4) { S0 = MFMA32(kf[s4][0], Qf[s4], S0); S1 = MFMA32(kf[s4][1], Qf[s4], S1); } } while (0)
#define ATT_PV(kt) do { const LAS unsigned char* Vb = lds + ((kt) % 3) * 32768 + 16384; \
        _Pragma("unroll") for (int c2 = 0; c2 < 4; c2 += 2) { bf16x8 vf[2][4]; \
            _Pragma("unroll") for (int cc = 0; cc < 2; ++cc) { const LAS unsigned char* vp0 = Vb + vad[0][c2 + cc]; const LAS unsigned char* vp1 = Vb + vad[1][c2 + cc]; asm volatile("" : "+v"(vp0), "+v"(vp1)); \
                _Pragma("unroll") for (int ks = 0; ks < 4; ++ks) vf[cc][ks] = cat8(tr_read(vp0 + 4096 * ks), tr_read(vp1 + 4096 * ks)); } \
            _Pragma("unroll") for (int cc = 0; cc < 2; ++cc) _Pragma("unroll") for (int ks = 0; ks < 4; ++ks) O[c2 + cc] = MFMA32(vf[cc][ks], Pf[ks], O[c2 + cc]); } } while (0)
#define ATT_SM(kt, PN) do { \
        const bool nearT = (kt) >= cq - 2; float mx; \
        if (nearT) { const int idx0 = 64 * (kt) - q0 - (lane & 31) + 4 * h_ + 191; \
            _Pragma("unroll") for (int r = 0; r < 16; ++r) { const int cr = (r & 3) + 8 * (r >> 2); S0[r] = S0[r] * C1 + TAB2[idx0 + cr]; S1[r] = S1[r] * C1 + TAB2[idx0 + 32 + cr]; } } \
        mx = vmax(S0[0], S1[0]); \
        _Pragma("unroll") for (int r = 1; r < 16; ++r) mx = vmax3(mx, S0[r], S1[r]); \
        if (!nearT) mx = mx * C1 + far2; \
        mx = vmax(mx, __shfl_xor(mx, 32)); \
        float alpha = 1.0f; const bool resc = __any(mx > m + THR); \
        if (resc) { const float mn = vmax(m, mx); alpha = __builtin_amdgcn_exp2f(m - mn); m = mn; } \
        float rsum = 0.f; \
        if (nearT) { _Pragma("unroll") for (int r = 0; r < 16; ++r) { S0[r] = __builtin_amdgcn_exp2f(S0[r] - m); S1[r] = __builtin_amdgcn_exp2f(S1[r] - m); rsum += S0[r] + S1[r]; } } \
        else { const float nb = far2 - m; _Pragma("unroll") for (int r = 0; r < 16; ++r) { S0[r] = __builtin_amdgcn_exp2f(__builtin_fmaf(S0[r], C1, nb)); S1[r] = __builtin_amdgcn_exp2f(__builtin_fmaf(S1[r], C1, nb)); rsum += S0[r] + S1[r]; } } \
        PN[0] = pack8(S0[0], S0[1], S0[2], S0[3], S0[4], S0[5], S0[6], S0[7]); PN[1] = pack8(S0[8], S0[9], S0[10], S0[11], S0[12], S0[13], S0[14], S0[15]); \
        PN[2] = pack8(S1[0], S1[1], S1[2], S1[3], S1[4], S1[5], S1[6], S1[7]); PN[3] = pack8(S1[8], S1[9], S1[10], S1[11], S1[12], S1[13], S1[14], S1[15]); \
        lsum = lsum * alpha + rsum; \
        if (resc) { _Pragma("unroll") for (int c = 0; c < 4; ++c) _Pragma("unroll") for (int r = 0; r < 16; ++r) O[c][r] *= alpha; } } while (0)
    ATT_STAGE(0); ATT_STAGE(1);
    asm volatile("s_waitcnt vmcnt(4)" ::: "memory"); LBAR();
    for (int kt = 0; kt < ntiles; ++kt) {
        const bool more = kt + 2 < ntiles;
        if (more) ATT_STAGE(kt + 2);
        if (kt <= cq) { ATT_QK(kt); ATT_SM(kt, Pf); ATT_PV(kt); }
        if (more) asm volatile("s_waitcnt vmcnt(4)" ::: "memory"); else asm volatile("s_waitcnt vmcnt(0)" ::: "memory");
        LBAR();
    }
#undef ATT_STAGE
#undef ATT_QK
#undef ATT_PV
#undef ATT_SM
    const float ltot = lsum + __shfl_xor(lsum, 32), inv = 1.0f / ltot;
    LAS float* COMB = (LAS float*)lds;
    if (map == 1) {
#pragma unroll
        for (int c = 0; c < 4; ++c)
#pragma unroll
            for (int r = 0; r < 16; ++r) COMB[(wq * 64 + c * 16 + r) * 64 + lane] = O[c][r] * inv;
    }
    __syncthreads();
    if (map == 0) {
        float ss = 0.f;
#pragma unroll
        for (int c = 0; c < 4; ++c)
#pragma unroll
            for (int r = 0; r < 16; ++r) { const float o = O[c][r] * inv - lam * COMB[(wq * 64 + c * 16 + r) * 64 + lane]; O[c][r] = o; ss += o * o; }
        ss += __shfl_xor(ss, 32);
        const float rms = cfin * __builtin_amdgcn_rsqf(ss * (1.0f / 128.0f) + EPS);
        bf16* op = MIX + (size_t)(tokbase + q0 + (lane & 31)) * D + 1280 + hh * 128 + 4 * h_;
        const LAS float* sg = SGL + 4 * h_;
#pragma unroll
        for (int c = 0; c < 4; ++c)
#pragma unroll
            for (int g = 0; g < 4; ++g) { const f32x4 gv = *(const LAS f32x4*)(sg + 32 * c + 8 * g);
                u32x2 wv; wv.x = pk2(O[c][4 * g] * rms * gv[0], O[c][4 * g + 1] * rms * gv[1]); wv.y = pk2(O[c][4 * g + 2] * rms * gv[2], O[c][4 * g + 3] * rms * gv[3]);
                *(u32x2*)(op + 32 * c + 8 * g) = wv; }
    }
    __syncthreads();
}

constexpr int GL_G = 0, GL_QN = 16384, GL_KF = 25600, GL_KN = 34816, GL_OP = 0, GL_QF = 44032, GL_KD = 53248, GL_AM = 62464, GL_VV = 71680, GL_SS = 89088, GL_ALR = 106496, GL_DEC = 110592, GL_SEG = 110848, GL_GL = 112896, GL_GNG = 113664, GL_ALRB = 134144, GL_WA2H = 108544, GL_WA2L = 114688, GL_Z = 116736;
DI void gla_unit(Frame& F, int l, int b, int hh) {
    const int tid = F.tid, lane = F.lane, w = F.wave;
    const bf16* PROJ = (const bf16*)(F.ws + WS_PROJ);
    bf16* MIX = (bf16*)(F.ws + WS_MIX);
    LAS unsigned char* lds = F.lds;
    LAS float* G = (LAS float*)(lds + GL_G); LAS float* OP = (LAS float*)(lds + GL_OP); LAS float* ALR = (LAS float*)(lds + GL_ALR);
    LAS float* DEC = (LAS float*)(lds + GL_DEC); LAS float* SEG = (LAS float*)(lds + GL_SEG); LAS float* GLL = (LAS float*)(lds + GL_GL);
    const int tokbase = b * SEQ;
    const int ta = tid >> 3, dg = tid & 7;
    const int cd = tid & 63, seg = tid >> 6;
    const int h_ = lane >> 5, blk = (lane >> 4) & 1, qq = (lane & 15) >> 2, pp = lane & 3;
    for (int i = tid; i < 1024; i += 512) { const int ch = i >> 4, r = i & 15; const float wv = PARP(I_GWA2)[((size_t)l * 16 + r) * 384 + hh * 64 + ch];
        const unsigned hi = pk2(wv, 0.f) & 0xffffu; const float res = wv - __uint_as_float(hi << 16);
        *(LAS bf16*)(lds + GL_WA2H + i * 2) = (bf16)hi; *(LAS bf16*)(lds + GL_WA2L + i * 2) = (bf16)(pk2(res, 0.f) & 0xffffu); }
    LAS float* Zf = (LAS float*)(lds + GL_Z);
    const int t2 = tid - 256;
    const bool a_lane = t2 >= 0 && t2 < 128;
#define GLA_ZSTAGE() do { if (w < 4) { const int tb_ = w >> 1, cb_ = w & 1; f32x16 z_; _Pragma("unroll") for (int r = 0; r < 16; ++r) z_[r] = 0.f; \
        const bf16x8 bA_ = *(const LAS bf16x8*)(lds + GL_ALRB + (32 * tb_ + (lane & 31)) * 32 + 16 * h_); \
        z_ = MFMA32(*(const LAS bf16x8*)(lds + GL_WA2H + (32 * cb_ + (lane & 31)) * 32 + 16 * h_), bA_, z_); \
        z_ = MFMA32(*(const LAS bf16x8*)(lds + GL_WA2L + (32 * cb_ + (lane & 31)) * 32 + 16 * h_), bA_, z_); \
        _Pragma("unroll") for (int g = 0; g < 4; ++g) *(LAS f32x4*)(Zf + (32 * tb_ + (lane & 31)) * 68 + 32 * cb_ + 8 * g + 4 * h_) = (f32x4){z_[4 * g], z_[4 * g + 1], z_[4 * g + 2], z_[4 * g + 3]}; } } while (0)
    LAS float* GNL = (LAS float*)(lds + GL_GNG);
    if (tid < 128) GNL[tid] = PARP(I_GNG)[l * 768 + hh * 128 + tid];
    const float ba = PARP(I_GBA)[l * 384 + hh * 64 + cd];
    f32x16 Sacc;
#pragma unroll
    for (int r = 0; r < 16; ++r) Sacc[r] = 0.f;
    const int sdb = w >> 2, svb = w & 3;
    for (int i = tid; i < 128 * 144 / 4; i += 512) ((LAS unsigned*)(lds + GL_SS))[i] = 0u;
    u32x4 nq, nk, nv0, nv1, nog0, nog1, na;
    {
        const bf16* rp = PROJ + (size_t)(tokbase + ta) * PLD;
        nq = *(const u32x4*)(rp + C_GQ + hh * 64 + 8 * dg); nk = *(const u32x4*)(rp + C_GK + hh * 64 + 8 * dg);
        nv0 = *(const u32x4*)(rp + C_GV + hh * 128 + 16 * dg); nv1 = *(const u32x4*)(rp + C_GV + hh * 128 + 16 * dg + 8);
        nog0 = *(const u32x4*)(rp + C_GOG + hh * 128 + 16 * dg); nog1 = *(const u32x4*)(rp + C_GOG + hh * 128 + 16 * dg + 8);
        na = a_lane ? *(const u32x4*)(PROJ + (size_t)(tokbase + (t2 >> 1)) * PLD + C_GA + 8 * (t2 & 1)) : (u32x4){0u, 0u, 0u, 0u};
    }
#define GLA_ALR_WRITE() do { if (a_lane) *(LAS u32x4*)(lds + GL_ALRB + t2 * 16) = na; } while (0)
    GLA_ALR_WRITE();
    LBAR();
    GLA_ZSTAGE();
    LBAR();
    for (int n = 0; n < 32; ++n) {
        const int tok0 = tokbase + 64 * n;
        const u32x4 cq_ = nq, ck_ = nk, cv0 = nv0, cv1 = nv1;
        float g8[8]; float run = 0.f;
#pragma unroll
        for (int tt = 0; tt < 8; ++tt) { const float x = ba + Zf[(8 * seg + tt) * 68 + cd];
            const float ls = fminf(x, 0.f) - __logf(1.0f + __expf(-fabsf(x)));
            run += ls * (1.0f / 16.0f); g8[tt] = run; }
        SEG[seg * 64 + cd] = run;
        LBAR();
        { float off = 0.f;
#pragma unroll
          for (int s2 = 0; s2 < 8; ++s2) off += (s2 < seg) ? SEG[s2 * 64 + cd] : 0.f;
#pragma unroll
          for (int tt = 0; tt < 8; ++tt) G[(8 * seg + tt) * 64 + cd] = g8[tt] + off;
          if (seg == 7) DEC[cd] = __expf(g8[7] + off); }
        if (n + 1 < 32) { const bf16* rp = PROJ + (size_t)(tok0 + 64 + ta) * PLD;
            nq = *(const u32x4*)(rp + C_GQ + hh * 64 + 8 * dg); nk = *(const u32x4*)(rp + C_GK + hh * 64 + 8 * dg);
            nv0 = *(const u32x4*)(rp + C_GV + hh * 128 + 16 * dg); nv1 = *(const u32x4*)(rp + C_GV + hh * 128 + 16 * dg + 8);
            if (a_lane) na = *(const u32x4*)(PROJ + (size_t)(tok0 + 64 + (t2 >> 1)) * PLD + C_GA + 8 * (t2 & 1)); }
        LBAR();
        {
            const float qv[8] = {bflo(cq_.x), bfhi(cq_.x), bflo(cq_.y), bfhi(cq_.y), bflo(cq_.z), bfhi(cq_.z), bflo(cq_.w), bfhi(cq_.w)};
            const float kv[8] = {bflo(ck_.x), bfhi(ck_.x), bflo(ck_.y), bfhi(ck_.y), bflo(ck_.z), bfhi(ck_.z), bflo(ck_.w), bfhi(ck_.w)};
            float qf[8], qn[8], kf[8], kn[8], kd[8];
#pragma unroll
            for (int j = 0; j < 8; ++j) { const float g = G[ta * 64 + 8 * dg + j]; const float eg = __expf(g), eng = __expf(-g), ed = DEC[8 * dg + j] * eng;
                qf[j] = qv[j] * 0.125f * eg; qn[j] = qv[j] * 0.125f * eng; kf[j] = kv[j] * eg; kn[j] = kv[j] * eng; kd[j] = kv[j] * ed; }
            const int to = ta * 144 + 16 * dg;
            *(LAS bf16x8*)(lds + GL_QF + to) = pack8(qf[0], qf[1], qf[2], qf[3], qf[4], qf[5], qf[6], qf[7]);
            *(LAS bf16x8*)(lds + GL_QN + to) = pack8(qn[0], qn[1], qn[2], qn[3], qn[4], qn[5], qn[6], qn[7]);
            *(LAS bf16x8*)(lds + GL_KF + to) = pack8(kf[0], kf[1], kf[2], kf[3], kf[4], kf[5], kf[6], kf[7]);
            *(LAS bf16x8*)(lds + GL_KN + to) = pack8(kn[0], kn[1], kn[2], kn[3], kn[4], kn[5], kn[6], kn[7]);
            *(LAS bf16x8*)(lds + GL_KD + to) = pack8(kd[0], kd[1], kd[2], kd[3], kd[4], kd[5], kd[6], kd[7]);
            *(LAS u32x4*)(lds + GL_VV + ta * 272 + 32 * dg) = cv0; *(LAS u32x4*)(lds + GL_VV + ta * 272 + 32 * dg + 16) = cv1;
        }
        LBAR();
        if (w < 4) {
            const int ib = w >> 1, jb = w & 1;
            f32x16 cf, cb_;
#pragma unroll
            for (int r = 0; r < 16; ++r) { cf[r] = 0.f; cb_[r] = 0.f; }
            const int ra = (32 * jb + (lane & 31)) * 144 + 16 * h_, rb = (32 * ib + (lane & 31)) * 144 + 16 * h_;
            if (jb <= ib) {
#pragma unroll
                for (int s = 0; s < 4; ++s) cf = MFMA32(*(const LAS bf16x8*)(lds + GL_KN + ra + 32 * s), *(const LAS bf16x8*)(lds + GL_QF + rb + 32 * s), cf); }
            if (jb >= ib) {
#pragma unroll
                for (int s = 0; s < 4; ++s) cb_ = MFMA32(*(const LAS bf16x8*)(lds + GL_KF + ra + 32 * s), *(const LAS bf16x8*)(lds + GL_QN + rb + 32 * s), cb_); }
            const int i_ = 32 * ib + (lane & 31);
#pragma unroll
            for (int g = 0; g < 4; ++g) { float v[4];
#pragma unroll
                for (int j = 0; j < 4; ++j) { const int jj = 32 * jb + 8 * g + 4 * h_ + j; v[j] = (jj <= i_) ? cf[4 * g + j] : cb_[4 * g + j]; }
                u32x2 wv; wv.x = pk2(v[0], v[1]); wv.y = pk2(v[2], v[3]);
                *(LAS u32x2*)(lds + GL_AM + i_ * 144 + (32 * jb + 8 * g + 4 * h_) * 2) = wv; }
        } else { GLA_ALR_WRITE(); }
        LBAR();
        {
            const int ib = w >> 2, vb = w & 3;
            bf16x8 vvf[4];
#pragma unroll
            for (int ks = 0; ks < 4; ++ks) { const LAS unsigned char* p0 = lds + GL_VV + (16 * ks + 8 * h_ + qq) * 272 + (32 * vb + 16 * blk + 4 * pp) * 2; vvf[ks] = cat8(tr_read(p0), tr_read(p0 + 4 * 272)); }
            f32x16 o;
#pragma unroll
            for (int r = 0; r < 16; ++r) o[r] = 0.f;
            const int ra = (32 * ib + (lane & 31)) * 144 + 16 * h_;
#pragma unroll
            for (int ks = 0; ks < 4; ++ks) o = MFMA32(*(const LAS bf16x8*)(lds + GL_AM + ra + 32 * ks), vvf[ks], o);
#pragma unroll
            for (int ks = 0; ks < 4; ++ks) o = MFMA32(*(const LAS bf16x8*)(lds + GL_QF + ra + 32 * ks), *(const LAS bf16x8*)(lds + GL_SS + (32 * vb + (lane & 31)) * 144 + 16 * h_ + 32 * ks), o);
#pragma unroll
            for (int r = 0; r < 16; ++r) Sacc[r] *= DEC[32 * sdb + (r & 3) + 8 * (r >> 2) + 4 * h_];
#pragma unroll
            for (int ks = 0; ks < 4; ++ks) { const LAS unsigned char* p0 = lds + GL_KD + (16 * ks + 8 * h_ + qq) * 144 + (32 * sdb + 16 * blk + 4 * pp) * 2;
                Sacc = MFMA32(cat8(tr_read(p0), tr_read(p0 + 4 * 144)), vvf[ks], Sacc); }
            GLA_ZSTAGE();
            LBAR();
#pragma unroll
            for (int r = 0; r < 16; ++r) { const int rr = (r & 3) + 8 * (r >> 2) + 4 * h_;
                OP[(32 * ib + rr) * 132 + 32 * vb + (lane & 31)] = o[r]; }
#pragma unroll
            for (int g = 0; g < 4; ++g) { u32x2 sv; sv.x = pk2(Sacc[4 * g], Sacc[4 * g + 1]); sv.y = pk2(Sacc[4 * g + 2], Sacc[4 * g + 3]);
                *(LAS u32x2*)(lds + GL_SS + (32 * svb + (lane & 31)) * 144 + (32 * sdb + 8 * g + 4 * h_) * 2) = sv; }
        }
        LBAR();
        {
            f32x4 ov[4]; float ss = 0.f;
#pragma unroll
            for (int j = 0; j < 4; ++j) { ov[j] = *(const LAS f32x4*)(OP + ta * 132 + 16 * dg + 4 * j); ss += (ov[j][0] * ov[j][0] + ov[j][1] * ov[j][1]) + (ov[j][2] * ov[j][2] + ov[j][3] * ov[j][3]); }
            ss += __shfl_xor(ss, 1); ss += __shfl_xor(ss, 2); ss += __shfl_xor(ss, 4);
            const float rms = __builtin_amdgcn_rsqf(ss * (1.0f / 128.0f) + EPS);
            const LAS float* ng = GNL + 16 * dg;
            const unsigned ogw[8] = {nog0.x, nog0.y, nog0.z, nog0.w, nog1.x, nog1.y, nog1.z, nog1.w};
            unsigned ow[8];
#pragma unroll
            for (int j = 0; j < 4; ++j) { const f32x4 gv = *(const LAS f32x4*)(ng + 4 * j);
                const float a0 = ov[j][0] * rms * gv[0] * bflo(ogw[2 * j]), a1 = ov[j][1] * rms * gv[1] * bfhi(ogw[2 * j]);
                const float a2 = ov[j][2] * rms * gv[2] * bflo(ogw[2 * j + 1]), a3 = ov[j][3] * rms * gv[3] * bfhi(ogw[2 * j + 1]);
                ow[2 * j] = pk2(a0, a1); ow[2 * j + 1] = pk2(a2, a3); }
            bf16* op = MIX + (size_t)(tok0 + ta) * D + hh * 128 + 16 * dg;
            *(u32x4*)op = (u32x4){ow[0], ow[1], ow[2], ow[3]}; *(u32x4*)(op + 8) = (u32x4){ow[4], ow[5], ow[6], ow[7]};
            if (n + 1 < 32) { const bf16* rp = PROJ + (size_t)(tok0 + 64 + ta) * PLD;
                nog0 = *(const u32x4*)(rp + C_GOG + hh * 128 + 16 * dg); nog1 = *(const u32x4*)(rp + C_GOG + hh * 128 + 16 * dg + 8); }
        }
        LBAR();
    }
}

constexpr int LR_XR = 0, LR_XC = 17408, LR_XCB = 33792, LR_WAB = 43008, LR_WXB = 52224, LR_RI = 61440, LR_SP = 95232, LR_SH = 97280, LR_HC = 99328;
#undef GLA_ALR_WRITE
#undef GLA_ZSTAGE
DI void lru_unit(Frame& F, int l, int b, int nb) {
    const int tid = F.tid, lane = F.lane, w = F.wave;
    const bf16* PROJ = (const bf16*)(F.ws + WS_PROJ);
    bf16* MIX = (bf16*)(F.ws + WS_MIX);
    LAS unsigned char* lds = F.lds;
    LAS float* XR = (LAS float*)(lds + LR_XR); LAS float* XC = (LAS float*)(lds + LR_XC); LAS float* RI = (LAS float*)(lds + LR_RI);
    LAS float* SP = (LAS float*)(lds + LR_SP); LAS float* SH = (LAS float*)(lds + LR_SH); LAS float* HC = (LAS float*)(lds + LR_HC);
    const int tokbase = b * SEQ, ch0 = nb * 64;
    const int ta = tid >> 3, cg = tid & 7;
    const int cc = tid & 63, seg = tid >> 6;
    const int h_ = lane >> 5, blk = (lane >> 4) & 1, qq = (lane & 15) >> 2, pp = lane & 3;
    float cw[4][8], cb[8];
#pragma unroll
    for (int j = 0; j < 8; ++j) { cb[j] = PARP(I_LCB)[l * 512 + ch0 + 8 * cg + j];
#pragma unroll
        for (int i = 0; i < 4; ++i) cw[i][j] = PARP(I_LCW)[((size_t)l * 4 + i) * 512 + ch0 + 8 * cg + j]; }
    const float bac = PARP(I_LBA)[l * 512 + ch0 + cc], bxc = PARP(I_LBX)[l * 512 + ch0 + cc];
    const float lamc = PARP(I_LLAM)[l * 512 + ch0 + cc]; const float c8 = -8.0f * LOG2E * log1pf(__expf(-lamc));
    for (int i = tid; i < 64 * 64; i += 512) { const int d = i >> 6, e = i & 63;
        *(LAS bf16*)(lds + LR_WAB + d * 144 + e * 2) = (bf16)(pk2(PARP(I_LWA)[(((size_t)l * 8 + nb) * 64 + d) * 64 + e], 0.f) & 0xffffu);
        *(LAS bf16*)(lds + LR_WXB + d * 144 + e * 2) = (bf16)(pk2(PARP(I_LWX)[(((size_t)l * 8 + nb) * 64 + d) * 64 + e], 0.f) & 0xffffu); }
    if (tid < 192) XR[tid] = 0.f;
    if (tid < 64) HC[tid] = 0.f;
    u32x4 nx, ny;
    { const bf16* rp = PROJ + (size_t)(tokbase + ta) * PLD; nx = *(const u32x4*)(rp + C_LX + ch0 + 8 * cg); ny = *(const u32x4*)(rp + C_LY + ch0 + 8 * cg); }
    LBAR();
    for (int n = 0; n < 32; ++n) {
        const int tok0 = tokbase + 64 * n, par = n & 1;
        { LAS float* xp = XR + (3 + ta) * 64 + 8 * cg;
          *(LAS f32x4*)xp = (f32x4){bflo(nx.x), bfhi(nx.x), bflo(nx.y), bfhi(nx.y)}; *(LAS f32x4*)(xp + 4) = (f32x4){bflo(nx.z), bfhi(nx.z), bflo(nx.w), bfhi(nx.w)}; }
        if (n + 1 < 32) nx = *(const u32x4*)(PROJ + (size_t)(tok0 + 64 + ta) * PLD + C_LX + ch0 + 8 * cg);
        LBAR();
        { float xc[8];
#pragma unroll
          for (int j = 0; j < 8; ++j) xc[j] = cb[j];
#pragma unroll
          for (int i = 0; i < 4; ++i) { const f32x4 a = *(const LAS f32x4*)(XR + (ta + i) * 64 + 8 * cg), c2 = *(const LAS f32x4*)(XR + (ta + i) * 64 + 8 * cg + 4);
              xc[0] += a[0] * cw[i][0]; xc[1] += a[1] * cw[i][1]; xc[2] += a[2] * cw[i][2]; xc[3] += a[3] * cw[i][3];
              xc[4] += c2[0] * cw[i][4]; xc[5] += c2[1] * cw[i][5]; xc[6] += c2[2] * cw[i][6]; xc[7] += c2[3] * cw[i][7]; }
          *(LAS f32x4*)(XC + ta * 64 + 8 * cg) = (f32x4){xc[0], xc[1], xc[2], xc[3]}; *(LAS f32x4*)(XC + ta * 64 + 8 * cg + 4) = (f32x4){xc[4], xc[5], xc[6], xc[7]};
          *(LAS bf16x8*)(lds + LR_XCB + ta * 144 + 16 * cg) = pack8(xc[0], xc[1], xc[2], xc[3], xc[4], xc[5], xc[6], xc[7]); }
        LBAR();
        if (tid < 192) XR[tid] = XR[64 * 64 + tid];
        { const int mat = w >> 2, tb = (w >> 1) & 1, eb = w & 1;
          const int wo = mat ? LR_WXB : LR_WAB;
          f32x16 c;
#pragma unroll
          for (int r = 0; r < 16; ++r) c[r] = 0.f;
          const int ra = (32 * tb + (lane & 31)) * 144 + 16 * h_;
#pragma unroll
          for (int ks = 0; ks < 4; ++ks) { const LAS unsigned char* p0 = lds + wo + (16 * ks + 8 * h_ + qq) * 144 + (32 * eb + 16 * blk + 4 * pp) * 2;
              c = MFMA32(*(const LAS bf16x8*)(lds + LR_XCB + ra + 32 * ks), cat8(tr_read(p0), tr_read(p0 + 4 * 144)), c); }
#pragma unroll
          for (int r = 0; r < 16; ++r) RI[(mat * 64 + 32 * tb + (r & 3) + 8 * (r >> 2) + 4 * h_) * 66 + 32 * eb + (lane & 31)] = c[r]; }
        LBAR();
        float hloc[8], pcum[8];
        { float Hh = 0.f, P = 1.f;
#pragma unroll
          for (int tt = 0; tt < 8; ++tt) { const int t = 8 * seg + tt;
              const float rg = fsigmoid(RI[t * 66 + cc] + bac), ig = fsigmoid(RI[(64 + t) * 66 + cc] + bxc), xc = XC[t * 64 + cc];
              const float a = __builtin_amdgcn_exp2f(rg * c8), om = fmaxf(1.0f - a * a, 0.0f), bb = __builtin_amdgcn_sqrtf(om) * (ig * xc);
              Hh = a * Hh + bb; P *= a; hloc[tt] = Hh; pcum[tt] = P; }
          SP[seg * 64 + cc] = P; SH[seg * 64 + cc] = Hh; }
        LBAR();
        { float hin = HC[par * 64 + cc]; float sp[7], sh7[7];
#pragma unroll
          for (int s2 = 0; s2 < 7; ++s2) { sp[s2] = SP[s2 * 64 + cc]; sh7[s2] = SH[s2 * 64 + cc]; }
#pragma unroll
          for (int s2 = 0; s2 < 7; ++s2) { const float nh = sp[s2] * hin + sh7[s2]; hin = (s2 < seg) ? nh : hin; }
#pragma unroll
          for (int tt = 0; tt < 8; ++tt) XC[(8 * seg + tt) * 64 + cc] = hloc[tt] + pcum[tt] * hin;
          if (seg == 7) HC[(par ^ 1) * 64 + cc] = hloc[7] + pcum[7] * hin; }
        LBAR();
        { const f32x4 h0 = *(const LAS f32x4*)(XC + ta * 64 + 8 * cg), h1 = *(const LAS f32x4*)(XC + ta * 64 + 8 * cg + 4);
          u32x4 o; o.x = pk2(h0[0] * fgelu_tanh(bflo(ny.x)), h0[1] * fgelu_tanh(bfhi(ny.x))); o.y = pk2(h0[2] * fgelu_tanh(bflo(ny.y)), h0[3] * fgelu_tanh(bfhi(ny.y)));
          o.z = pk2(h1[0] * fgelu_tanh(bflo(ny.z)), h1[1] * fgelu_tanh(bfhi(ny.z))); o.w = pk2(h1[2] * fgelu_tanh(bflo(ny.w)), h1[3] * fgelu_tanh(bfhi(ny.w)));
          *(u32x4*)(MIX + (size_t)(tok0 + ta) * D + 768 + ch0 + 8 * cg) = o;
          if (n + 1 < 32) ny = *(const u32x4*)(PROJ + (size_t)(tok0 + 64 + ta) * PLD + C_LY + ch0 + 8 * cg); }
        LBAR();
    }
}

DI void p_mixers(Frame& F, int l) {
    const float lam_init = 0.8f - 0.6f * expf(-0.3f * (float)l);
    if (F.wave == 0) {
        float a = (F.lane < 64) ? PARP(I_DLQ1)[l * 64 + F.lane] * PARP(I_DLK1)[l * 64 + F.lane] : 0.f, c = PARP(I_DLQ2)[l * 64 + F.lane] * PARP(I_DLK2)[l * 64 + F.lane];
        a = wave_sum(a); c = wave_sum(c);
        if (F.lane == 0) F.MISC[4] = __float_as_uint(expf(a) - expf(c) + lam_init);
    }
    __syncthreads();
    const float lam = __uint_as_float(F.MISC[4]);
    unsigned* q = F.ctl + CW_Q + 64 * 4 * l + 512 * F.qset;
#define CONVERT_LOOP() do { if (!(F.skip & 8)) for (;;) { const int it = dequeue(F, q + 192); if (it >= 1024) break; moe_convert_wg(F, l, it); } } while (0)
    const bool streamer = ((blockIdx.x >> 3) & 7) < 3;
    if (streamer) CONVERT_LOOP();
    if (!(F.skip & 1)) for (;;) { const int it = dequeue(F, q); if (it >= 48) break; gla_unit(F, l, it / 6, it % 6); }
    if (!(F.skip & 2)) for (;;) { const int it = dequeue(F, q + 64); if (it >= 64) break; lru_unit(F, l, it >> 3, it & 7); }
    if (!(F.skip & 4)) for (;;) { const int it = dequeue(F, q + 128); if (it >= 768) break; const int qb = 15 - it / 48, bh = it % 48; attn_unit(F, l, bh / 6, bh % 6, qb, lam, 1.0f - lam_init); }
    if (!streamer && !(F.skip & 16)) CONVERT_LOOP();
#undef CONVERT_LOOP
}

#define REFRESH() do { int t_ = threadIdx.x; asm volatile("" : "+v"(t_)); F.tid = t_; F.lane = t_ & 63; F.wave = __builtin_amdgcn_readfirstlane(t_ >> 6); } while (0)
#define IN(k) (lo <= (k) && (k) < hi)
#define SEAM(k) do { if (IN(k) && IN((k) + 1)) xcd_barrier(bar); } while (0)
template <int L>
DI void layer_phases(Frame& F, const XcdBarrier& bar, const int lo, const int hi) {
    constexpr int l = L, pb = 1 + 7 * L;
    if (IN(pb)) { REFRESH(); p_norm<L>(F); SEAM(pb); }
    if (IN(pb + 1)) {
        REFRESH();
        pg8::DenseSched S; S.init(F.ws + WS_U, F.ws + WS_WIN + (size_t)l * PLD * D * 2, T, PLD, D, F.G, (int)blockIdx.x);
        pg8::EpiProj E{(bf16*)(F.ws + WS_PROJ), PLD};
        pg8::gemm_phase<pg8::EpiProj, pg8::DenseSched>(F.lds, S, E);
        SEAM(pb + 1);
    }
    if (IN(pb + 2)) { REFRESH(); p_mixers(F, l); SEAM(pb + 2); }
    if (IN(pb + 3)) {
        REFRESH();
        pg8::DenseSched S; S.init(F.ws + WS_MIX, F.ws + WS_WOUT + (size_t)l * D * D * 2, T, D, D, F.G, (int)blockIdx.x);
        pg8::EpiDelta E{(bf16*)(F.ws + WS_DELTA), (const float*)(F.ws + WS_MOD) + (size_t)l * NB * 6 * D + 2 * D};
        pg8::gemm_phase<pg8::EpiDelta, pg8::DenseSched>(F.lds, S, E);
        SEAM(pb + 3);
    }
    if (IN(pb + 4)) { REFRESH(); p_norm2_router(F, l); SEAM(pb + 4); }
#define MOE_SPLIT() const int n1 = ntile * 4, R2 = n1 / F.G, rem = n1 - R2 * F.G, n_idle = F.G - rem; \
        int E_rt = (rem > 0) ? (3 * n_idle) / 8 : 0; { const int cap = R2 * (F.G / 4); if (E_rt > cap) E_rt = cap; }
    if (IN(pb + 5)) {
        REFRESH();
        const int ntile = moe_tiles(F, l);
        const LAS int* TE = (const LAS int*)(F.lds + TILETAB_OFF); const LAS int* TL = TE + 192; const LAS int* CN = TE + 384;
        LAS unsigned* RT = (LAS unsigned*)(F.lds + ROWTAB_OFF); LAS int* RT2 = (LAS int*)(F.lds + ROWTAB_OFF);
        const int* LIST = (const int*)(F.ws + WS_LIST); const float* WT = (const float*)(F.ws + WS_WT);
        MOE_SPLIT();
        const int c = (int)blockIdx.x;
        pg8::MoeSched S; S.K = D; S.A = (const char*)(F.ws + WS_U); S.Bt = (const char*)(F.ws + WS_W13) + (size_t)l * NE * 1024 * D * 2; S.Bf0 = nullptr; S.Bf1 = nullptr; S.bstride_e = 1024u * D * 2u; S.bstride_pn = 256u * 2u * D;
        S.npn = 4; S.G = F.G; S.c = c; S.tile_e = TE; S.tile_l = TL; S.rowtab = RT; S.gather = true;
        S.rt0 = 0; S.rt_end = ntile; S.rmax = R2; S.lin = 0; S.L0 = 0; S.Lend = 0; S.cl = 0; S.Gl = 1;
        pg8::EpiSwiglu E{(bf16*)(F.ws + WS_HID)};
#define FILL_RT() do { for (int ui = 0; ui < 12; ++ui) { int rt, pn; if (!S.unit_of(ui, rt, pn)) break; const int e = TE[rt], tl = TL[rt]; \
            for (int r = F.tid; r < 256; r += 512) { const int slot = tl * 256 + r; RT[ui * 256 + r] = (slot < CN[e]) ? (unsigned)(LIST[e * 16384 + slot] >> 1) : 0u; } } __syncthreads(); } while (0)
#define FILL_RT2(S2) do { for (int ui = 0; ui < 6; ++ui) { int rt, pn; if (!(S2).unit_of(ui, rt, pn)) break; const int e = TE[rt], tl = TL[rt]; \
            for (int r = F.tid; r < 256; r += 512) { const int slot = tl * 256 + r; int a = -1, wb = 0; if (slot < CN[e]) { a = LIST[e * 16384 + slot]; wb = __float_as_int(WT[a]); } \
                RT2[(ui * 256 + r) * 2] = a; RT2[(ui * 256 + r) * 2 + 1] = wb; } } __syncthreads(); } while (0)
        FILL_RT();
        pg8::gemm_phase<pg8::EpiSwiglu, pg8::MoeSched>(F.lds, S, E);
        if (rem > 0) {
            xcd_barrier(bar);
            const int rtB = ntile - R2 * (F.G / 4), perB = (rtB + 7) >> 3;
#define PB_RT(cc) (R2 * (F.G / 4) + perB * ((cc) & 7) + ((cc) >> 5))
#define PB_BUSY(cc) ((((cc) >> 5) < perB) && (PB_RT(cc) < ntile))
            __syncthreads();
            if (F.tid == 0) F.MISC[6] = 0u;
            __syncthreads();
            if (F.tid < c && !PB_BUSY(F.tid)) __hip_atomic_fetch_add((LAS unsigned*)(F.lds + MISC_OFF) + 6, 1u, __ATOMIC_RELAXED, __HIP_MEMORY_SCOPE_WORKGROUP);
            __syncthreads();
            const int idle_rank = (int)F.MISC[6];
            if (PB_BUSY(c)) {
                S.rmax = 1; S.lin = 1; S.L0 = PB_RT(c) * 4 + ((c >> 3) & 3); S.Lend = S.L0 + 1; S.cl = 0; S.Gl = 1;
                __syncthreads(); FILL_RT();
                pg8::gemm_phase<pg8::EpiSwiglu, pg8::MoeSched>(F.lds, S, E);
            } else if (E_rt > 0) {
                pg8::MoeSched S2; S2.K = DE; S2.A = (const char*)(F.ws + WS_HID); S2.Bt = (const char*)(F.ws + WS_W2); S2.Bf0 = F.in[I_W2] + (size_t)l * NE * DE * D; S2.Bf1 = nullptr; S2.bstride_e = (unsigned)D * DE * 4u; S2.bstride_pn = 1024u;
                S2.npn = 8; S2.G = F.G; S2.c = c; S2.tile_e = TE; S2.tile_l = TL; S2.rowtab = nullptr; S2.gather = false;
                S2.rt0 = 0; S2.rt_end = E_rt; S2.rmax = 3; S2.lin = 1; S2.L0 = 0; S2.Lend = 8 * E_rt; S2.cl = idle_rank; S2.Gl = n_idle;
                __syncthreads(); FILL_RT2(S2);
                pg8::EpiY2 E2{(bf16*)(F.ws + WS_Y2), RT2};
                pg8::gemm_phase<pg8::EpiY2, pg8::MoeSched, true, 2>(F.lds, S2, E2);
            }
        }
        SEAM(pb + 5);
    }
    if (IN(pb + 6)) {
        REFRESH();
        const int ntile = moe_tiles(F, l);
        const LAS int* TE = (const LAS int*)(F.lds + TILETAB_OFF); const LAS int* TL = TE + 192; const LAS int* CN = TE + 384;
        LAS int* RT2 = (LAS int*)(F.lds + ROWTAB_OFF);
        const int* LIST = (const int*)(F.ws + WS_LIST); const float* WT = (const float*)(F.ws + WS_WT);
        MOE_SPLIT();
        pg8::MoeSched S; S.K = DE; S.A = (const char*)(F.ws + WS_HID); S.Bt = (const char*)(F.ws + WS_W2); S.Bf0 = F.in[I_W2] + (size_t)l * NE * DE * D; S.Bf1 = nullptr; S.bstride_e = (unsigned)D * DE * 4u; S.bstride_pn = 1024u;
        S.npn = 8; S.G = F.G; S.c = (int)blockIdx.x; S.tile_e = TE; S.tile_l = TL; S.rowtab = nullptr; S.gather = false;
        S.rt0 = E_rt; S.rt_end = ntile; S.rmax = 6; S.lin = 0; S.L0 = 0; S.Lend = 0; S.cl = 0; S.Gl = 1;
        FILL_RT2(S);
        pg8::EpiY2 E{(bf16*)(F.ws + WS_Y2), RT2};
        pg8::gemm_phase<pg8::EpiY2, pg8::MoeSched, true, 2>(F.lds, S, E);
        SEAM(pb + 6);
    }
#undef MOE_SPLIT
#undef PB_RT
#undef PB_BUSY
#undef FILL_RT
#undef FILL_RT2
}
__global__ void __launch_bounds__(512, 2) mega(Args args) {
    extern __shared__ __attribute__((aligned(16))) unsigned char lds_raw[];
    Frame F;
    F.lds = (LAS unsigned char*)lds_raw; F.MISC = (volatile LAS unsigned*)(F.lds + MISC_OFF);
    F.tid = threadIdx.x; F.lane = F.tid & 63; F.wave = __builtin_amdgcn_readfirstlane(F.tid >> 6);
    F.G = gridDim.x; { const int bx = blockIdx.x; F.vcu = (F.G % 8 == 0) ? (bx % 8) * (F.G / 8) + bx / 8 : bx; }
    F.in = args.in; F.out = args.out; F.ws = args.ws; F.ctl = (unsigned*)(args.ws + WS_CTL); F.qset = args.qset & 255; F.skip = args.qset >> 8;
    if (F.tid < 64) F.MISC[F.tid] = 0u;
    __syncthreads();
    const int lo = args.ph_lo, hi = args.ph_hi;
    XcdBarrier bar; bar.bar = F.ctl + CW_BAR + args.li * XCD_BAR_WORDS; bar.x = 0; bar.st = F.MISC;
    bar = xcd_barrier_post(F.ctl + CW_BAR + args.li * XCD_BAR_WORDS, F.MISC);
    if (IN(0)) { p0_prologue(F); SEAM(0); }
    layer_phases<0>(F, bar, lo, hi);
    layer_phases<1>(F, bar, lo, hi);
    if (IN(15)) { REFRESH(); p_norm<2>(F); }
}
#undef IN
#undef SEAM

extern "C" void kernel_launch(void* const* d_in, const int* in_sizes, int n_in, void* d_out, int out_size, void* d_ws, size_t ws_size, hipStream_t stream) {
    static int grid = 0;
    if (grid == 0) {
        if (n_in != 32 || out_size != T * D || ws_size < WS_END) { fprintf(stderr, "kernel_launch: unexpected shapes (n_in %d, out %d, ws %zu)\n", n_in, out_size, ws_size); grid = -1; return; }
        int dev = 0, cus = 0, per_cu = 0;
        if (hipGetDevice(&dev) != hipSuccess || hipDeviceGetAttribute(&cus, hipDeviceAttributeMultiprocessorCount, dev) != hipSuccess) { grid = -1; return; }
        if (hipFuncSetAttribute((const void*)mega, hipFuncAttributeMaxDynamicSharedMemorySize, LDS_BYTES) != hipSuccess) { fprintf(stderr, "kernel_launch: hipFuncSetAttribute failed\n"); grid = -1; return; }
        if (hipOccupancyMaxActiveBlocksPerMultiprocessor(&per_cu, (const void*)mega, 512, LDS_BYTES) != hipSuccess || per_cu < 1) fprintf(stderr, "kernel_launch: occupancy query reports %d\n", per_cu);
        (void)hipGetLastError();
        grid = cus;
    }
    if (grid < 0) return;
    if (hipMemsetAsync((char*)d_ws + WS_CTL, 0, CTL_BYTES, stream) != hipSuccess) return;
    Args a{};
    for (int i = 0; i < 32; ++i) a.in[i] = (const float*)d_in[i];
    a.out = (float*)d_out; a.ws = (unsigned char*)d_ws;
    static const int plan[][3] = { PLAN };
    for (int li = 0; li < (int)(sizeof(plan) / sizeof(plan[0])); ++li) { a.ph_lo = plan[li][0]; a.ph_hi = plan[li][1]; a.li = li; a.qset = plan[li][2];
        hipLaunchKernelGGL(mega, dim3(grid), dim3(512), LDS_BYTES, stream, a); }
}
```

```cpp
#include <hip/hip_runtime.h>
#include <cstdio>
#include <cstdint>

#define PLAN {0, 16, 0}

#define GAS __attribute__((address_space(1)))
#define LAS __attribute__((address_space(3)))
typedef unsigned short bf16;
typedef short bf16x8 __attribute__((ext_vector_type(8)));
typedef short s16x4 __attribute__((ext_vector_type(4)));
typedef float f32x2 __attribute__((ext_vector_type(2)));
typedef float f32x4 __attribute__((ext_vector_type(4)));
typedef float f32x16 __attribute__((ext_vector_type(16)));
typedef unsigned u32x2 __attribute__((ext_vector_type(2)));
typedef unsigned u32x4 __attribute__((ext_vector_type(4)));
typedef __bf16 bf16x2_t __attribute__((ext_vector_type(2)));
#define DI __device__ __forceinline__

constexpr int NB = 8, SEQ = 2048, D = 2048, T = NB * SEQ, NL = 2;
constexpr int INW = 5648, PLD = 5888;
constexpr int C_GQ = 0, C_GK = 384, C_GV = 768, C_GOG = 1536, C_LY = 2304, C_LX = 2816, C_DQ = 3328, C_DK = 4096, C_DV = 4864, C_GA = 5632;
constexpr int NE = 64, DE = 512;
constexpr float EPS = 1e-6f, LOG2E = 1.4426950408889634f;
constexpr int NPH = 16;

constexpr size_t MiB = 1u << 20;
constexpr size_t WS_CTL = 0, CTL_BYTES = 65536;
constexpr size_t WS_MOD = 1 * MiB;
constexpr size_t WS_WR = 2 * MiB;
constexpr size_t WS_LIST = 4 * MiB;
constexpr size_t WS_WT = 8 * MiB;
constexpr size_t WS_CB = 8 * MiB + 512 * 1024;
constexpr size_t WS_PAR = 9 * MiB;
constexpr size_t WS_WIN = 16 * MiB;
constexpr size_t WS_WOUT = 64 * MiB;
constexpr size_t WS_W13 = 80 * MiB;
constexpr size_t WS_W2 = 592 * MiB;
constexpr size_t WS_H = 848 * MiB;
constexpr size_t WS_U = 976 * MiB;
constexpr size_t WS_PROJ = 1040 * MiB;
constexpr size_t WS_MIX = 1224 * MiB;
constexpr size_t WS_HID = 1288 * MiB;
constexpr size_t WS_Y2 = 1336 * MiB;
constexpr size_t WS_DELTA = 1464 * MiB;
constexpr size_t WS_END = 1528 * MiB;
constexpr int CW_FLAG = 0;
constexpr int CW_Q = 64;
constexpr int CW_CNT = 2048;
constexpr int CW_BAR = 4096;

constexpr int RING_BYTES = 131072;
constexpr int ROWTAB_OFF = 131072;
constexpr int TILETAB_OFF = 143360;
constexpr int MISC_OFF = 145408;
constexpr int LDS_BYTES = 147456;

DI unsigned pk2(float lo, float hi) { f32x2 v = {lo, hi}; return __builtin_bit_cast(unsigned, __builtin_convertvector(v, bf16x2_t)); }
DI float bflo(unsigned w) { return __uint_as_float(w << 16); }
DI float bfhi(unsigned w) { return __uint_as_float(w & 0xffff0000u); }
DI float bf2f(bf16 v) { return __uint_as_float((unsigned)v << 16); }
DI float wave_sum(float v) {
#pragma unroll
    for (int o = 1; o < 64; o <<= 1) v += __shfl_xor(v, o);
    return v;
}
DI float frcp(float x) { return __builtin_amdgcn_rcpf(x); }
DI float fsigmoid(float x) { return frcp(1.f + __builtin_amdgcn_exp2f(-1.4426950408889634f * x)); }
DI float fsilu(float x) { return x * frcp(1.f + __builtin_amdgcn_exp2f(-1.4426950408889634f * x)); }
DI float fgelu_tanh(float x) { const float u2 = (2.0f * 0.7978845608028654f * 1.4426950408889634f) * (x + 0.044715f * x * x * x); return x * frcp(1.f + __builtin_amdgcn_exp2f(-u2)); }
#define LDS_WAIT() asm volatile("s_waitcnt lgkmcnt(0)" ::: "memory")
#define VM_WAIT() asm volatile("s_waitcnt vmcnt(0)" ::: "memory")
#define LBAR() do { asm volatile("s_waitcnt lgkmcnt(0)" ::: "memory"); __builtin_amdgcn_s_barrier(); asm volatile("" ::: "memory"); } while (0)

#define XB_TMO      128
#define XB_XCNT(j)  (256  + 64 * (j))
#define XB_XSUB(j)  (1280 + 64 * (j))
#define XB_XGEN(j)  (2304 + 64 * (j))
#define XB_TOP      3328
#define XB_TOPGEN   3392
#define XCD_BAR_WORDS 3456
#define XB_SPIN_CAP (1u << 18)
DI unsigned xb_ld(unsigned* p)              { return __hip_atomic_load(p, __ATOMIC_RELAXED, __HIP_MEMORY_SCOPE_AGENT); }
DI unsigned xb_add(unsigned* p, unsigned v) { return __hip_atomic_fetch_add(p, v, __ATOMIC_RELAXED, __HIP_MEMORY_SCOPE_AGENT); }
DI unsigned xb_xcc_id() { return (unsigned)__builtin_amdgcn_s_getreg((3 << 11) | 20) & 0xFu; }
#define XB_SPIN(cond, bar) do { unsigned _sp = 0; while (cond) { __builtin_amdgcn_s_sleep(1); \
    if ((++_sp & 255u) == 0u) { if (xb_ld(&(bar)[XB_TMO])) break; if (_sp > XB_SPIN_CAP) { atomicAdd(&(bar)[XB_TMO], 1u); break; } } } } while (0)
struct XcdBarrier { unsigned* bar; unsigned x; volatile LAS unsigned* st; };
DI XcdBarrier xcd_barrier_post(unsigned* bar, volatile LAS unsigned* st) {
    XcdBarrier b; b.bar = bar; b.x = xb_xcc_id(); b.st = st;
    if (threadIdx.x == 0) (void)xb_add(&bar[XB_XCNT(b.x)], 1u);
    return b;
}
DI void xcd_barrier_complete(unsigned* bar, unsigned x, unsigned& nloc, unsigned& nx) {
    const unsigned G = gridDim.x * gridDim.y * gridDim.z;
    unsigned sum, cnt, mine, sp = 0u;
    for (;;) {
        sum = 0u; cnt = 0u; mine = 0u;
#pragma unroll
        for (unsigned j = 0; j < 16; ++j) { const unsigned c = xb_ld(&bar[XB_XCNT(j)]); sum += c; cnt += (c > 0u) ? 1u : 0u; mine = (j == x) ? c : mine; }
        if (sum == G) break;
        __builtin_amdgcn_s_sleep(1);
        if ((++sp & 255u) == 0u) { if (xb_ld(&bar[XB_TMO])) break; if (sp > XB_SPIN_CAP) { atomicAdd(&bar[XB_TMO], 1u); break; } }
    }
    nloc = mine > 0u ? mine : 1u; nx = cnt > 0u ? cnt : 1u;
}
DI void xcd_barrier(const XcdBarrier& b) {
    asm volatile("s_waitcnt vmcnt(0)" ::: "memory");
    __syncthreads();
    if (threadIdx.x == 0) {
        unsigned* bar = b.bar;
        __builtin_amdgcn_s_waitcnt(0);
        unsigned nloc = b.st[0], nx = b.st[1];
        if (nloc == 0u) { xcd_barrier_complete(bar, b.x, nloc, nx); b.st[0] = nloc; b.st[1] = nx; }
        const unsigned old = xb_add(&bar[XB_XSUB(b.x)], 1u);
        const unsigned gen = old / nloc;
        if (old + 1u == (gen + 1u) * nloc) {
            __builtin_amdgcn_fence(__ATOMIC_RELEASE, "agent");
            asm volatile("s_waitcnt vmcnt(0)" ::: "memory");
            const unsigned og = xb_add(&bar[XB_TOP], 1u);
            const unsigned tg = og / nx;
            if (og + 1u == (tg + 1u) * nx) xb_add(&bar[XB_TOPGEN], 1u);
            else XB_SPIN(xb_ld(&bar[XB_TOPGEN]) == tg, bar);
            __builtin_amdgcn_fence(__ATOMIC_ACQUIRE, "agent");
            xb_add(&bar[XB_XGEN(b.x)], 1u);
            asm volatile("s_waitcnt vmcnt(0)" ::: "memory");
        } else {
            XB_SPIN(xb_ld(&bar[XB_XGEN(b.x)]) == gen, bar);
            __builtin_amdgcn_fence(__ATOMIC_ACQUIRE, "agent");
            asm volatile("s_waitcnt vmcnt(0)" ::: "memory");
        }
    }
    __syncthreads();
}

namespace pg8 {
constexpr int BM = 256, BK = 64, HALF = 128, HTB = HALF * BK * 2, STAGE_BYTES = 8 * HTB, NXCD = 8, WGM = 8;
__host__ __device__ __forceinline__ int lds_byte(int r, int c) { const int st = (r >> 4) * 2 + (c >> 5), rr = r & 15, cc = c & 31, ob = rr * 64 + cc * 2; return st * 1024 + (ob ^ (((ob >> 9) & 1) << 5)); }
__host__ __device__ __forceinline__ void stage_rc(int b, int& R, int& C) { const int st = b / 1024, sb = b % 1024, swz = sb ^ (((sb >> 9) & 1) << 5); R = (st >> 1) * 16 + swz / 64; C = (st & 1) * 32 + (swz % 64) / 2; }
__host__ __device__ __forceinline__ int perm32(int rho) { const int n = rho >> 4, i = rho & 15; return 8 * (i >> 2) + 4 * n + (i & 3); }

struct Unit { int pm, pn, e, aux; };

DI s16x4 tr_read_b(const LAS unsigned char* p) { return __builtin_bit_cast(s16x4, __builtin_amdgcn_ds_read_tr16_b64_v4i16((LAS s16x4*)p)); }
template <class Epi, class Sched, bool ALIGN_EPI = true, int BF = 0>
DI void gemm_phase(LAS unsigned char* lds, const Sched& S, const Epi& E) {
    int tid_ = threadIdx.x; asm volatile("" : "+v"(tid_));
    const int tid = tid_, wid = __builtin_amdgcn_readfirstlane(tid >> 6), lane = tid & 63, wr = wid >> 2, wc = wid & 3, fr = lane & 15, fq = lane >> 4;
    const int K = S.K, nt = K / BK;
    const unsigned K2 = (unsigned)K * 2u;
    unsigned voffB[2];
#pragma unroll
    for (int i = 0; i < 2; ++i) { int R, C; stage_rc(tid * 16 + i * 8192, R, C); const int Rb = Epi::PERM ? ((R & ~31) + perm32(R & 31)) : R;
        voffB[i] = (unsigned)(Rb * K + C) * 2u; }
    const unsigned hstepB = (unsigned)HALF * K * 2u;
    const unsigned ldsw = (unsigned)wid * 1024u;
    const int aoff = lds_byte(wr * 64 + fr, fq * 8), boff = lds_byte(wc * 32 + fr, fq * 8);
    const __amdgpu_buffer_rsrc_t rsA = __builtin_amdgcn_make_buffer_rsrc((void*)S.A, 0, 0x7fffffff, 0x00020000);
    const __amdgpu_buffer_rsrc_t rsB = __builtin_amdgcn_make_buffer_rsrc((void*)S.Bt, 0, 0x7fffffff, 0x00020000);
    const __amdgpu_buffer_rsrc_t rsF = __builtin_amdgcn_make_buffer_rsrc((void*)((BF == 1 && (wid & 1)) ? S.Bf1 : S.Bf0), 0, 0x7fffffff, 0x00020000);
    constexpr unsigned KBMUL = (BF == 1) ? 1024u : 4096u, ROWB = (BF == 1) ? 2048u : 8192u;
    unsigned voffF = 0, wrowoff = 0, bwr0 = 0, brd0 = 0; const unsigned ldsbase = (unsigned)(unsigned long long)lds;
    u32x4 bq[8];
    if constexpr (BF == 2) {
        const unsigned r0 = ((unsigned)wid & 3u) + 8u * ((unsigned)wid >> 2);
        voffF = (unsigned)lane * 16u; wrowoff = r0 * ROWB;
        const unsigned seg = 8u * (lane >> 3) + 4u * (lane & 1) + ((lane >> 1) & 3);
        bwr0 = r0 * 512u + ((seg ^ (((r0 & 3u) << 2) | (((r0 >> 3) & 1u) << 4))) << 3);
    } else if constexpr (BF == 1) {
        const unsigned rh = lane >> 5, c = lane & 31, kq = (unsigned)wid >> 1, hs = (unsigned)wid & 1u;
        const unsigned r0w = 2u * (kq & 1u) + 8u * (kq >> 1), r0 = r0w + rh;
        voffF = rh * ROWB + c * 16u; wrowoff = r0w * ROWB;
        const unsigned seg = 32u * hs + 8u * (c >> 3) + 4u * (c & 1) + ((c >> 1) & 3);
        bwr0 = r0 * 512u + ((seg ^ (((r0 & 3u) << 2) | (((r0 >> 3) & 1u) << 4))) << 3);
    }
    if constexpr (BF != 0) {
        const unsigned segb = 8u * wc, mask = (((unsigned)fr >> 2) << 2) | (((unsigned)fq & 1u) << 4);
        brd0 = (unsigned)(8 * fq + (fr >> 2)) * 512u + (((segb ^ mask) | ((unsigned)fr & 3u)) << 3);
    }
    const unsigned brdA = ldsbase + brd0, brdB = ldsbase + (brd0 ^ 32u);
#define PG8_ROWD(i) ((unsigned)(((i) & 1) * 4 + ((i) >> 1) * 16))
#define PG8_LDBF(bp, kb) do { const unsigned _s = (bp) + (kb) * KBMUL + wrowoff; _Pragma("unroll") for (int _i = 0; _i < 8; ++_i) \
        bq[_i] = __builtin_bit_cast(u32x4, __builtin_amdgcn_raw_buffer_load_b128(rsF, voffF, _s + PG8_ROWD(_i) * ROWB, 0)); } while (0)
#define PG8_WRB(slot) do { PG8_WAIT_V(4); _Pragma("unroll") for (int _i = 0; _i < 8; ++_i) { \
        u32x2 _w; _w.x = pk2(__uint_as_float(bq[_i].x), __uint_as_float(bq[_i].y)); _w.y = pk2(__uint_as_float(bq[_i].z), __uint_as_float(bq[_i].w)); \
        *(LAS u32x2*)(lds + PG8_SB(slot, 0) + bwr0 + PG8_ROWD(_i) * 512u) = _w; } } while (0)
#define PG8_TR(d, a, off) asm volatile("ds_read_b64_tr_b16 %0, %1 offset:%2" : "=v"(d) : "v"(a), "i"(off) : "memory")
#define PG8_LDBT(dst, b, bj) do { constexpr int _o = PG8_SB(b, 0) + (bj) * 256; s16x4 _t0, _t1, _t2, _t3, _t4, _t5, _t6, _t7; \
        PG8_TR(_t0, brdA, _o); PG8_TR(_t1, brdA, _o + 2048); PG8_TR(_t2, brdA, _o + 16384); PG8_TR(_t3, brdA, _o + 18432); PG8_TR(_t4, brdB, _o); PG8_TR(_t5, brdB, _o + 2048); PG8_TR(_t6, brdB, _o + 16384); PG8_TR(_t7, brdB, _o + 18432); \
        dst[0][0] = __builtin_shufflevector(_t0, _t1, 0, 1, 2, 3, 4, 5, 6, 7); dst[0][1] = __builtin_shufflevector(_t2, _t3, 0, 1, 2, 3, 4, 5, 6, 7); \
        dst[1][0] = __builtin_shufflevector(_t4, _t5, 0, 1, 2, 3, 4, 5, 6, 7); dst[1][1] = __builtin_shufflevector(_t6, _t7, 0, 1, 2, 3, 4, 5, 6, 7); } while (0)
#define PG8_TIEB(x) asm volatile("s_waitcnt lgkmcnt(0)" : "+v"(x[0][0]), "+v"(x[0][1]), "+v"(x[1][0]), "+v"(x[1][1]) :: "memory")
#define PG8_LDBTH(dst, n, b, bj) do { constexpr int _o = PG8_SB(b, 0) + (bj) * 256; const unsigned _a = (n) ? brdB : brdA; s16x4 _t0, _t1, _t2, _t3; \
        PG8_TR(_t0, _a, _o); PG8_TR(_t1, _a, _o + 2048); PG8_TR(_t2, _a, _o + 16384); PG8_TR(_t3, _a, _o + 18432); \
        dst[n][0] = __builtin_shufflevector(_t0, _t1, 0, 1, 2, 3, 4, 5, 6, 7); dst[n][1] = __builtin_shufflevector(_t2, _t3, 0, 1, 2, 3, 4, 5, 6, 7); } while (0)
#define PG8_TIEH(x, n, cnt) asm volatile("s_waitcnt lgkmcnt(" #cnt ")" : "+v"(x[n][0]), "+v"(x[n][1]) :: "memory")
#define PG8_MMAH(ai, bj, n, At, Bt) do { _Pragma("unroll") for (int m = 0; m < 4; ++m) _Pragma("unroll") for (int k = 0; k < 2; ++k) \
        acc[ai][bj][m][n] = __builtin_amdgcn_mfma_f32_16x16x32_bf16(Bt[n][k], At[m][k], acc[ai][bj][m][n], 0, 0, 0); } while (0)
#define PG8_MMA2(ai, bj0, bj1, b) do { __builtin_amdgcn_s_setprio(1); PG8_MMAH(ai, bj0, 0, At, B0); PG8_SCHED; PG8_LDBTH(B0, 0, b, bj1); PG8_SCHED; PG8_MMAH(ai, bj0, 1, At, B0); PG8_SCHED; PG8_LDBTH(B0, 1, b, bj1); PG8_SCHED; \
        PG8_TIEH(B0, 0, 4); PG8_MMAH(ai, bj1, 0, At, B0); PG8_SCHED; PG8_TIEH(B0, 1, 0); PG8_MMAH(ai, bj1, 1, At, B0); __builtin_amdgcn_s_setprio(0); } while (0)
#define PG8_SA(b, h) (((BF != 0 ? 4 : 0) + (b) * 2 + (h)) * HTB)
#define PG8_SB(b, h) (((BF != 0 ? 0 : 4) + (b) * 2 + (h)) * HTB)
#define PG8_STAGE_A(bufoff, kb, va) do { _Pragma("unroll") for (int _i = 0; _i < 2; ++_i) \
        __builtin_amdgcn_raw_ptr_buffer_load_lds(rsA, (LAS unsigned*)(lds + (bufoff) + ldsw + _i * 8192), 16, (va)[_i], (kb), 0, 0); } while (0)
#define PG8_STAGE_B(bufoff, bp, kb) do { _Pragma("unroll") for (int _i = 0; _i < 2; ++_i) \
        __builtin_amdgcn_raw_ptr_buffer_load_lds(rsB, (LAS unsigned*)(lds + (bufoff) + ldsw + _i * 8192), 16, voffB[_i], (bp) + (kb), 0, 0); } while (0)
#define PG8_LDA(dst, b, h) do { _Pragma("unroll") for (int m = 0; m < 4; ++m) _Pragma("unroll") for (int k = 0; k < 2; ++k) dst[m][k] = *(const LAS bf16x8*)(lds + PG8_SA(b, h) + aoff + m * 2048 + k * 1024); } while (0)
#define PG8_LDB(dst, b, h) do { _Pragma("unroll") for (int n = 0; n < 2; ++n) _Pragma("unroll") for (int k = 0; k < 2; ++k) dst[n][k] = *(const LAS bf16x8*)(lds + PG8_SB(b, h) + boff + n * 2048 + k * 1024); } while (0)
#define PG8_MMA(ai, bj, At, Bt) do { __builtin_amdgcn_s_setprio(1); _Pragma("unroll") for (int m = 0; m < 4; ++m) _Pragma("unroll") for (int n = 0; n < 2; ++n) _Pragma("unroll") for (int k = 0; k < 2; ++k) \
        acc[ai][bj][m][n] = __builtin_amdgcn_mfma_f32_16x16x32_bf16(Bt[n][k], At[m][k], acc[ai][bj][m][n], 0, 0, 0); __builtin_amdgcn_s_setprio(0); } while (0)
#define PG8_WAIT_V(n) asm volatile("s_waitcnt vmcnt(" #n ")" ::: "memory")
#define PG8_WAIT_L(n) asm volatile("s_waitcnt lgkmcnt(" #n ")" ::: "memory")
#define PG8_BAR __builtin_amdgcn_s_barrier()
#define PG8_SCHED __builtin_amdgcn_sched_barrier(0)
    Unit cur, nxt; int ui = 0;
    if (!S.next(0, cur)) return;
    f32x4 acc[2][2][4][2];
#pragma unroll
    for (int a = 0; a < 2; ++a)
#pragma unroll
        for (int b = 0; b < 2; ++b)
#pragma unroll
            for (int m = 0; m < 4; ++m)
#pragma unroll
                for (int n = 0; n < 2; ++n) acc[a][b][m][n] = (f32x4){0.f, 0.f, 0.f, 0.f};
    bf16x8 At[4][2], B0[2][2], B1[2][2];
    unsigned vAc[2][2];
#define PG8_SETVA(dst, unit, uidx) do { int _t = tid; if constexpr (BF != 0) asm volatile("" : "+v"(_t));   \
        _Pragma("unroll") for (int _i = 0; _i < 2; ++_i) { int _R, _C; stage_rc(_t * 16 + _i * 8192, _R, _C); \
        _Pragma("unroll") for (int _h = 0; _h < 2; ++_h) dst[_h][_i] = S.arow(unit, uidx, 128 * _h + _R) * K2 + (unsigned)_C * 2u; } } while (0)
    PG8_SETVA(vAc, cur, 0);
    unsigned cB = S.bbase(cur);
    if constexpr (BF == 0) {
        PG8_STAGE_B(PG8_SB(0, 0), cB, 0u); PG8_STAGE_B(PG8_SB(0, 1), cB + hstepB, 0u); PG8_STAGE_A(PG8_SA(0, 0), 0u, vAc[0]); PG8_STAGE_A(PG8_SA(0, 1), 0u, vAc[1]);
        if (wr == 1) PG8_BAR;
        PG8_WAIT_V(2); PG8_BAR;
        PG8_STAGE_B(PG8_SB(1, 0), cB, 128u); PG8_STAGE_A(PG8_SA(1, 0), 128u, vAc[0]); PG8_STAGE_B(PG8_SB(1, 1), cB + hstepB, 128u);
        PG8_WAIT_V(6); PG8_BAR;
    } else {
        PG8_LDBF(cB, 0u); PG8_STAGE_A(PG8_SA(0, 0), 0u, vAc[0]); PG8_STAGE_A(PG8_SA(0, 1), 0u, vAc[1]);
        if (wr == 1) PG8_BAR;
        PG8_WRB(0); PG8_WAIT_V(2); PG8_WAIT_L(0); PG8_BAR;
        PG8_LDBF(cB, 128u); PG8_STAGE_A(PG8_SA(1, 0), 128u, vAc[0]);
        PG8_WAIT_V(10); PG8_BAR;
    }
#define PG8_KTRIP(kb1, kb2, kb3, VA2, B2) do { if constexpr (BF != 0) { \
              \
            PG8_LDBT(B0, 0, 0); PG8_SCHED; PG8_LDA(At, 0, 0); PG8_STAGE_A(PG8_SA(1, 1), kb1, vAc[1]); \
            PG8_WAIT_V(12); PG8_TIEB(B0); PG8_BAR; PG8_MMA2(0, 0, 1, 0); PG8_BAR; PG8_SCHED; \
            PG8_WRB(1); PG8_SCHED; PG8_LDBF(B2, kb2); PG8_SCHED; PG8_LDA(At, 0, 1); PG8_STAGE_A(PG8_SA(0, 0), kb2, VA2[0]); \
            PG8_WAIT_V(12); PG8_WAIT_L(0); PG8_BAR; PG8_MMA2(1, 1, 0, 0); PG8_BAR; PG8_SCHED; \
            PG8_LDBT(B0, 1, 0); PG8_SCHED; PG8_LDA(At, 1, 0); PG8_STAGE_A(PG8_SA(0, 1), kb2, VA2[1]); \
            PG8_WAIT_V(12); PG8_TIEB(B0); PG8_BAR; PG8_MMA2(0, 0, 1, 1); PG8_BAR; PG8_SCHED; \
            PG8_WRB(0); PG8_SCHED; PG8_LDBF(B2, kb3); PG8_SCHED; PG8_LDA(At, 1, 1); PG8_STAGE_A(PG8_SA(1, 0), kb3, VA2[0]); \
            PG8_WAIT_V(12); PG8_WAIT_L(0); PG8_BAR; PG8_MMA2(1, 1, 0, 1); PG8_BAR; PG8_SCHED; } else { \
            PG8_LDB(B0, 0, 0); PG8_LDB(B1, 0, 1); PG8_SCHED; PG8_LDA(At, 0, 0); PG8_STAGE_A(PG8_SA(1, 1), kb1, vAc[1]); \
            PG8_WAIT_V(8); PG8_WAIT_L(0); PG8_BAR; PG8_MMA(0, 0, At, B0); PG8_MMA(0, 1, At, B1); PG8_BAR; PG8_SCHED; \
            PG8_LDA(At, 0, 1); PG8_STAGE_B(PG8_SB(0, 0), B2, kb2); PG8_STAGE_B(PG8_SB(0, 1), (B2) + hstepB, kb2); PG8_STAGE_A(PG8_SA(0, 0), kb2, VA2[0]); \
            PG8_WAIT_V(8); PG8_WAIT_L(0); PG8_BAR; PG8_MMA(1, 0, At, B0); PG8_MMA(1, 1, At, B1); PG8_BAR; PG8_SCHED; \
            PG8_LDB(B0, 1, 0); PG8_LDB(B1, 1, 1); PG8_SCHED; PG8_LDA(At, 1, 0); PG8_STAGE_A(PG8_SA(0, 1), kb2, VA2[1]); \
            PG8_WAIT_V(8); PG8_WAIT_L(0); PG8_BAR; PG8_MMA(0, 0, At, B0); PG8_MMA(0, 1, At, B1); PG8_BAR; PG8_SCHED; \
            PG8_LDA(At, 1, 1); PG8_STAGE_B(PG8_SB(1, 0), B2, kb3); PG8_STAGE_B(PG8_SB(1, 1), (B2) + hstepB, kb3); PG8_STAGE_A(PG8_SA(1, 0), kb3, VA2[0]); \
            PG8_WAIT_V(8); PG8_WAIT_L(0); PG8_BAR; PG8_MMA(1, 0, At, B0); PG8_MMA(1, 1, At, B1); PG8_BAR; PG8_SCHED; } } while (0)
    for (;;) {
        for (int t = 0; t < nt - 2; t += 2) { const unsigned kb1 = (unsigned)(t + 1) * 128u; PG8_KTRIP(kb1, kb1 + 128u, kb1 + 256u, vAc, cB); }
        const bool has_next = S.next(ui + 1, nxt);
        unsigned vAn[2][2]; unsigned nB = cB;
#pragma unroll
        for (int h = 0; h < 2; ++h)
#pragma unroll
            for (int i = 0; i < 2; ++i) vAn[h][i] = vAc[h][i];
        if (has_next) { nB = S.bbase(nxt); PG8_SETVA(vAn, nxt, ui + 1); }
        { const unsigned kb1 = (unsigned)(nt - 1) * 128u; PG8_KTRIP(kb1, 0u, 128u, vAn, nB); }
        if constexpr (ALIGN_EPI) { if (wr == 0) PG8_BAR; }
        if constexpr (BF != 0) { int t_ = tid; asm volatile("" : "+v"(t_)); E(acc, cur, ui, wr, wc, t_ & 15, (t_ & 63) >> 4); }
        else E(acc, cur, ui, wr, wc, fr, fq);
        if (!has_next) break;
#pragma unroll
        for (int a = 0; a < 2; ++a)
#pragma unroll
            for (int b = 0; b < 2; ++b)
#pragma unroll
                for (int m = 0; m < 4; ++m)
#pragma unroll
                    for (int n = 0; n < 2; ++n) acc[a][b][m][n] = (f32x4){0.f, 0.f, 0.f, 0.f};
        cur = nxt; cB = nB; ++ui;
#pragma unroll
        for (int h = 0; h < 2; ++h)
#pragma unroll
            for (int i = 0; i < 2; ++i) vAc[h][i] = vAn[h][i];
        if constexpr (ALIGN_EPI) { if (wr == 1) PG8_BAR; }
    }
    PG8_WAIT_V(0);
    if constexpr (!ALIGN_EPI) { if (wr == 0) PG8_BAR; }
    PG8_BAR;
#undef PG8_KTRIP
#undef PG8_LDBF
#undef PG8_WRB
#undef PG8_LDBT
#undef PG8_TR
#undef PG8_TIEB
#undef PG8_ROWD
#undef PG8_LDBTH
#undef PG8_TIEH
#undef PG8_MMAH
#undef PG8_MMA2
#undef PG8_SETVA
#undef PG8_SA
#undef PG8_SB
#undef PG8_STAGE_A
#undef PG8_STAGE_B
#undef PG8_LDA
#undef PG8_LDB
#undef PG8_MMA
#undef PG8_WAIT_V
#undef PG8_WAIT_L
#undef PG8_BAR
#undef PG8_SCHED
}

struct DenseSched {
    int K; const char* A; const char* Bt; int nM, nN, nwg, G, c; static constexpr const float* Bf0 = nullptr; static constexpr const float* Bf1 = nullptr;
    DI void init(const void* A_, const void* Bt_, int M, int N, int K_, int G_, int c_) { A = (const char*)A_; Bt = (const char*)Bt_; K = K_; nM = M / BM; nN = N / BM; nwg = nM * nN; G = G_; c = c_; }
    DI bool next(int i, Unit& u) const {
        const long L = (long)i * G + c; if (L >= nwg) return false;
        int wgid = (int)L; { const int q = nwg / NXCD, r = nwg % NXCD, xcd = wgid % NXCD, off = wgid / NXCD; wgid = (xcd < r ? xcd * (q + 1) : r * (q + 1) + (xcd - r) * q) + off; }
        const int nig = WGM * nN, gid = wgid / nig, fm = gid * WGM, gsz = (nM - fm) < WGM ? (nM - fm) : WGM;
        u.pm = fm + ((wgid % nig) % gsz); u.pn = (wgid % nig) / gsz; u.e = 0; u.aux = 0; return true;
    }
    DI unsigned arow(const Unit& u, int, int r) const { return (unsigned)(u.pm * BM + r); }
    DI unsigned bbase(const Unit& u) const { return (unsigned)u.pn * (unsigned)(BM * 2) * (unsigned)K; }
};
struct MoeSched {
    int K; const char* A; const char* Bt; const float* Bf0; const float* Bf1; unsigned bstride_e, bstride_pn; int npn, G, c; const LAS int* tile_e; const LAS int* tile_l; const LAS unsigned* rowtab; bool gather;
    int rt0, rt_end, rmax;
    int lin, L0, Lend, cl, Gl;
    DI bool unit_of(int i, int& rt, int& pn) const {
        if (i >= rmax) return false;
        if (lin) { if (cl < 0) return false; const int L = L0 + i * Gl + cl; rt = L / npn; pn = L - rt * npn; return L < Lend; }
        if (G % (8 * npn) == 0) { const int x = c & 7, j = c >> 3, per = G / (8 * npn); pn = j % npn; rt = rt0 + i * (G / npn) + per * x + j / npn; return rt < rt_end; }
        const int L = i * G + c; rt = rt0 + L / npn; pn = L % npn; return rt < rt_end;
    }
    DI bool next(int i, Unit& u) const {
        int rt, pn; if (!unit_of(i, rt, pn)) return false;
        u.pm = rt; u.pn = pn; u.e = __builtin_amdgcn_readfirstlane(tile_e[rt]); u.aux = __builtin_amdgcn_readfirstlane(tile_l[rt]); return true;
    }
    DI unsigned arow(const Unit& u, int ui, int r) const { return gather ? rowtab[ui * 256 + r] : (unsigned)(u.pm * BM + r); }
    DI unsigned bbase(const Unit& u) const { return (unsigned)u.e * bstride_e + (unsigned)u.pn * bstride_pn; }
};

struct EpiProj {
    static constexpr bool PERM = true;
    bf16* O; int ldc; const float* gg;
    DI void operator()(const f32x4 (&acc)[2][2][4][2], const Unit& u, int, int wr, int wc, int fr, int fq) const {
        const int row0 = u.pm * BM + wr * 64 + fr, col0 = u.pn * BM + wc * 32 + 8 * fq;
        const bool gate = u.pn >= 6 && u.pn < 9;
#pragma unroll
        for (int ai = 0; ai < 2; ++ai)
#pragma unroll
            for (int m = 0; m < 4; ++m) { bf16* rowp = O + (size_t)(row0 + ai * HALF + m * 16) * ldc + col0;
#pragma unroll
                for (int bj = 0; bj < 2; ++bj) { f32x4 v0 = acc[ai][bj][m][0], v1 = acc[ai][bj][m][1];
                    if (gate) { const f32x4 g0 = *(const f32x4*)(gg + col0 + bj * HALF - 1536), g1 = *(const f32x4*)(gg + col0 + bj * HALF - 1536 + 4);
#pragma unroll
                        for (int j = 0; j < 4; ++j) { v0[j] = fsilu(v0[j]) * g0[j]; v1[j] = fsilu(v1[j]) * g1[j]; } }
                    u32x4 w; w.x = pk2(v0[0], v0[1]); w.y = pk2(v0[2], v0[3]); w.z = pk2(v1[0], v1[1]); w.w = pk2(v1[2], v1[3]);
                    *(u32x4*)(rowp + bj * HALF) = w; } }
    }
};
struct EpiDelta {
    static constexpr bool PERM = true;
    bf16* O; const float* g;
    DI void operator()(const f32x4 (&acc)[2][2][4][2], const Unit& u, int, int wr, int wc, int fr, int fq) const {
        const int row0 = u.pm * BM + wr * 64 + fr, col0 = u.pn * BM + wc * 32 + 8 * fq;
        const float* gb = g + (size_t)(u.pm >> 3) * (6 * D) + col0;
        f32x4 gv[2][2];
#pragma unroll
        for (int bj = 0; bj < 2; ++bj)
#pragma unroll
            for (int n = 0; n < 2; ++n) gv[bj][n] = *(const f32x4*)(gb + bj * HALF + 4 * n);
#pragma unroll
        for (int ai = 0; ai < 2; ++ai)
#pragma unroll
            for (int m = 0; m < 4; ++m) { bf16* rowp = O + (size_t)(row0 + ai * HALF + m * 16) * D + col0;
#pragma unroll
                for (int bj = 0; bj < 2; ++bj) { const f32x4 v0 = acc[ai][bj][m][0] * gv[bj][0], v1 = acc[ai][bj][m][1] * gv[bj][1];
                    u32x4 w; w.x = pk2(v0[0], v0[1]); w.y = pk2(v0[2], v0[3]); w.z = pk2(v1[0], v1[1]); w.w = pk2(v1[2], v1[3]);
                    *(u32x4*)(rowp + bj * HALF) = w; } }
    }
};
struct EpiSwiglu {
    static constexpr bool PERM = true;
    bf16* O;
    DI void operator()(const f32x4 (&acc)[2][2][4][2], const Unit& u, int, int wr, int wc, int fr, int fq) const {
        const int row0 = u.pm * BM + wr * 64 + fr, col0 = u.pn * HALF + wc * 32 + 8 * fq;
#pragma unroll
        for (int ai = 0; ai < 2; ++ai)
#pragma unroll
            for (int m = 0; m < 4; ++m) { bf16* rowp = O + (size_t)(row0 + ai * HALF + m * 16) * DE + col0;
                float hv[8];
#pragma unroll
                for (int n = 0; n < 2; ++n)
#pragma unroll
                    for (int j = 0; j < 4; ++j) { const float a = acc[ai][0][m][n][j], b = acc[ai][1][m][n][j]; hv[4 * n + j] = fsilu(a) * b; }
                u32x4 w; w.x = pk2(hv[0], hv[1]); w.y = pk2(hv[2], hv[3]); w.z = pk2(hv[4], hv[5]); w.w = pk2(hv[6], hv[7]);
                *(u32x4*)rowp = w; }
    }
};
struct EpiY2 {
    static constexpr bool PERM = true;
    bf16* Y; const LAS int* rowtab;
    DI void operator()(const f32x4 (&acc)[2][2][4][2], const Unit& u, int ui, int wr, int wc, int fr, int fq) const {
        const int col0 = u.pn * BM + wc * 32 + 8 * fq;
#pragma unroll
        for (int ai = 0; ai < 2; ++ai)
#pragma unroll
            for (int m = 0; m < 4; ++m) { const int r = ai * HALF + wr * 64 + m * 16 + fr; const int a = rowtab[(ui * 256 + r) * 2]; const float wgt = __int_as_float(rowtab[(ui * 256 + r) * 2 + 1]);
                if (a >= 0) { bf16* rowp = Y + (size_t)a * D + col0;
#pragma unroll
                    for (int bj = 0; bj < 2; ++bj) { const f32x4 v0 = acc[ai][bj][m][0] * wgt, v1 = acc[ai][bj][m][1] * wgt;
                        u32x4 w; w.x = pk2(v0[0], v0[1]); w.y = pk2(v0[2], v0[3]); w.z = pk2(v1[0], v1[1]); w.w = pk2(v1[2], v1[3]);
                        *(u32x4*)(rowp + bj * HALF) = w; } } }
    }
};
}

struct Args { const float* in[32]; float* out; unsigned char* ws; int ph_lo, ph_hi, li, qset; };
struct Frame {
    LAS unsigned char* lds; volatile LAS unsigned* MISC; unsigned* ctl;
    int tid, lane, wave, G, vcu, qset, skip;
    const float* const* in; float* out; unsigned char* ws;
};
enum { I_X = 0, I_C, I_ADAW, I_ADAB, I_N1G, I_WIN, I_GWA2, I_GBA, I_GNG, I_LCW, I_LCB, I_LWA, I_LBA, I_LWX, I_LBX, I_LLAM, I_DLQ1, I_DLK1, I_DLQ2, I_DLK2, I_DSUB, I_RELB, I_WOUT, I_N2G,
       I_RGW, I_RGB, I_REW, I_REB, I_W1, I_W3, I_W2, I_FING };


constexpr int par_size(int id) {
    return id == I_N1G ? 4096 : id == I_GWA2 ? 12288 : id == I_GBA ? 768 : id == I_GNG ? 1536 : id == I_LCW ? 4096 : id == I_LCB ? 1024 : id == I_LWA ? 65536 : id == I_LBA ? 1024 : id == I_LWX ? 65536 :
           id == I_LBX ? 1024 : id == I_LLAM ? 1024 : (id >= I_DLQ1 && id <= I_DLK2) ? 128 : id == I_DSUB ? 256 : id == I_RELB ? 192 : id == I_N2G ? 4096 : id == I_RGB ? 16 : id == I_REB ? 128 : id == I_FING ? 2048 : 0;
}
constexpr int par_off(int id) { int o = 0; for (int i = 0; i < id; ++i) o += par_size(i); return o; }
constexpr int PAR_TOTAL = par_off(32);
#define PARP(id) ((const float*)(F.ws + WS_PAR) + par_off(id))
struct CvItem { const float* src; bf16* dst; unsigned ldsrc, lddst; int nvalid; };
DI void cv_load(const CvItem& ci, f32x4 (&v)[8], int lane) {
    const int kq = lane >> 3, c = lane & 7;
    if (4 * c < ci.nvalid) {
#pragma unroll
        for (int i = 0; i < 8; ++i) v[i] = __builtin_nontemporal_load((const f32x4*)(ci.src + (size_t)(8 * kq + i) * ci.ldsrc + 4 * c));
    } else {
#pragma unroll
        for (int i = 0; i < 8; ++i) v[i] = (f32x4){0.f, 0.f, 0.f, 0.f};
    }
}
DI void cv_store(const CvItem& ci, const f32x4 (&v)[8], int lane) {
    const int kq = lane >> 3, c = lane & 7;
#pragma unroll
    for (int q = 0; q < 4; ++q) { u32x4 o; o.x = pk2(v[0][q], v[1][q]); o.y = pk2(v[2][q], v[3][q]); o.z = pk2(v[4][q], v[5][q]); o.w = pk2(v[6][q], v[7][q]);
        __builtin_nontemporal_store(o, (u32x4*)(ci.dst + (size_t)(4 * c + q) * ci.lddst + 8 * kq)); }
}
DI CvItem moe_item(Frame& F, int l, int r) {
    CvItem c; c.nvalid = 32;
    if (r < 65536) {
        const int e = r / 1024, r2 = r % 1024, kb = r2 / 32, nb = r2 % 32, n0 = nb * 32, jt = n0 >> 8, rr = n0 & 255;
        const float* W = (rr < 128) ? F.in[I_W1] : F.in[I_W3];
        c.src = W + ((size_t)(l * NE + e) * D + kb * 64) * DE + jt * 128 + (rr & 127); c.ldsrc = DE;
        c.dst = (bf16*)(F.ws + WS_W13) + ((size_t)(l * NE + e) * 1024 + n0) * D + kb * 64; c.lddst = D;
    } else {
        r -= 65536; const int e = r / 512, r2 = r % 512, kb = r2 / 64, nb = r2 % 64;
        c.src = F.in[I_W2] + ((size_t)(l * NE + e) * DE + kb * 64) * D + nb * 32; c.ldsrc = D;
        c.dst = (bf16*)(F.ws + WS_W2) + ((size_t)(l * NE + e) * D + nb * 32) * DE + kb * 64; c.lddst = DE;
    }
    return c;
}
DI void moe_convert_wg(Frame& F, int l, int it) {
    const int r0 = it * 64 + F.wave, lane = F.lane;
    f32x4 va[8], vb[8], vc[8];
#define CV_L(buf, j) cv_load(moe_item(F, l, r0 + 8 * (j)), buf, lane)
#define CV_S(buf, j) cv_store(moe_item(F, l, r0 + 8 * (j)), buf, lane)
    CV_L(va, 0); CV_L(vb, 1); CV_L(vc, 2);
    CV_S(va, 0); CV_L(va, 3);
    CV_S(vb, 1); CV_L(vb, 4);
    CV_S(vc, 2); CV_L(vc, 5);
    CV_S(va, 3); CV_L(va, 6);
    CV_S(vb, 4); CV_L(vb, 7);
    CV_S(vc, 5); CV_S(va, 6); CV_S(vb, 7);
#undef CV_L
#undef CV_S
}
DI void p0_prologue(Frame& F) {
    const int tid = F.tid;
    {
        LAS float* SC = (LAS float*)F.lds;
        LAS float* RED = (LAS float*)(F.lds + 65536);
        const float* cin = F.in[I_C];
        for (int idx = tid; idx < NB * D; idx += 512) { const float c = cin[idx]; SC[idx] = fsilu(c); }
        __syncthreads();
        for (int tile = blockIdx.x; tile < 256; tile += F.G) {
            const int l = tile >> 7, col0 = (tile & 127) * 96;
            const int cg = tid % 24, rs = tid / 24;
            f32x4 acc[NB];
#pragma unroll
            for (int b = 0; b < NB; ++b) acc[b] = (f32x4){0.f, 0.f, 0.f, 0.f};
            if (tid < 504) {
                const float* wp = F.in[I_ADAW] + (size_t)l * D * (6 * D) + col0 + 4 * cg;
#pragma unroll 4
                for (int k = rs; k < D; k += 21) { const f32x4 w = __builtin_nontemporal_load((const f32x4*)(wp + (size_t)k * (6 * D)));
#pragma unroll
                    for (int b = 0; b < NB; ++b) acc[b] += SC[b * D + k] * w; }
#pragma unroll
                for (int b = 0; b < NB; ++b) *(LAS f32x4*)(RED + (rs * NB + b) * 96 + cg * 4) = acc[b];
            }
            __syncthreads();
            for (int idx = tid; idx < NB * 96; idx += 512) { const int b = idx / 96, cc = idx % 96; float s = F.in[I_ADAB][(size_t)l * 6 * D + col0 + cc];
                for (int r = 0; r < 21; ++r) s += RED[(r * NB + b) * 96 + cc];
                ((float*)(F.ws + WS_MOD))[(size_t)(l * NB + b) * (6 * D) + col0 + cc] = s; }
            __syncthreads();
        }
    }
    {
        const int gt = F.vcu * 512 + tid, NT_ = F.G * 512;
        float* PAR = (float*)(F.ws + WS_PAR);
#define PAR_COPY(id) for (int idx = gt; idx < par_size(id); idx += NT_) PAR[par_off(id) + idx] = F.in[id][idx];
        PAR_COPY(I_N1G) PAR_COPY(I_GWA2) PAR_COPY(I_GBA) PAR_COPY(I_GNG) PAR_COPY(I_LCW) PAR_COPY(I_LCB) PAR_COPY(I_LWA) PAR_COPY(I_LBA) PAR_COPY(I_LWX) PAR_COPY(I_LBX) PAR_COPY(I_LLAM)
        PAR_COPY(I_DLQ1) PAR_COPY(I_DLK1) PAR_COPY(I_DLQ2) PAR_COPY(I_DLK2) PAR_COPY(I_DSUB) PAR_COPY(I_RELB) PAR_COPY(I_N2G) PAR_COPY(I_RGB) PAR_COPY(I_REB) PAR_COPY(I_FING)
#undef PAR_COPY
    }
    {
        const int gt = F.vcu * 512 + tid, NT_ = F.G * 512;
        bf16* WR = (bf16*)(F.ws + WS_WR);
        for (int idx = gt; idx < NL * 80 * D; idx += NT_) { const int l = idx / (80 * D), rem = idx % (80 * D), n = rem / D, k = rem % D;
            float w = 0.f; if (n < 8) w = F.in[I_RGW][((size_t)l * D + k) * 8 + n]; else if (n < 72) w = F.in[I_REW][((size_t)l * D + k) * 64 + (n - 8)];
            const unsigned hi = pk2(w, 0.f) & 0xffffu; const float rem_ = w - bflo(hi); const unsigned lo = pk2(rem_, 0.f) & 0xffffu;
            WR[((size_t)(l * 2 + 0) * 80 + n) * D + k] = (bf16)hi; WR[((size_t)(l * 2 + 1) * 80 + n) * D + k] = (bf16)lo; }
    }
    {
        const int gw = F.vcu * 8 + F.wave, NGW = F.G * 8, lane = F.lane;
        constexpr int I_A = 32 * 184, I_B = 32 * 64, I_L = I_A + I_B;
        for (int it = gw; it < NL * I_L; it += NGW) {
            const int l = it / I_L; int r = it % I_L; CvItem ci;
            if (r < I_A) {
                const int kb = r / 184, nb = r % 184, n0 = nb * 32; int src0, nv;
                if (n0 < 2304) { src0 = n0; nv = 32; } else if (n0 < 5632) { src0 = n0 + 16; nv = 32; } else if (n0 == 5632) { src0 = 2304; nv = 16; } else { src0 = 0; nv = 0; }
                ci.src = F.in[I_WIN] + ((size_t)l * D + kb * 64) * INW + src0; ci.ldsrc = INW; ci.nvalid = nv; ci.dst = (bf16*)(F.ws + WS_WIN) + ((size_t)l * PLD + n0) * D + kb * 64; ci.lddst = D;
            } else {
                r -= I_A; const int kb = r / 64, nb = r % 64;
                ci.src = F.in[I_WOUT] + ((size_t)l * D + kb * 64) * D + nb * 32; ci.ldsrc = D; ci.nvalid = 32; ci.dst = (bf16*)(F.ws + WS_WOUT) + ((size_t)l * D + nb * 32) * D + kb * 64; ci.lddst = D;
            }
            f32x4 v[8]; cv_load(ci, v, lane); cv_store(ci, v, lane);
        }
    }
}

template <int MODE>
DI void p_norm(Frame& F) {
    const int gw = F.vcu * 8 + F.wave, NGW = F.G * 8, lane = F.lane;
    const float* MOD = (const float*)(F.ws + WS_MOD);
    float* H = (float*)(F.ws + WS_H);
    bf16* U = (bf16*)(F.ws + WS_U);
    const bf16* Y2 = (const bf16*)(F.ws + WS_Y2);
    constexpr int L = (MODE == 1) ? 1 : 0;
    constexpr int LP = (MODE == 1) ? 0 : 1;
    if (MODE != 2) {
        const bf16* WRH = (const bf16*)(F.ws + WS_WR) + (size_t)(L * 2 + 0) * 80 * D; const bf16* WRL = (const bf16*)(F.ws + WS_WR) + (size_t)(L * 2 + 1) * 80 * D;
        for (int o = gw; o < NB * 72; o += NGW) { const int b = o / 72, n = o % 72; const float* sh = MOD + (size_t)(L * NB + b) * 6 * D + 3 * D; float a = 0.f;
#pragma unroll
            for (int j = 0; j < 4; ++j) { const int k = 8 * lane + 512 * j; const u32x4 wh = *(const u32x4*)(WRH + (size_t)n * D + k), wl = *(const u32x4*)(WRL + (size_t)n * D + k);
                const f32x4 s0 = *(const f32x4*)(sh + k), s1 = *(const f32x4*)(sh + k + 4);
                a += s0[0] * (bflo(wh.x) + bflo(wl.x)) + s0[1] * (bfhi(wh.x) + bfhi(wl.x)) + s0[2] * (bflo(wh.y) + bflo(wl.y)) + s0[3] * (bfhi(wh.y) + bfhi(wl.y))
                   + s1[0] * (bflo(wh.z) + bflo(wl.z)) + s1[1] * (bfhi(wh.z) + bfhi(wl.z)) + s1[2] * (bflo(wh.w) + bflo(wl.w)) + s1[3] * (bfhi(wh.w) + bfhi(wl.w)); }
            a = wave_sum(a);
            if (lane == 0) ((float*)(F.ws + WS_CB))[(L * NB + b) * 80 + n] = a + ((n < 8) ? PARP(I_RGB)[L * 8 + n] : PARP(I_REB)[L * 64 + n - 8]); }
    }
    for (int row0 = gw * 8; row0 < T; row0 += NGW * 8) {
        const int b = row0 / SEQ;
        f32x4 gs[8], sh[8], g2[8];
#pragma unroll
        for (int j = 0; j < 8; ++j) { const int idx = 4 * lane + 256 * j;
            if (MODE == 2) { gs[j] = *(const f32x4*)(PARP(I_FING) + idx); sh[j] = (f32x4){0.f, 0.f, 0.f, 0.f}; }
            else { const f32x4 g = *(const f32x4*)(PARP(I_N1G) + (size_t)L * D + idx), sc = *(const f32x4*)(MOD + (size_t)(L * NB + b) * 6 * D + D + idx);
                gs[j] = g * (sc + 1.0f); sh[j] = *(const f32x4*)(MOD + (size_t)(L * NB + b) * 6 * D + idx); }
            if (MODE != 0) g2[j] = *(const f32x4*)(MOD + (size_t)(LP * NB + b) * 6 * D + 5 * D + idx); }
        for (int rr = 0; rr < 8; ++rr) {
            const int r = row0 + rr;
            f32x4 x[8]; float ss = 0.f;
#pragma unroll
            for (int j = 0; j < 8; ++j) { const int idx = 4 * lane + 256 * j;
                if (MODE == 0) x[j] = __builtin_nontemporal_load((const f32x4*)(F.in[I_X] + (size_t)r * D + idx));
                else { x[j] = *(const f32x4*)(H + (size_t)r * D + idx);
                    const u32x2 y0 = __builtin_nontemporal_load((const u32x2*)(Y2 + (size_t)(2 * r) * D + idx)), y1 = __builtin_nontemporal_load((const u32x2*)(Y2 + (size_t)(2 * r + 1) * D + idx));
                    f32x4 y; y[0] = bflo(y0.x) + bflo(y1.x); y[1] = bfhi(y0.x) + bfhi(y1.x); y[2] = bflo(y0.y) + bflo(y1.y); y[3] = bfhi(y0.y) + bfhi(y1.y);
                    x[j] += g2[j] * y; }
                ss += (x[j][0] * x[j][0] + x[j][1] * x[j][1]) + (x[j][2] * x[j][2] + x[j][3] * x[j][3]); }
            const float rs = __builtin_amdgcn_rsqf(wave_sum(ss) * (1.0f / D) + EPS);
#pragma unroll
            for (int j = 0; j < 8; ++j) { const int idx = 4 * lane + 256 * j;
                if (MODE == 2) { __builtin_nontemporal_store(x[j] * rs * gs[j], (f32x4*)(F.out + (size_t)r * D + idx)); }
                else { if (MODE != 0) *(f32x4*)(H + (size_t)r * D + idx) = x[j];
                    const f32x4 u = x[j] * rs * gs[j] + sh[j]; u32x2 w; w.x = pk2(u[0], u[1]); w.y = pk2(u[2], u[3]);
                    *(u32x2*)(U + (size_t)r * D + idx) = w; } }
        }
    }
}

DI void p_norm2_router(Frame& F, int l) {
    const int tid = F.tid, lane = F.lane, w = F.wave;
    const float* MOD = (const float*)(F.ws + WS_MOD);
    float* H = (float*)(F.ws + WS_H);
    const float* HIN = (l == 0) ? F.in[I_X] : (const float*)(F.ws + WS_H);
    const bf16* DELTA = (const bf16*)(F.ws + WS_DELTA);
    bf16* U = (bf16*)(F.ws + WS_U);
    const bf16* WRH = (const bf16*)(F.ws + WS_WR) + (size_t)(l * 2 + 0) * 80 * D;
    const bf16* WRL = (const bf16*)(F.ws + WS_WR) + (size_t)(l * 2 + 1) * 80 * D;
    int* LIST = (int*)(F.ws + WS_LIST);
    float* WT = (float*)(F.ws + WS_WT);
    unsigned* CNT = F.ctl + CW_CNT + 64 * l + 128 * F.qset;
    LAS float* PART = (LAS float*)F.lds;
    LAS float* SSQ = (LAS float*)(F.lds + 81920);
    LAS float* CBP = (LAS float*)(F.lds + 83968);
    LAS float* CB = (LAS float*)(F.lds + 102400);
    LAS float* LG = (LAS float*)(F.lds + 102912);
    LAS float* RS = (LAS float*)(F.lds + 121344);
    LAS unsigned* HIST = (LAS unsigned*)(F.lds + 121600);
    LAS unsigned* BASE = (LAS unsigned*)(F.lds + 121856);
    const float* G2 = PARP(I_N2G) + (size_t)l * D;
    for (int step = blockIdx.x; step < T / 64; step += F.G) {
        const int row0 = step * 64, b = row0 / SEQ;
        const float* SC = MOD + (size_t)(l * NB + b) * 6 * D + 4 * D;
        const float* SH = MOD + (size_t)(l * NB + b) * 6 * D + 3 * D;
        if (tid < 64) HIST[tid] = 0u;
        if (tid < 72) CB[tid] = ((const float*)(F.ws + WS_CB))[(l * NB + b) * 80 + tid];
        { const int r = lane & 15, kg = lane >> 4;
          f32x4 acc[4][5]; float ssq[4] = {0.f, 0.f, 0.f, 0.f};
#pragma unroll
          for (int rb = 0; rb < 4; ++rb)
#pragma unroll
              for (int nb = 0; nb < 5; ++nb) acc[rb][nb] = (f32x4){0.f, 0.f, 0.f, 0.f};
          const size_t ho0 = (size_t)(row0 + r) * D + 256 * w + 8 * kg;
#pragma unroll 1
          for (int kk = 0; kk < 8; ++kk) {
              const int k = 256 * w + 32 * kk + 8 * kg;
              f32x4 gs0, gs1;
              { const f32x4 g0 = *(const f32x4*)(G2 + k), g1 = *(const f32x4*)(G2 + k + 4), c0 = *(const f32x4*)(SC + k), c1 = *(const f32x4*)(SC + k + 4); gs0 = g0 * (c0 + 1.0f); gs1 = g1 * (c1 + 1.0f); }
              bf16x8 bh[5], bl[5];
#pragma unroll
              for (int nb = 0; nb < 5; ++nb) { bh[nb] = *(const bf16x8*)(WRH + (size_t)(nb * 16 + r) * D + k); bl[nb] = *(const bf16x8*)(WRL + (size_t)(nb * 16 + r) * D + k); }
#pragma unroll
              for (int rb = 0; rb < 4; ++rb) {
                  const size_t ho = ho0 + (size_t)(16 * rb) * D + 32 * kk; const u32x4 dl = *(const u32x4*)(DELTA + ho);
                  f32x4 x0 = *(const f32x4*)(HIN + ho), x1 = *(const f32x4*)(HIN + ho + 4);
                  x0[0] += bflo(dl.x); x0[1] += bfhi(dl.x); x0[2] += bflo(dl.y); x0[3] += bfhi(dl.y); x1[0] += bflo(dl.z); x1[1] += bfhi(dl.z); x1[2] += bflo(dl.w); x1[3] += bfhi(dl.w);
                  *(f32x4*)(H + ho) = x0; *(f32x4*)(H + ho + 4) = x1;
                  ssq[rb] += (x0[0] * x0[0] + x0[1] * x0[1]) + (x0[2] * x0[2] + x0[3] * x0[3]) + (x1[0] * x1[0] + x1[1] * x1[1]) + (x1[2] * x1[2] + x1[3] * x1[3]);
                  const f32x4 v0 = x0 * gs0, v1 = x1 * gs1;
                  u32x4 hi, lo;
                  hi.x = pk2(v0[0], v0[1]); hi.y = pk2(v0[2], v0[3]); hi.z = pk2(v1[0], v1[1]); hi.w = pk2(v1[2], v1[3]);
                  lo.x = pk2(v0[0] - bflo(hi.x), v0[1] - bfhi(hi.x)); lo.y = pk2(v0[2] - bflo(hi.y), v0[3] - bfhi(hi.y)); lo.z = pk2(v1[0] - bflo(hi.z), v1[1] - bfhi(hi.z)); lo.w = pk2(v1[2] - bflo(hi.w), v1[3] - bfhi(hi.w));
                  const bf16x8 ah = __builtin_bit_cast(bf16x8, hi), al = __builtin_bit_cast(bf16x8, lo);
#pragma unroll
                  for (int nb = 0; nb < 5; ++nb) {
                      acc[rb][nb] = __builtin_amdgcn_mfma_f32_16x16x32_bf16(ah, bh[nb], acc[rb][nb], 0, 0, 0);
                      acc[rb][nb] = __builtin_amdgcn_mfma_f32_16x16x32_bf16(ah, bl[nb], acc[rb][nb], 0, 0, 0);
                      acc[rb][nb] = __builtin_amdgcn_mfma_f32_16x16x32_bf16(al, bh[nb], acc[rb][nb], 0, 0, 0); } } }
#pragma unroll
          for (int rb = 0; rb < 4; ++rb) { float s = ssq[rb]; s += __shfl_xor(s, 16); s += __shfl_xor(s, 32); if (kg == 0) SSQ[w * 64 + 16 * rb + r] = s; }
          if (w >= 4) {
#pragma unroll
              for (int rb = 0; rb < 4; ++rb)
#pragma unroll
                  for (int nb = 0; nb < 5; ++nb)
#pragma unroll
                      for (int j = 0; j < 4; ++j) PART[((w - 4) * 64 + 16 * rb + 4 * kg + j) * 80 + nb * 16 + r] = acc[rb][nb][j]; }
          __syncthreads();
          if (w < 4) {
#pragma unroll
              for (int rb = 0; rb < 4; ++rb)
#pragma unroll
                  for (int nb = 0; nb < 5; ++nb)
#pragma unroll
                      for (int j = 0; j < 4; ++j) { const int pi = (w * 64 + 16 * rb + 4 * kg + j) * 80 + nb * 16 + r; PART[pi] += acc[rb][nb][j]; } } }
        __syncthreads();
        for (int idx = tid; idx < 64 * 72; idx += 512) { const int row = idx / 72, n = idx % 72;
            float s = 0.f, ss = 0.f;
#pragma unroll
            for (int q = 0; q < 4; ++q) s += PART[(q * 64 + row) * 80 + n];
#pragma unroll
            for (int q = 0; q < 8; ++q) ss += SSQ[q * 64 + row];
            const float rs = __builtin_amdgcn_rsqf(ss * (1.0f / D) + EPS);
            LG[row * 72 + n] = rs * s + CB[n]; if (n == 0) RS[row] = rs; }
        __syncthreads();
        int e0 = 0, e1 = 0; unsigned rk0 = 0, rk1 = 0; float wt0 = 0.f, wt1 = 0.f;
        if (tid < 64) {
            const LAS float* lg = LG + tid * 72;
            int gi = 0; float gm = lg[0];
#pragma unroll
            for (int j = 1; j < 8; ++j) if (lg[j] > gm) { gm = lg[j]; gi = j; }
            float gsum = 0.f;
#pragma unroll
            for (int j = 0; j < 8; ++j) gsum += __expf(lg[j] - gm);
            const float gw = 1.0f / gsum;
            const LAS float* el = lg + 8 + gi * 8;
            int i0 = 0; float v0 = el[0];
#pragma unroll
            for (int j = 1; j < 8; ++j) if (el[j] > v0) { v0 = el[j]; i0 = j; }
            int i1 = -1; float v1 = -3.0e38f;
#pragma unroll
            for (int j = 0; j < 8; ++j) if (j != i0 && el[j] > v1) { v1 = el[j]; i1 = j; }
            const float ex = __expf(v1 - v0), w0 = 1.0f / (1.0f + ex), w1 = ex * w0;
            e0 = gi * 8 + i0; e1 = gi * 8 + i1; wt0 = gw * w0; wt1 = gw * w1;
            rk0 = __hip_atomic_fetch_add(HIST + e0, 1u, __ATOMIC_RELAXED, __HIP_MEMORY_SCOPE_WORKGROUP); rk1 = __hip_atomic_fetch_add(HIST + e1, 1u, __ATOMIC_RELAXED, __HIP_MEMORY_SCOPE_WORKGROUP);
        }
        __syncthreads();
        if (tid < 64) { int tt = tid; asm volatile("" : "+v"(tt)); const unsigned n = HIST[tt]; BASE[tt] = n ? atomicAdd(CNT + tt, n) : 0u; }
        __syncthreads();
        if (tid < 64) { const int tok = row0 + tid;
            LIST[e0 * 16384 + BASE[e0] + rk0] = tok * 2; LIST[e1 * 16384 + BASE[e1] + rk1] = tok * 2 + 1;
            WT[tok * 2] = wt0; WT[tok * 2 + 1] = wt1; }
        { f32x4 gs[8], sh[8];
#pragma unroll
          for (int j = 0; j < 8; ++j) { const int idx = 4 * lane + 256 * j; gs[j] = *(const f32x4*)(G2 + idx) * (*(const f32x4*)(SC + idx) + 1.0f); sh[j] = *(const f32x4*)(SH + idx); }
          for (int i = 0; i < 8; ++i) { const int rl = 8 * w + i; const float rs = RS[rl];
#pragma unroll
              for (int j = 0; j < 8; ++j) { const int idx = 4 * lane + 256 * j; const f32x4 x = *(const f32x4*)(H + (size_t)(row0 + rl) * D + idx);
                  const f32x4 u = x * rs * gs[j] + sh[j]; u32x2 wv; wv.x = pk2(u[0], u[1]); wv.y = pk2(u[2], u[3]);
                  *(u32x2*)(U + (size_t)(row0 + rl) * D + idx) = wv; } } }
        __syncthreads();
    }
}

DI int moe_tiles(Frame& F, int l) {
    LAS int* TE = (LAS int*)(F.lds + TILETAB_OFF); LAS int* TL = TE + 192; LAS int* CN = TE + 384;
    __syncthreads();
    if (F.tid < 64) CN[F.tid] = (int)__hip_atomic_load(F.ctl + CW_CNT + 64 * l + 128 * F.qset + F.tid, __ATOMIC_RELAXED, __HIP_MEMORY_SCOPE_AGENT);
    __syncthreads();
    if (F.tid == 0) { int nt = 0; for (int e = 0; e < 64; ++e) { const int n = (CN[e] + 255) >> 8; for (int j = 0; j < n && nt < 192; ++j) { TE[nt] = e; TL[nt] = j; ++nt; } } CN[64] = nt; }
    __syncthreads();
    return CN[64];
}


DI unsigned offb(unsigned row, unsigned ch) { return 256u * row + 16u * (ch ^ (((row & 3u) << 2) | ((row >> 2) & 3u))); }
DI int swap23(int r) { return (r & ~12) | ((r & 4) << 1) | ((r & 8) >> 1); }
DI int t5_bucket(int rel) {
    const int ret = rel > 0 ? 16 : 0; const int n = rel < 0 ? -rel : rel;
    if (n < 8) return ret + n;
    const float v = logf((float)n * 0.125f) / 2.7725887f * 8.0f;
    int large = 8 + (int)(v + 1e-5f); if (large > 15) large = 15;
    return ret + large;
}
DI int dequeue(Frame& F, unsigned* q) {
    __syncthreads();
    if (F.tid == 0) F.MISC[2] = atomicAdd(q, 1u);
    __syncthreads();
    return (int)F.MISC[2];
}
DI s16x4 tr_read(const LAS unsigned char* p) { return __builtin_bit_cast(s16x4, __builtin_amdgcn_ds_read_tr16_b64_v4i16((LAS s16x4*)p)); }
DI bf16x8 cat8(s16x4 lo, s16x4 hi) { return __builtin_shufflevector(lo, hi, 0, 1, 2, 3, 4, 5, 6, 7); }
DI bf16x8 pack8(float a0, float a1, float a2, float a3, float a4, float a5, float a6, float a7) { u32x4 p; p.x = pk2(a0, a1); p.y = pk2(a2, a3); p.z = pk2(a4, a5); p.w = pk2(a6, a7); return __builtin_bit_cast(bf16x8, p); }
#define MFMA32(a, b, c) __builtin_amdgcn_mfma_f32_32x32x16_bf16((a), (b), (c), 0, 0, 0)
DI float vmax(float a, float b) { float r; asm("v_max_f32 %0, %1, %2" : "=v"(r) : "v"(a), "v"(b)); return r; }
DI float vmax3(float a, float b, float c) { float r; asm("v_max3_f32 %0, %1, %2, %3" : "=v"(r) : "v"(a), "v"(b), "v"(c)); return r; }

DI void attn_unit(Frame& F, int l, int b, int hh, int qb, float lam, float cfin) {
    int tid = F.tid, lane = F.lane; const int w = F.wave;
    asm volatile("" : "+v"(tid), "+v"(lane));
    const int map = w >> 2, wq = w & 3;
    const bf16* PROJ = (const bf16*)(F.ws + WS_PROJ);
    bf16* MIX = (bf16*)(F.ws + WS_MIX);
    LAS unsigned char* lds = F.lds;
    constexpr int TABOFF = 98304;
    LAS float* TAB2 = (LAS float*)(lds + TABOFF);
    const int tokbase = b * SEQ;
    const int q0 = qb * 128 + wq * 32, cq = q0 >> 6, ntiles = 2 * qb + 2;
    if (tid < 255) TAB2[tid] = PARP(I_RELB)[t5_bucket(tid - 191) * 6 + hh] * LOG2E;
    LAS float* SGL = (LAS float*)(lds + TABOFF + 1024);
    if (tid >= 256 && tid < 384) SGL[tid - 256] = PARP(I_DSUB)[l * 128 + tid - 256];
    const float far2 = PARP(I_RELB)[15 * 6 + hh] * LOG2E;
    const int h_ = lane >> 5, blk = (lane >> 4) & 1, qq = (lane & 15) >> 2, pp = lane & 3;
    bf16x8 Qf[4];
    { const bf16* qp = PROJ + (size_t)(tokbase + q0 + (lane & 31)) * PLD + C_DQ + hh * 128 + map * 64 + 8 * h_;
#pragma unroll
      for (int s = 0; s < 4; ++s) Qf[s] = *(const bf16x8*)(qp + 16 * s); }
    unsigned srcK[2], srcV[2];
#pragma unroll
    for (int pi = 0; pi < 2; ++pi) { const int p = 2 * w + pi, row = 4 * p + (lane >> 4), pc = lane & 15, ch = pc ^ (((row & 3) << 2) | ((row >> 2) & 3));
        srcK[pi] = (unsigned)((tokbase + row) * PLD + C_DK + hh * 128 + 8 * ch);
        srcV[pi] = (unsigned)((tokbase + swap23(row)) * PLD + C_DV + hh * 128 + 8 * ch); }
#define ATT_STAGE(kt) do { const unsigned ko = (unsigned)(kt) * 64u * PLD; const int st_ = ((kt) % 3) * 32768; _Pragma("unroll") for (int pi = 0; pi < 2; ++pi) { \
        __builtin_amdgcn_global_load_lds((const unsigned*)(PROJ + (size_t)(srcK[pi] + ko)), (LAS unsigned*)(lds + st_ + (2 * w + pi) * 1024), 16, 0, 0); \
        __builtin_amdgcn_global_load_lds((const unsigned*)(PROJ + (size_t)(srcV[pi] + ko)), (LAS unsigned*)(lds + st_ + 16384 + (2 * w + pi) * 1024), 16, 0, 0); } } while (0)
    unsigned kad[4], vad[2][4];
#pragma unroll
    for (int s = 0; s < 4; ++s) kad[s] = offb(lane & 31, 8 * map + 2 * s + h_);
#pragma unroll
    for (int t = 0; t < 2; ++t)
#pragma unroll
        for (int c = 0; c < 4; ++c) vad[t][c] = offb(8 * h_ + 4 * t + qq, 4 * c + 2 * blk + (pp >> 1)) + 8 * (pp & 1);
    f32x16 O[4];
#pragma unroll
    for (int c = 0; c < 4; ++c)
#pragma unroll
        for (int r = 0; r < 16; ++r) O[c][r] = 0.f;
    float m = -1.0e30f, lsum = 0.f;
    constexpr float C1 = 0.125f * LOG2E, THR = 8.0f;
    f32x16 S0, S1;
    bf16x8 Pf[4];
#define ATT_QK(kt) do { const LAS unsigned char* Kb = lds + ((kt) % 3) * 32768; \
        const LAS unsigned char* kp[4]; _Pragma("unroll") for (int s4 = 0; s4 < 4; ++s4) { kp[s4] = Kb + kad[s4]; asm volatile("" : "+v"(kp[s4])); } \
        _Pragma("unroll") for (int r = 0; r < 16; ++r) { S0[r] = 0.f; S1[r] = 0.f; } \
        bf16x8 kf[4][2]; _Pragma("unroll") for (int s4 = 0; s4 < 4; ++s4) { kf[s4][0] = *(const LAS bf16x8*)(kp[s4]); kf[s4][1] = *(const LAS bf16x8*)(kp[s4] + 8192); } \
        _Pragma("unroll") for (int s4 = 0; s4 < 4; ++s4) { S0 = MFMA32(kf[s4][0], Qf[s4], S0); S1 = MFMA32(kf[s4][1], Qf[s4], S1); } } while (0)
#define ATT_PV(kt) do { const LAS unsigned char* Vb = lds + ((kt) % 3) * 32768 + 16384; \
        _Pragma("unroll") for (int c2 = 0; c2 < 4; c2 += 2) { bf16x8 vf[2][4]; \
            _Pragma("unroll") for (int cc = 0; cc < 2; ++cc) { const LAS unsigned char* vp0 = Vb + vad[0][c2 + cc]; const LAS unsigned char* vp1 = Vb + vad[1][c2 + cc]; asm volatile("" : "+v"(vp0), "+v"(vp1)); \
                _Pragma("unroll") for (int ks = 0; ks < 4; ++ks) vf[cc][ks] = cat8(tr_read(vp0 + 4096 * ks), tr_read(vp1 + 4096 * ks)); } \
            _Pragma("unroll") for (int cc = 0; cc < 2; ++cc) _Pragma("unroll") for (int ks = 0; ks < 4; ++ks) O[c2 + cc] = MFMA32(vf[cc][ks], Pf[ks], O[c2 + cc]); } } while (0)
#define ATT_SM(kt, PN) do { \
        const bool nearT = (kt) >= cq - 2; float mx; \
        if (nearT) { const int idx0 = 64 * (kt) - q0 - (lane & 31) + 4 * h_ + 191; \
            _Pragma("unroll") for (int r = 0; r < 16; ++r) { const int cr = (r & 3) + 8 * (r >> 2); S0[r] = S0[r] * C1 + TAB2[idx0 + cr]; S1[r] = S1[r] * C1 + TAB2[idx0 + 32 + cr]; } } \
        mx = vmax(S0[0], S1[0]); \
        _Pragma("unroll") for (int r = 1; r < 16; ++r) mx = vmax3(mx, S0[r], S1[r]); \
        if (!nearT) mx = mx * C1 + far2; \
        mx = vmax(mx, __shfl_xor(mx, 32)); \
        float alpha = 1.0f; const bool resc = __any(mx > m + THR); \
        if (resc) { const float mn = vmax(m, mx); alpha = __builtin_amdgcn_exp2f(m - mn); m = mn; } \
        float rsum = 0.f; \
        if (nearT) { _Pragma("unroll") for (int r = 0; r < 16; ++r) { S0[r] = __builtin_amdgcn_exp2f(S0[r] - m); S1[r] = __builtin_amdgcn_exp2f(S1[r] - m); rsum += S0[r] + S1[r]; } } \
        else { const float nb = far2 - m; _Pragma("unroll") for (int r = 0; r < 16; ++r) { S0[r] = __builtin_amdgcn_exp2f(__builtin_fmaf(S0[r], C1, nb)); S1[r] = __builtin_amdgcn_exp2f(__builtin_fmaf(S1[r], C1, nb)); rsum += S0[r] + S1[r]; } } \
        PN[0] = pack8(S0[0], S0[1], S0[2], S0[3], S0[4], S0[5], S0[6], S0[7]); PN[1] = pack8(S0[8], S0[9], S0[10], S0[11], S0[12], S0[13], S0[14], S0[15]); \
        PN[2] = pack8(S1[0], S1[1], S1[2], S1[3], S1[4], S1[5], S1[6], S1[7]); PN[3] = pack8(S1[8], S1[9], S1[10], S1[11], S1[12], S1[13], S1[14], S1[15]); \
        lsum = lsum * alpha + rsum; \
        if (resc) { _Pragma("unroll") for (int c = 0; c < 4; ++c) _Pragma("unroll") for (int r = 0; r < 16; ++r) O[c][r] *= alpha; } } while (0)
    ATT_STAGE(0); ATT_STAGE(1);
    asm volatile("s_waitcnt vmcnt(4)" ::: "memory"); LBAR();
    for (int kt = 0; kt < ntiles; ++kt) {
        const bool more = kt + 2 < ntiles;
        if (more) ATT_STAGE(kt + 2);
        if (kt <= cq) { ATT_QK(kt); ATT_SM(kt, Pf); ATT_PV(kt); }
        if (more) asm volatile("s_waitcnt vmcnt(4)" ::: "memory"); else asm volatile("s_waitcnt vmcnt(0)" ::: "memory");
        LBAR();
    }
#undef ATT_STAGE
#undef ATT_QK
#undef ATT_PV
#undef ATT_SM
    const float ltot = lsum + __shfl_xor(lsum, 32), inv = 1.0f / ltot;
    LAS float* COMB = (LAS float*)lds;
    if (map == 1) {
#pragma unroll
        for (int c = 0; c < 4; ++c)
#pragma unroll
            for (int r = 0; r < 16; ++r) COMB[(wq * 64 + c * 16 + r) * 64 + lane] = O[c][r] * inv;
    }
    __syncthreads();
    if (map == 0) {
        float ss = 0.f;
#pragma unroll
        for (int c = 0; c < 4; ++c)
#pragma unroll
            for (int r = 0; r < 16; ++r) { const float o = O[c][r] * inv - lam * COMB[(wq * 64 + c * 16 + r) * 64 + lane]; O[c][r] = o; ss += o * o; }
        ss += __shfl_xor(ss, 32);
        const float rms = cfin * __builtin_amdgcn_rsqf(ss * (1.0f / 128.0f) + EPS);
        bf16* op = MIX + (size_t)(tokbase + q0 + (lane & 31)) * D + 1280 + hh * 128 + 4 * h_;
        const LAS float* sg = SGL + 4 * h_;
#pragma unroll
        for (int c = 0; c < 4; ++c)
#pragma unroll
            for (int g = 0; g < 4; ++g) { const f32x4 gv = *(const LAS f32x4*)(sg + 32 * c + 8 * g);
                u32x2 wv; wv.x = pk2(O[c][4 * g] * rms * gv[0], O[c][4 * g + 1] * rms * gv[1]); wv.y = pk2(O[c][4 * g + 2] * rms * gv[2], O[c][4 * g + 3] * rms * gv[3]);
                *(u32x2*)(op + 32 * c + 8 * g) = wv; }
    }
    __syncthreads();
}

constexpr int GL_G = 0, GL_QN = 16384, GL_KF = 25600, GL_KN = 34816, GL_OP = 0, GL_QF = 44032, GL_KD = 53248, GL_AM = 62464, GL_VV = 71680, GL_SS = 89088, GL_ALR = 106496, GL_DEC = 110592, GL_SEG = 110848, GL_GL = 112896, GL_GNG = 113664, GL_ALRB = 134144, GL_WA2H = 108544, GL_WA2L = 114688, GL_Z = 116736;
DI void gla_unit(Frame& F, int l, int b, int hh) {
    const int tid = F.tid, lane = F.lane, w = F.wave;
    const bf16* PROJ = (const bf16*)(F.ws + WS_PROJ);
    bf16* MIX = (bf16*)(F.ws + WS_MIX);
    LAS unsigned char* lds = F.lds;
    LAS float* G = (LAS float*)(lds + GL_G); LAS float* OP = (LAS float*)(lds + GL_OP); LAS float* ALR = (LAS float*)(lds + GL_ALR);
    LAS float* DEC = (LAS float*)(lds + GL_DEC); LAS float* SEG = (LAS float*)(lds + GL_SEG); LAS float* GLL = (LAS float*)(lds + GL_GL);
    const int tokbase = b * SEQ;
    const int ta = tid >> 3, dg = tid & 7;
    const int cd = tid & 63, seg = tid >> 6;
    const int h_ = lane >> 5, blk = (lane >> 4) & 1, qq = (lane & 15) >> 2, pp = lane & 3;
    for (int i = tid; i < 1024; i += 512) { const int ch = i >> 4, r = i & 15; const float wv = PARP(I_GWA2)[((size_t)l * 16 + r) * 384 + hh * 64 + ch];
        const unsigned hi = pk2(wv, 0.f) & 0xffffu; const float res = wv - __uint_as_float(hi << 16);
        *(LAS bf16*)(lds + GL_WA2H + i * 2) = (bf16)hi; *(LAS bf16*)(lds + GL_WA2L + i * 2) = (bf16)(pk2(res, 0.f) & 0xffffu); }
    LAS float* Zf = (LAS float*)(lds + GL_Z);
    const int t2 = tid - 256;
    const bool a_lane = t2 >= 0 && t2 < 128;
#define GLA_ZSTAGE() do { if (w < 4) { const int tb_ = w >> 1, cb_ = w & 1; f32x16 z_; _Pragma("unroll") for (int r = 0; r < 16; ++r) z_[r] = 0.f; \
        const bf16x8 bA_ = *(const LAS bf16x8*)(lds + GL_ALRB + (32 * tb_ + (lane & 31)) * 32 + 16 * h_); \
        z_ = MFMA32(*(const LAS bf16x8*)(lds + GL_WA2H + (32 * cb_ + (lane & 31)) * 32 + 16 * h_), bA_, z_); \
        z_ = MFMA32(*(const LAS bf16x8*)(lds + GL_WA2L + (32 * cb_ + (lane & 31)) * 32 + 16 * h_), bA_, z_); \
        _Pragma("unroll") for (int g = 0; g < 4; ++g) *(LAS f32x4*)(Zf + (32 * tb_ + (lane & 31)) * 68 + 32 * cb_ + 8 * g + 4 * h_) = (f32x4){z_[4 * g], z_[4 * g + 1], z_[4 * g + 2], z_[4 * g + 3]}; } } while (0)
    LAS float* GNL = (LAS float*)(lds + GL_GNG);
    if (tid < 128) GNL[tid] = PARP(I_GNG)[l * 768 + hh * 128 + tid];
    const float ba = PARP(I_GBA)[l * 384 + hh * 64 + cd];
    f32x16 Sacc;
#pragma unroll
    for (int r = 0; r < 16; ++r) Sacc[r] = 0.f;
    const int sdb = w >> 2, svb = w & 3;
    for (int i = tid; i < 128 * 144 / 4; i += 512) ((LAS unsigned*)(lds + GL_SS))[i] = 0u;
    u32x4 nq, nk, nv0, nv1, nog0, nog1, na;
    {
        const bf16* rp = PROJ + (size_t)(tokbase + ta) * PLD;
        nq = *(const u32x4*)(rp + C_GQ + hh * 64 + 8 * dg); nk = *(const u32x4*)(rp + C_GK + hh * 64 + 8 * dg);
        nv0 = *(const u32x4*)(rp + C_GV + hh * 128 + 16 * dg); nv1 = *(const u32x4*)(rp + C_GV + hh * 128 + 16 * dg + 8);
        nog0 = *(const u32x4*)(rp + C_GOG + hh * 128 + 16 * dg); nog1 = *(const u32x4*)(rp + C_GOG + hh * 128 + 16 * dg + 8);
        na = a_lane ? *(const u32x4*)(PROJ + (size_t)(tokbase + (t2 >> 1)) * PLD + C_GA + 8 * (t2 & 1)) : (u32x4){0u, 0u, 0u, 0u};
    }
#define GLA_ALR_WRITE() do { if (a_lane) *(LAS u32x4*)(lds + GL_ALRB + t2 * 16) = na; } while (0)
    GLA_ALR_WRITE();
    LBAR();
    GLA_ZSTAGE();
    LBAR();
    for (int n = 0; n < 32; ++n) {
        const int tok0 = tokbase + 64 * n;
        const u32x4 cq_ = nq, ck_ = nk, cv0 = nv0, cv1 = nv1;
        float g8[8]; float run = 0.f;
#pragma unroll
        for (int tt = 0; tt < 8; ++tt) { const float x = ba + Zf[(8 * seg + tt) * 68 + cd];
            const float ls = fminf(x, 0.f) - __logf(1.0f + __expf(-fabsf(x)));
            run += ls * (1.0f / 16.0f); g8[tt] = run; }
        SEG[seg * 64 + cd] = run;
        LBAR();
        { float off = 0.f;
#pragma unroll
          for (int s2 = 0; s2 < 8; ++s2) off += (s2 < seg) ? SEG[s2 * 64 + cd] : 0.f;
#pragma unroll
          for (int tt = 0; tt < 8; ++tt) G[(8 * seg + tt) * 64 + cd] = g8[tt] + off;
          if (seg == 7) DEC[cd] = __expf(g8[7] + off); }
        if (n + 1 < 32) { const bf16* rp = PROJ + (size_t)(tok0 + 64 + ta) * PLD;
            nq = *(const u32x4*)(rp + C_GQ + hh * 64 + 8 * dg); nk = *(const u32x4*)(rp + C_GK + hh * 64 + 8 * dg);
            nv0 = *(const u32x4*)(rp + C_GV + hh * 128 + 16 * dg); nv1 = *(const u32x4*)(rp + C_GV + hh * 128 + 16 * dg + 8);
            if (a_lane) na = *(const u32x4*)(PROJ + (size_t)(tok0 + 64 + (t2 >> 1)) * PLD + C_GA + 8 * (t2 & 1)); }
        LBAR();
        {
            const float qv[8] = {bflo(cq_.x), bfhi(cq_.x), bflo(cq_.y), bfhi(cq_.y), bflo(cq_.z), bfhi(cq_.z), bflo(cq_.w), bfhi(cq_.w)};
            const float kv[8] = {bflo(ck_.x), bfhi(ck_.x), bflo(ck_.y), bfhi(ck_.y), bflo(ck_.z), bfhi(ck_.z), bflo(ck_.w), bfhi(ck_.w)};
            float qf[8], qn[8], kf[8], kn[8], kd[8];
#pragma unroll
            for (int j = 0; j < 8; ++j) { const float g = G[ta * 64 + 8 * dg + j]; const float eg = __expf(g), eng = __expf(-g), ed = DEC[8 * dg + j] * eng;
                qf[j] = qv[j] * 0.125f * eg; qn[j] = qv[j] * 0.125f * eng; kf[j] = kv[j] * eg; kn[j] = kv[j] * eng; kd[j] = kv[j] * ed; }
            const int to = ta * 144 + 16 * dg;
            *(LAS bf16x8*)(lds + GL_QF + to) = pack8(qf[0], qf[1], qf[2], qf[3], qf[4], qf[5], qf[6], qf[7]);
            *(LAS bf16x8*)(lds + GL_QN + to) = pack8(qn[0], qn[1], qn[2], qn[3], qn[4], qn[5], qn[6], qn[7]);
            *(LAS bf16x8*)(lds + GL_KF + to) = pack8(kf[0], kf[1], kf[2], kf[3], kf[4], kf[5], kf[6], kf[7]);
            *(LAS bf16x8*)(lds + GL_KN + to) = pack8(kn[0], kn[1], kn[2], kn[3], kn[4], kn[5], kn[6], kn[7]);
            *(LAS bf16x8*)(lds + GL_KD + to) = pack8(kd[0], kd[1], kd[2], kd[3], kd[4], kd[5], kd[6], kd[7]);
            *(LAS u32x4*)(lds + GL_VV + ta * 272 + 32 * dg) = cv0; *(LAS u32x4*)(lds + GL_VV + ta * 272 + 32 * dg + 16) = cv1;
        }
        LBAR();
        if (w < 4) {
            const int ib = w >> 1, jb = w & 1;
            f32x16 cf, cb_;
#pragma unroll
            for (int r = 0; r < 16; ++r) { cf[r] = 0.f; cb_[r] = 0.f; }
            const int ra = (32 * jb + (lane & 31)) * 144 + 16 * h_, rb = (32 * ib + (lane & 31)) * 144 + 16 * h_;
            if (jb <= ib) {
#pragma unroll
                for (int s = 0; s < 4; ++s) cf = MFMA32(*(const LAS bf16x8*)(lds + GL_KN + ra + 32 * s), *(const LAS bf16x8*)(lds + GL_QF + rb + 32 * s), cf); }
            if (jb >= ib) {
#pragma unroll
                for (int s = 0; s < 4; ++s) cb_ = MFMA32(*(const LAS bf16x8*)(lds + GL_KF + ra + 32 * s), *(const LAS bf16x8*)(lds + GL_QN + rb + 32 * s), cb_); }
            const int i_ = 32 * ib + (lane & 31);
#pragma unroll
            for (int g = 0; g < 4; ++g) { float v[4];
#pragma unroll
                for (int j = 0; j < 4; ++j) { const int jj = 32 * jb + 8 * g + 4 * h_ + j; v[j] = (jj <= i_) ? cf[4 * g + j] : cb_[4 * g + j]; }
                u32x2 wv; wv.x = pk2(v[0], v[1]); wv.y = pk2(v[2], v[3]);
                *(LAS u32x2*)(lds + GL_AM + i_ * 144 + (32 * jb + 8 * g + 4 * h_) * 2) = wv; }
        } else { GLA_ALR_WRITE(); }
        LBAR();
        {
            const int ib = w >> 2, vb = w & 3;
            bf16x8 vvf[4];
#pragma unroll
            for (int ks = 0; ks < 4; ++ks) { const LAS unsigned char* p0 = lds + GL_VV + (16 * ks + 8 * h_ + qq) * 272 + (32 * vb + 16 * blk + 4 * pp) * 2; vvf[ks] = cat8(tr_read(p0), tr_read(p0 + 4 * 272)); }
            f32x16 o;
#pragma unroll
            for (int r = 0; r < 16; ++r) o[r] = 0.f;
            const int ra = (32 * ib + (lane & 31)) * 144 + 16 * h_;
#pragma unroll
            for (int ks = 0; ks < 4; ++ks) o = MFMA32(*(const LAS bf16x8*)(lds + GL_AM + ra + 32 * ks), vvf[ks], o);
#pragma unroll
            for (int ks = 0; ks < 4; ++ks) o = MFMA32(*(const LAS bf16x8*)(lds + GL_QF + ra + 32 * ks), *(const LAS bf16x8*)(lds + GL_SS + (32 * vb + (lane & 31)) * 144 + 16 * h_ + 32 * ks), o);
#pragma unroll
            for (int r = 0; r < 16; ++r) Sacc[r] *= DEC[32 * sdb + (r & 3) + 8 * (r >> 2) + 4 * h_];
#pragma unroll
            for (int ks = 0; ks < 4; ++ks) { const LAS unsigned char* p0 = lds + GL_KD + (16 * ks + 8 * h_ + qq) * 144 + (32 * sdb + 16 * blk + 4 * pp) * 2;
                Sacc = MFMA32(cat8(tr_read(p0), tr_read(p0 + 4 * 144)), vvf[ks], Sacc); }
            GLA_ZSTAGE();
            LBAR();
#pragma unroll
            for (int r = 0; r < 16; ++r) { const int rr = (r & 3) + 8 * (r >> 2) + 4 * h_;
                OP[(32 * ib + rr) * 132 + 32 * vb + (lane & 31)] = o[r]; }
#pragma unroll
            for (int g = 0; g < 4; ++g) { u32x2 sv; sv.x = pk2(Sacc[4 * g], Sacc[4 * g + 1]); sv.y = pk2(Sacc[4 * g + 2], Sacc[4 * g + 3]);
                *(LAS u32x2*)(lds + GL_SS + (32 * svb + (lane & 31)) * 144 + (32 * sdb + 8 * g + 4 * h_) * 2) = sv; }
        }
        LBAR();
        {
            f32x4 ov[4]; float ss = 0.f;
#pragma unroll
            for (int j = 0; j < 4; ++j) { ov[j] = *(const LAS f32x4*)(OP + ta * 132 + 16 * dg + 4 * j); ss += (ov[j][0] * ov[j][0] + ov[j][1] * ov[j][1]) + (ov[j][2] * ov[j][2] + ov[j][3] * ov[j][3]); }
            ss += __shfl_xor(ss, 1); ss += __shfl_xor(ss, 2); ss += __shfl_xor(ss, 4);
            const float rms = __builtin_amdgcn_rsqf(ss * (1.0f / 128.0f) + EPS);
            const LAS float* ng = GNL + 16 * dg;
            const unsigned ogw[8] = {nog0.x, nog0.y, nog0.z, nog0.w, nog1.x, nog1.y, nog1.z, nog1.w};
            unsigned ow[8];
#pragma unroll
            for (int j = 0; j < 4; ++j) {
                const float a0 = ov[j][0] * rms * bflo(ogw[2 * j]), a1 = ov[j][1] * rms * bfhi(ogw[2 * j]);
                const float a2 = ov[j][2] * rms * bflo(ogw[2 * j + 1]), a3 = ov[j][3] * rms * bfhi(ogw[2 * j + 1]);
                ow[2 * j] = pk2(a0, a1); ow[2 * j + 1] = pk2(a2, a3); }
            bf16* op = MIX + (size_t)(tok0 + ta) * D + hh * 128 + 16 * dg;
            *(u32x4*)op = (u32x4){ow[0], ow[1], ow[2], ow[3]}; *(u32x4*)(op + 8) = (u32x4){ow[4], ow[5], ow[6], ow[7]};
            if (n + 1 < 32) { const bf16* rp = PROJ + (size_t)(tok0 + 64 + ta) * PLD;
                nog0 = *(const u32x4*)(rp + C_GOG + hh * 128 + 16 * dg); nog1 = *(const u32x4*)(rp + C_GOG + hh * 128 + 16 * dg + 8); }
        }
        LBAR();
    }
}

constexpr int LR_XR = 0, LR_XC = 17408, LR_XCB = 33792, LR_WAB = 43008, LR_WXB = 52224, LR_RI = 61440, LR_SP = 95232, LR_SH = 97280, LR_HC = 99328;
#undef GLA_ALR_WRITE
#undef GLA_ZSTAGE
DI void lru_unit(Frame& F, int l, int b, int nb) {
    const int tid = F.tid, lane = F.lane, w = F.wave;
    const bf16* PROJ = (const bf16*)(F.ws + WS_PROJ);
    bf16* MIX = (bf16*)(F.ws + WS_MIX);
    LAS unsigned char* lds = F.lds;
    LAS float* XR = (LAS float*)(lds + LR_XR); LAS float* XC = (LAS float*)(lds + LR_XC); LAS float* RI = (LAS float*)(lds + LR_RI);
    LAS float* SP = (LAS float*)(lds + LR_SP); LAS float* SH = (LAS float*)(lds + LR_SH); LAS float* HC = (LAS float*)(lds + LR_HC);
    const int tokbase = b * SEQ, ch0 = nb * 64;
    const int ta = tid >> 3, cg = tid & 7;
    const int cc = tid & 63, seg = tid >> 6;
    const int h_ = lane >> 5, blk = (lane >> 4) & 1, qq = (lane & 15) >> 2, pp = lane & 3;
    float cw[4][8], cb[8];
#pragma unroll
    for (int j = 0; j < 8; ++j) { cb[j] = PARP(I_LCB)[l * 512 + ch0 + 8 * cg + j];
#pragma unroll
        for (int i = 0; i < 4; ++i) cw[i][j] = PARP(I_LCW)[((size_t)l * 4 + i) * 512 + ch0 + 8 * cg + j]; }
    const float bac = PARP(I_LBA)[l * 512 + ch0 + cc], bxc = PARP(I_LBX)[l * 512 + ch0 + cc];
    const float lamc = PARP(I_LLAM)[l * 512 + ch0 + cc]; const float c8 = -8.0f * LOG2E * log1pf(__expf(-lamc));
    for (int i = tid; i < 64 * 64; i += 512) { const int d = i >> 6, e = i & 63;
        *(LAS bf16*)(lds + LR_WAB + d * 144 + e * 2) = (bf16)(pk2(PARP(I_LWA)[(((size_t)l * 8 + nb) * 64 + d) * 64 + e], 0.f) & 0xffffu);
        *(LAS bf16*)(lds + LR_WXB + d * 144 + e * 2) = (bf16)(pk2(PARP(I_LWX)[(((size_t)l * 8 + nb) * 64 + d) * 64 + e], 0.f) & 0xffffu); }
    if (tid < 192) XR[tid] = 0.f;
    if (tid < 64) HC[tid] = 0.f;
    u32x4 nx, ny;
    { const bf16* rp = PROJ + (size_t)(tokbase + ta) * PLD; nx = *(const u32x4*)(rp + C_LX + ch0 + 8 * cg); ny = *(const u32x4*)(rp + C_LY + ch0 + 8 * cg); }
    LBAR();
    for (int n = 0; n < 32; ++n) {
        const int tok0 = tokbase + 64 * n, par = n & 1;
        { LAS float* xp = XR + (3 + ta) * 64 + 8 * cg;
          *(LAS f32x4*)xp = (f32x4){bflo(nx.x), bfhi(nx.x), bflo(nx.y), bfhi(nx.y)}; *(LAS f32x4*)(xp + 4) = (f32x4){bflo(nx.z), bfhi(nx.z), bflo(nx.w), bfhi(nx.w)}; }
        if (n + 1 < 32) nx = *(const u32x4*)(PROJ + (size_t)(tok0 + 64 + ta) * PLD + C_LX + ch0 + 8 * cg);
        LBAR();
        { float xc[8];
#pragma unroll
          for (int j = 0; j < 8; ++j) xc[j] = cb[j];
#pragma unroll
          for (int i = 0; i < 4; ++i) { const f32x4 a = *(const LAS f32x4*)(XR + (ta + i) * 64 + 8 * cg), c2 = *(const LAS f32x4*)(XR + (ta + i) * 64 + 8 * cg + 4);
              xc[0] += a[0] * cw[i][0]; xc[1] += a[1] * cw[i][1]; xc[2] += a[2] * cw[i][2]; xc[3] += a[3] * cw[i][3];
              xc[4] += c2[0] * cw[i][4]; xc[5] += c2[1] * cw[i][5]; xc[6] += c2[2] * cw[i][6]; xc[7] += c2[3] * cw[i][7]; }
          *(LAS f32x4*)(XC + ta * 64 + 8 * cg) = (f32x4){xc[0], xc[1], xc[2], xc[3]}; *(LAS f32x4*)(XC + ta * 64 + 8 * cg + 4) = (f32x4){xc[4], xc[5], xc[6], xc[7]};
          *(LAS bf16x8*)(lds + LR_XCB + ta * 144 + 16 * cg) = pack8(xc[0], xc[1], xc[2], xc[3], xc[4], xc[5], xc[6], xc[7]); }
        LBAR();
        if (tid < 192) XR[tid] = XR[64 * 64 + tid];
        { const int mat = w >> 2, tb = (w >> 1) & 1, eb = w & 1;
          const int wo = mat ? LR_WXB : LR_WAB;
          f32x16 c;
#pragma unroll
          for (int r = 0; r < 16; ++r) c[r] = 0.f;
          const int ra = (32 * tb + (lane & 31)) * 144 + 16 * h_;
#pragma unroll
          for (int ks = 0; ks < 4; ++ks) { const LAS unsigned char* p0 = lds + wo + (16 * ks + 8 * h_ + qq) * 144 + (32 * eb + 16 * blk + 4 * pp) * 2;
              c = MFMA32(*(const LAS bf16x8*)(lds + LR_XCB + ra + 32 * ks), cat8(tr_read(p0), tr_read(p0 + 4 * 144)), c); }
#pragma unroll
          for (int r = 0; r < 16; ++r) RI[(mat * 64 + 32 * tb + (r & 3) + 8 * (r >> 2) + 4 * h_) * 66 + 32 * eb + (lane & 31)] = c[r]; }
        LBAR();
        float hloc[8], pcum[8];
        { float Hh = 0.f, P = 1.f;
#pragma unroll
          for (int tt = 0; tt < 8; ++tt) { const int t = 8 * seg + tt;
              const float rg = fsigmoid(RI[t * 66 + cc] + bac), ig = fsigmoid(RI[(64 + t) * 66 + cc] + bxc), xc = XC[t * 64 + cc];
              const float a = __builtin_amdgcn_exp2f(rg * c8), om = fmaxf(1.0f - a * a, 0.0f), bb = __builtin_amdgcn_sqrtf(om) * (ig * xc);
              Hh = a * Hh + bb; P *= a; hloc[tt] = Hh; pcum[tt] = P; }
          SP[seg * 64 + cc] = P; SH[seg * 64 + cc] = Hh; }
        LBAR();
        { float hin = HC[par * 64 + cc]; float sp[7], sh7[7];
#pragma unroll
          for (int s2 = 0; s2 < 7; ++s2) { sp[s2] = SP[s2 * 64 + cc]; sh7[s2] = SH[s2 * 64 + cc]; }
#pragma unroll
          for (int s2 = 0; s2 < 7; ++s2) { const float nh = sp[s2] * hin + sh7[s2]; hin = (s2 < seg) ? nh : hin; }
#pragma unroll
          for (int tt = 0; tt < 8; ++tt) XC[(8 * seg + tt) * 64 + cc] = hloc[tt] + pcum[tt] * hin;
          if (seg == 7) HC[(par ^ 1) * 64 + cc] = hloc[7] + pcum[7] * hin; }
        LBAR();
        { const f32x4 h0 = *(const LAS f32x4*)(XC + ta * 64 + 8 * cg), h1 = *(const LAS f32x4*)(XC + ta * 64 + 8 * cg + 4);
          u32x4 o; o.x = pk2(h0[0] * fgelu_tanh(bflo(ny.x)), h0[1] * fgelu_tanh(bfhi(ny.x))); o.y = pk2(h0[2] * fgelu_tanh(bflo(ny.y)), h0[3] * fgelu_tanh(bfhi(ny.y)));
          o.z = pk2(h1[0] * fgelu_tanh(bflo(ny.z)), h1[1] * fgelu_tanh(bfhi(ny.z))); o.w = pk2(h1[2] * fgelu_tanh(bflo(ny.w)), h1[3] * fgelu_tanh(bfhi(ny.w)));
          *(u32x4*)(MIX + (size_t)(tok0 + ta) * D + 768 + ch0 + 8 * cg) = o;
          if (n + 1 < 32) ny = *(const u32x4*)(PROJ + (size_t)(tok0 + 64 + ta) * PLD + C_LY + ch0 + 8 * cg); }
        LBAR();
    }
}

DI void p_mixers(Frame& F, int l) {
    const float lam_init = 0.8f - 0.6f * expf(-0.3f * (float)l);
    if (F.wave == 0) {
        float a = (F.lane < 64) ? PARP(I_DLQ1)[l * 64 + F.lane] * PARP(I_DLK1)[l * 64 + F.lane] : 0.f, c = PARP(I_DLQ2)[l * 64 + F.lane] * PARP(I_DLK2)[l * 64 + F.lane];
        a = wave_sum(a); c = wave_sum(c);
        if (F.lane == 0) F.MISC[4] = __float_as_uint(expf(a) - expf(c) + lam_init);
    }
    __syncthreads();
    const float lam = __uint_as_float(F.MISC[4]);
    unsigned* q = F.ctl + CW_Q + 64 * 4 * l + 512 * F.qset;
#define CONVERT_LOOP() do { if (!(F.skip & 8)) for (;;) { const int it = dequeue(F, q + 192); if (it >= 1024) break; moe_convert_wg(F, l, it); } } while (0)
    const bool streamer = ((blockIdx.x >> 3) & 7) < 3;
    if (streamer) CONVERT_LOOP();
    if (!(F.skip & 1)) for (;;) { const int it = dequeue(F, q); if (it >= 48) break; gla_unit(F, l, it / 6, it % 6); }
    if (!(F.skip & 2)) for (;;) { const int it = dequeue(F, q + 64); if (it >= 64) break; lru_unit(F, l, it >> 3, it & 7); }
    if (!(F.skip & 4)) for (;;) { const int it = dequeue(F, q + 128); if (it >= 768) break; const int qb = 15 - it / 48, bh = it % 48; attn_unit(F, l, bh / 6, bh % 6, qb, lam, 1.0f - lam_init); }
    if (!streamer && !(F.skip & 16)) CONVERT_LOOP();
#undef CONVERT_LOOP
}

#define REFRESH() do { int t_ = threadIdx.x; asm volatile("" : "+v"(t_)); F.tid = t_; F.lane = t_ & 63; F.wave = __builtin_amdgcn_readfirstlane(t_ >> 6); } while (0)
#define IN(k) (lo <= (k) && (k) < hi)
#define SEAM(k) do { if (IN(k) && IN((k) + 1)) xcd_barrier(bar); } while (0)
template <int L>
DI void layer_phases(Frame& F, const XcdBarrier& bar, const int lo, const int hi) {
    constexpr int l = L, pb = 1 + 7 * L;
    if (IN(pb)) { REFRESH(); p_norm<L>(F); SEAM(pb); }
    if (IN(pb + 1)) {
        REFRESH();
        pg8::DenseSched S; S.init(F.ws + WS_U, F.ws + WS_WIN + (size_t)l * PLD * D * 2, T, PLD, D, F.G, (int)blockIdx.x);
        pg8::EpiProj E{(bf16*)(F.ws + WS_PROJ), PLD, PARP(I_GNG) + l * 768};
        pg8::gemm_phase<pg8::EpiProj, pg8::DenseSched>(F.lds, S, E);
        SEAM(pb + 1);
    }
    if (IN(pb + 2)) { REFRESH(); p_mixers(F, l); SEAM(pb + 2); }
    if (IN(pb + 3)) {
        REFRESH();
        pg8::DenseSched S; S.init(F.ws + WS_MIX, F.ws + WS_WOUT + (size_t)l * D * D * 2, T, D, D, F.G, (int)blockIdx.x);
        pg8::EpiDelta E{(bf16*)(F.ws + WS_DELTA), (const float*)(F.ws + WS_MOD) + (size_t)l * NB * 6 * D + 2 * D};
        pg8::gemm_phase<pg8::EpiDelta, pg8::DenseSched>(F.lds, S, E);
        SEAM(pb + 3);
    }
    if (IN(pb + 4)) { REFRESH(); p_norm2_router(F, l); SEAM(pb + 4); }
#define MOE_SPLIT() const int n1 = ntile * 4, R2 = n1 / F.G, rem = n1 - R2 * F.G, n_idle = F.G - rem; \
        int E_rt = (rem > 0) ? (3 * n_idle) / 8 : 0; { const int cap = R2 * (F.G / 4); if (E_rt > cap) E_rt = cap; }
    if (IN(pb + 5)) {
        REFRESH();
        const int ntile = moe_tiles(F, l);
        const LAS int* TE = (const LAS int*)(F.lds + TILETAB_OFF); const LAS int* TL = TE + 192; const LAS int* CN = TE + 384;
        LAS unsigned* RT = (LAS unsigned*)(F.lds + ROWTAB_OFF); LAS int* RT2 = (LAS int*)(F.lds + ROWTAB_OFF);
        const int* LIST = (const int*)(F.ws + WS_LIST); const float* WT = (const float*)(F.ws + WS_WT);
        MOE_SPLIT();
        const int c = (int)blockIdx.x;
        pg8::MoeSched S; S.K = D; S.A = (const char*)(F.ws + WS_U); S.Bt = (const char*)(F.ws + WS_W13) + (size_t)l * NE * 1024 * D * 2; S.Bf0 = nullptr; S.Bf1 = nullptr; S.bstride_e = 1024u * D * 2u; S.bstride_pn = 256u * 2u * D;
        S.npn = 4; S.G = F.G; S.c = c; S.tile_e = TE; S.tile_l = TL; S.rowtab = RT; S.gather = true;
        S.rt0 = 0; S.rt_end = ntile; S.rmax = R2; S.lin = 0; S.L0 = 0; S.Lend = 0; S.cl = 0; S.Gl = 1;
        pg8::EpiSwiglu E{(bf16*)(F.ws + WS_HID)};
#define FILL_RT() do { for (int ui = 0; ui < 12; ++ui) { int rt, pn; if (!S.unit_of(ui, rt, pn)) break; const int e = TE[rt], tl = TL[rt]; \
            for (int r = F.tid; r < 256; r += 512) { const int slot = tl * 256 + r; RT[ui * 256 + r] = (slot < CN[e]) ? (unsigned)(LIST[e * 16384 + slot] >> 1) : 0u; } } __syncthreads(); } while (0)
#define FILL_RT2(S2) do { for (int ui = 0; ui < 6; ++ui) { int rt, pn; if (!(S2).unit_of(ui, rt, pn)) break; const int e = TE[rt], tl = TL[rt]; \
            for (int r = F.tid; r < 256; r += 512) { const int slot = tl * 256 + r; int a = -1, wb = 0; if (slot < CN[e]) { a = LIST[e * 16384 + slot]; wb = __float_as_int(WT[a]); } \
                RT2[(ui * 256 + r) * 2] = a; RT2[(ui * 256 + r) * 2 + 1] = wb; } } __syncthreads(); } while (0)
        FILL_RT();
        pg8::gemm_phase<pg8::EpiSwiglu, pg8::MoeSched>(F.lds, S, E);
        if (rem > 0) {
            xcd_barrier(bar);
            const int rtB = ntile - R2 * (F.G / 4), perB = (rtB + 7) >> 3;
#define PB_RT(cc) (R2 * (F.G / 4) + perB * ((cc) & 7) + ((cc) >> 5))
#define PB_BUSY(cc) ((((cc) >> 5) < perB) && (PB_RT(cc) < ntile))
            __syncthreads();
            if (F.tid == 0) F.MISC[6] = 0u;
            __syncthreads();
            if (F.tid < c && !PB_BUSY(F.tid)) __hip_atomic_fetch_add((LAS unsigned*)(F.lds + MISC_OFF) + 6, 1u, __ATOMIC_RELAXED, __HIP_MEMORY_SCOPE_WORKGROUP);
            __syncthreads();
            const int idle_rank = (int)F.MISC[6];
            if (PB_BUSY(c)) {
                S.rmax = 1; S.lin = 1; S.L0 = PB_RT(c) * 4 + ((c >> 3) & 3); S.Lend = S.L0 + 1; S.cl = 0; S.Gl = 1;
                __syncthreads(); FILL_RT();
                pg8::gemm_phase<pg8::EpiSwiglu, pg8::MoeSched>(F.lds, S, E);
            } else if (E_rt > 0) {
                pg8::MoeSched S2; S2.K = DE; S2.A = (const char*)(F.ws + WS_HID); S2.Bt = (const char*)(F.ws + WS_W2); S2.Bf0 = F.in[I_W2] + (size_t)l * NE * DE * D; S2.Bf1 = nullptr; S2.bstride_e = (unsigned)D * DE * 4u; S2.bstride_pn = 1024u;
                S2.npn = 8; S2.G = F.G; S2.c = c; S2.tile_e = TE; S2.tile_l = TL; S2.rowtab = nullptr; S2.gather = false;
                S2.rt0 = 0; S2.rt_end = E_rt; S2.rmax = 3; S2.lin = 1; S2.L0 = 0; S2.Lend = 8 * E_rt; S2.cl = idle_rank; S2.Gl = n_idle;
                __syncthreads(); FILL_RT2(S2);
                pg8::EpiY2 E2{(bf16*)(F.ws + WS_Y2), RT2};
                pg8::gemm_phase<pg8::EpiY2, pg8::MoeSched, true, 2>(F.lds, S2, E2);
            }
        }
        SEAM(pb + 5);
    }
    if (IN(pb + 6)) {
        REFRESH();
        const int ntile = moe_tiles(F, l);
        const LAS int* TE = (const LAS int*)(F.lds + TILETAB_OFF); const LAS int* TL = TE + 192; const LAS int* CN = TE + 384;
        LAS int* RT2 = (LAS int*)(F.lds + ROWTAB_OFF);
        const int* LIST = (const int*)(F.ws + WS_LIST); const float* WT = (const float*)(F.ws + WS_WT);
        MOE_SPLIT();
        pg8::MoeSched S; S.K = DE; S.A = (const char*)(F.ws + WS_HID); S.Bt = (const char*)(F.ws + WS_W2); S.Bf0 = F.in[I_W2] + (size_t)l * NE * DE * D; S.Bf1 = nullptr; S.bstride_e = (unsigned)D * DE * 4u; S.bstride_pn = 1024u;
        S.npn = 8; S.G = F.G; S.c = (int)blockIdx.x; S.tile_e = TE; S.tile_l = TL; S.rowtab = nullptr; S.gather = false;
        S.rt0 = E_rt; S.rt_end = ntile; S.rmax = 6; S.lin = 0; S.L0 = 0; S.Lend = 0; S.cl = 0; S.Gl = 1;
        FILL_RT2(S);
        pg8::EpiY2 E{(bf16*)(F.ws + WS_Y2), RT2};
        pg8::gemm_phase<pg8::EpiY2, pg8::MoeSched, true, 2>(F.lds, S, E);
        SEAM(pb + 6);
    }
#undef MOE_SPLIT
#undef PB_RT
#undef PB_BUSY
#undef FILL_RT
#undef FILL_RT2
}
__global__ void __launch_bounds__(512, 2) mega(Args args) {
    extern __shared__ __attribute__((aligned(16))) unsigned char lds_raw[];
    Frame F;
    F.lds = (LAS unsigned char*)lds_raw; F.MISC = (volatile LAS unsigned*)(F.lds + MISC_OFF);
    F.tid = threadIdx.x; F.lane = F.tid & 63; F.wave = __builtin_amdgcn_readfirstlane(F.tid >> 6);
    F.G = gridDim.x; { const int bx = blockIdx.x; F.vcu = (F.G % 8 == 0) ? (bx % 8) * (F.G / 8) + bx / 8 : bx; }
    F.in = args.in; F.out = args.out; F.ws = args.ws; F.ctl = (unsigned*)(args.ws + WS_CTL); F.qset = args.qset & 255; F.skip = args.qset >> 8;
    if (F.tid < 64) F.MISC[F.tid] = 0u;
    __syncthreads();
    const int lo = args.ph_lo, hi = args.ph_hi;
    XcdBarrier bar; bar.bar = F.ctl + CW_BAR + args.li * XCD_BAR_WORDS; bar.x = 0; bar.st = F.MISC;
    bar = xcd_barrier_post(F.ctl + CW_BAR + args.li * XCD_BAR_WORDS, F.MISC);
    if (IN(0)) { p0_prologue(F); SEAM(0); }
    layer_phases<0>(F, bar, lo, hi);
    layer_phases<1>(F, bar, lo, hi);
    if (IN(15)) { REFRESH(); p_norm<2>(F); }
}
#undef IN
#undef SEAM

extern "C" void kernel_launch(void* const* d_in, const int* in_sizes, int n_in, void* d_out, int out_size, void* d_ws, size_t ws_size, hipStream_t stream) {
    static int grid = 0;
    if (grid == 0) {
        if (n_in != 32 || out_size != T * D || ws_size < WS_END) { fprintf(stderr, "kernel_launch: unexpected shapes (n_in %d, out %d, ws %zu)\n", n_in, out_size, ws_size); grid = -1; return; }
        int dev = 0, cus = 0, per_cu = 0;
        if (hipGetDevice(&dev) != hipSuccess || hipDeviceGetAttribute(&cus, hipDeviceAttributeMultiprocessorCount, dev) != hipSuccess) { grid = -1; return; }
        if (hipFuncSetAttribute((const void*)mega, hipFuncAttributeMaxDynamicSharedMemorySize, LDS_BYTES) != hipSuccess) { fprintf(stderr, "kernel_launch: hipFuncSetAttribute failed\n"); grid = -1; return; }
        if (hipOccupancyMaxActiveBlocksPerMultiprocessor(&per_cu, (const void*)mega, 512, LDS_BYTES) != hipSuccess || per_cu < 1) fprintf(stderr, "kernel_launch: occupancy query reports %d\n", per_cu);
        (void)hipGetLastError();
        grid = cus;
    }
    if (grid < 0) return;
    if (hipMemsetAsync((char*)d_ws + WS_CTL, 0, CTL_BYTES, stream) != hipSuccess) return;
    Args a{};
    for (int i = 0; i < 32; ++i) a.in[i] = (const float*)d_in[i];
    a.out = (float*)d_out; a.ws = (unsigned char*)d_ws;
    static const int plan[][3] = { PLAN };
    for (int li = 0; li < (int)(sizeof(plan) / sizeof(plan[0])); ++li) { a.ph_lo = plan[li][0]; a.ph_hi = plan[li][1]; a.li = li; a.qset = plan[li][2];
        hipLaunchKernelGGL(mega, dim3(grid), dim3(512), LDS_BYTES, stream, a); }
}
```
